# Optimizing an MI355X kernel written in HIP

```python
import jax, jax.numpy as jnp
from jax import lax
import numpy as np

D_MODEL = 2048
BATCH = 1
SEQ = 16384
DEPTH = 4
DEC_BATCH = 16
DEC_SEQ = 2048
PAST_LEN = 128

N_MIXERS = 2
N_A_LAYERS = (DEPTH + 1) // 2
N_B_LAYERS = DEPTH // 2
CONV_WIDTH = 3
CONV_DIM = D_MODEL
N_FGROUPS = 8
FGROUP_DIM = D_MODEL // N_FGROUPS
D_FF = 4 * D_MODEL
RMS_EPS = 1e-6

kernel_name = "hybrid_conv_fourier_encoder"


def _rmsnorm(x, g):
    xf = x.astype(jnp.float32)
    y = xf * lax.rsqrt(jnp.mean(xf * xf, axis=-1, keepdims=True) + RMS_EPS)
    return (y * g.astype(jnp.float32)).astype(x.dtype)


def _short_conv_mixer(h, w_in, conv_w, w_out):
    s = h.shape[1]
    b_gate, c_gate, v = jnp.split(h @ w_in, 3, axis=-1)
    u = c_gate * v
    u_pad = jnp.pad(u, ((0, 0), (1, 1), (0, 0)))
    conv = (conv_w[0] * u_pad[:, 0:s]
            + conv_w[1] * u_pad[:, 1:s + 1]
            + conv_w[2] * u_pad[:, 2:s + 2])
    return (b_gate * conv) @ w_out


def _fourier_mixer(h, w_out):
    b, s, d = h.shape
    hg = h.astype(jnp.float32).reshape(b, s, N_FGROUPS, FGROUP_DIM)
    mixed = jnp.fft.fftn(hg, axes=(1, 3), norm="ortho").real
    return mixed.reshape(b, s, d).astype(h.dtype) @ w_out


def _mlp(h, w_up, w_down):
    return jnp.square(jax.nn.relu(h @ w_up)) @ w_down


def _trunk(x, norm_mix, a_w_in, a_conv_w, a_w_out, f_w_out, norm_ffn, w_up, w_down, final_norm):
    for i in range(DEPTH):
        h = _rmsnorm(x, norm_mix[i])
        j = i // N_MIXERS
        if i % N_MIXERS == 0:
            x = x + _short_conv_mixer(h, a_w_in[j], a_conv_w[j], a_w_out[j])
        else:
            x = x + _fourier_mixer(h, f_w_out[j])
        x = x + _mlp(_rmsnorm(x, norm_ffn[i]), w_up[i], w_down[i])
    return _rmsnorm(x, final_norm)


def setup_inputs(seed: int = 0) -> dict:
    key = jax.random.key(seed)
    ks = jax.random.split(key, 12)
    f32 = jnp.float32
    d = D_MODEL
    x_prompt = jax.random.normal(ks[0], (BATCH, SEQ, d), f32)
    x_sample = jax.random.normal(ks[1], (DEC_BATCH, DEC_SEQ, d), f32)
    norm_mix = 1.0 + 0.02 * jax.random.normal(ks[2], (DEPTH, d), f32)
    a_w_in = jax.random.normal(ks[3], (N_A_LAYERS, d, 3 * CONV_DIM), f32) * d ** -0.5
    a_conv_w = jax.random.normal(ks[4], (N_A_LAYERS, CONV_WIDTH, CONV_DIM), f32) * CONV_WIDTH ** -0.5
    a_w_out = jax.random.normal(ks[5], (N_A_LAYERS, CONV_DIM, d), f32) * CONV_DIM ** -0.5
    f_w_out = jax.random.normal(ks[6], (N_B_LAYERS, d, d), f32) * d ** -0.5
    norm_ffn = 1.0 + 0.02 * jax.random.normal(ks[7], (DEPTH, d), f32)
    w_up = jax.random.normal(ks[8], (DEPTH, d, D_FF), f32) * d ** -0.5
    w_down = jax.random.normal(ks[9], (DEPTH, D_FF, d), f32) * D_FF ** -0.5
    final_norm = 1.0 + 0.02 * jax.random.normal(ks[10], (d,), f32)
    return {"x_prompt": x_prompt, "x_sample": x_sample, "norm_mix": norm_mix,
            "a_w_in": a_w_in, "a_conv_w": a_conv_w, "a_w_out": a_w_out,
            "f_w_out": f_w_out, "norm_ffn": norm_ffn, "w_up": w_up,
            "w_down": w_down, "final_norm": final_norm}


def reference(x_prompt, x_sample, norm_mix, a_w_in, a_conv_w, a_w_out, f_w_out,
              norm_ffn, w_up, w_down, final_norm):
    y_prompt = _trunk(x_prompt, norm_mix, a_w_in, a_conv_w, a_w_out, f_w_out,
                      norm_ffn, w_up, w_down, final_norm)
    y_sample = _trunk(x_sample, norm_mix, a_w_in, a_conv_w, a_w_out, f_w_out,
                      norm_ffn, w_up, w_down, final_norm)
    return (y_prompt, y_sample)
```

```cpp
#include <hip/hip_runtime.h>
#include <cstdio>
#include <cstdint>

#define LAS __attribute__((address_space(3)))
#define GAS __attribute__((address_space(1)))
typedef unsigned short bf16_t;
typedef short bf16x8 __attribute__((ext_vector_type(8)));
typedef float f32x4 __attribute__((ext_vector_type(4)));
typedef float f32x2 __attribute__((ext_vector_type(2)));
typedef unsigned u32x4 __attribute__((ext_vector_type(4)));
typedef unsigned u32x2 __attribute__((ext_vector_type(2)));
typedef GAS unsigned gu32;

constexpr int D = 2048, DFF = 8192, SP = 16384, SS = 2048, NB = 16;
constexpr int MP = SP, MS = NB * SS, M = MP + MS;
constexpr int CG = 256, NGRP = 8, RAD = SP / SS;
constexpr int NSEQ = RAD + NB;
constexpr int MCH = M / 2;
constexpr float RMS_EPS = 1e-6f;

constexpr size_t MiB = 1u << 20;
constexpr size_t WS_CTL = 0, CTL_ZERO_BYTES = 1 * MiB;
constexpr size_t WS_WIN = 1 * MiB;
constexpr size_t WS_AWO = WS_WIN + 48 * MiB;
constexpr size_t WS_FWO = WS_AWO + 16 * MiB;
constexpr size_t WS_WUP = WS_FWO + 16 * MiB;
constexpr size_t WS_WDN = WS_WUP + 128 * MiB;
constexpr size_t WS_HART = WS_WDN + 128 * MiB;
constexpr size_t WS_PT = WS_HART + 8 * MiB;
constexpr size_t WS_TW = WS_PT + 1 * MiB;
constexpr size_t WS_B1 = WS_TW + 1 * MiB;
constexpr size_t WS_B2 = WS_B1 + 192 * MiB;
constexpr size_t WS_B3 = WS_B2 + 192 * MiB;
constexpr size_t WS_END = WS_B3 + 192 * MiB;
static_assert((size_t)M * D * 2 == 192 * MiB && (size_t)MCH * DFF * 2 == 384 * MiB, "buffer sizes");
constexpr int CW_BAR = 4096;

constexpr int RING_BYTES = 131072, LDSCTL_OFF = RING_BYTES, MISC_OFF = LDSCTL_OFF + 320, LDS_BYTES = 147456;
constexpr int NWAVES = 8;

__device__ __forceinline__ unsigned cvt_pk_bf16(float lo, float hi) { unsigned r; asm volatile("v_cvt_pk_bf16_f32 %0, %1, %2" : "=v"(r) : "v"(lo), "v"(hi)); return r; }
__device__ __forceinline__ float bf_lo(unsigned w) { return __builtin_bit_cast(float, w << 16); }
__device__ __forceinline__ float bf_hi(unsigned w) { return __builtin_bit_cast(float, w & 0xffff0000u); }
__device__ __forceinline__ float bf_at(const u32x4& v, int i) { const unsigned w = v[i >> 1]; return (i & 1) ? bf_hi(w) : bf_lo(w); }
#define LDS_WAIT() asm volatile("s_waitcnt lgkmcnt(0)" ::: "memory")

namespace pg8 {
constexpr int BM = 256, BK = 64, HALF = 128, HTB = HALF * BK * 2, STAGE_BYTES = 8 * HTB, NXCD = 8, WGM = 8;
__host__ __device__ __forceinline__ int lds_byte(int r, int c) { const int st = (r >> 4) * 2 + (c >> 5), rr = r & 15, cc = c & 31, ob = rr * 64 + cc * 2; return st * 1024 + (ob ^ (((ob >> 9) & 1) << 5)); }
__host__ __device__ __forceinline__ void stage_rc(int b, int& R, int& C) { const int st = b / 1024, sb = b % 1024, swz = sb ^ (((sb >> 9) & 1) << 5); R = (st >> 1) * 16 + swz / 64; C = (st & 1) * 32 + (swz % 64) / 2; }
__host__ __device__ __forceinline__ int perm32(int rho) { const int n = rho >> 4, i = rho & 15; return 8 * (i >> 2) + 4 * n + (i & 3); }

struct Unit { int pm, pn; };
struct StaticOrder {
    int nM, nN, nwg, G, c;
    __device__ __forceinline__ void init(int M_, int N_, int G_, int c_) { nM = M_ / BM; nN = N_ / BM; nwg = nM * nN; G = G_; c = c_; }
    __device__ __forceinline__ bool next(int i, Unit& u) const {
        const long L = (long)i * G + c; if (L >= nwg) return false;
        int wgid = (int)L; { const int q = nwg / NXCD, r = nwg % NXCD, xcd = wgid % NXCD, off = wgid / NXCD; wgid = (xcd < r ? xcd * (q + 1) : r * (q + 1) + (xcd - r) * q) + off; }
        const int nig = WGM * nN, gid = wgid / nig, fm = gid * WGM, gsz = (nM - fm) < WGM ? (nM - fm) : WGM;
        u.pm = fm + ((wgid % nig) % gsz); u.pn = (wgid % nig) / gsz; return true;
    }
};
struct DescPlain { const bf16_t* A; const bf16_t* Bt; int K, lda, ldb;
    __device__ __forceinline__ const char* abase(const Unit& u) const { return (const char*)A + (size_t)u.pm * BM * lda * 2; }
    __device__ __forceinline__ const char* bbase(const Unit& u) const { return (const char*)Bt + (size_t)u.pn * BM * ldb * 2; } };
struct DescF0 { const bf16_t* A; const bf16_t* Bt; int K, lda, ldb;
    __device__ __forceinline__ const char* abase(const Unit&) const { return (const char*)A; }
    __device__ __forceinline__ const char* bbase(const Unit& u) const { return (const char*)Bt + ((size_t)u.pn * BM * ldb + (size_t)u.pm * CG) * 2; } };
struct DescF2 { const bf16_t* A; const bf16_t* Bt; int K, lda, ldb;
    __device__ __forceinline__ const char* abase(const Unit& u) const { return (const char*)A + (size_t)(u.pm & 7) * BM * lda * 2; }
    __device__ __forceinline__ const char* bbase(const Unit& u) const { return (const char*)Bt + ((size_t)(u.pm >> 3) * D + (size_t)u.pn * BM) * ldb * 2; } };

struct EpiRes {
    static constexpr bool PERM = false;
    float* X;
    __device__ __forceinline__ void operator()(const f32x4 (&acc)[2][2][4][2], const Unit& u, int wr, int wc, int fr, int fq) const {
        GAS char* ub = (GAS char*)X + ((size_t)u.pm * BM * D + (size_t)u.pn * BM) * 4;
        const unsigned lo = (unsigned)((wr * 64 + fr) * D + wc * 32 + 4 * fq) * 4u;
#pragma unroll
        for (int ai = 0; ai < 2; ++ai)
#pragma unroll
            for (int m = 0; m < 4; ++m) { GAS char* rb = ub + (size_t)(ai * HALF + m * 16) * D * 4;
                f32x4 xv[2][2];
#pragma unroll
                for (int bj = 0; bj < 2; ++bj)
#pragma unroll
                    for (int n = 0; n < 2; ++n) xv[bj][n] = *(const GAS f32x4*)(rb + lo + (bj * HALF + n * 16) * 4);
#pragma unroll
                for (int bj = 0; bj < 2; ++bj)
#pragma unroll
                    for (int n = 0; n < 2; ++n) *(GAS f32x4*)(rb + lo + (bj * HALF + n * 16) * 4) = xv[bj][n] + acc[ai][bj][m][n];
                asm volatile("" ::: "memory"); }
    }
};
template <int MODE  > struct EpiBf16 {
    static constexpr bool PERM = true;
    bf16_t* O; int ldc;
    __device__ __forceinline__ void operator()(const f32x4 (&acc)[2][2][4][2], const Unit& u, int wr, int wc, int fr, int fq) const {
        GAS char* ub;
        if (MODE == 2) ub = (GAS char*)O + (((size_t)(u.pn >> 3) * D + (size_t)u.pm * BM) * SS + (size_t)(u.pn & 7) * BM) * 2;
        else ub = (GAS char*)O + ((size_t)u.pm * BM * ldc + (size_t)u.pn * BM) * 2;
        const unsigned lo = (unsigned)((wr * 64 + fr) * ldc + wc * 32 + 8 * fq) * 2u;
#pragma unroll
        for (int ai = 0; ai < 2; ++ai)
#pragma unroll
            for (int m = 0; m < 4; ++m) { GAS char* rb = ub + (size_t)(ai * HALF + m * 16) * ldc * 2;
#pragma unroll
                for (int bj = 0; bj < 2; ++bj) { f32x4 v0 = acc[ai][bj][m][0], v1 = acc[ai][bj][m][1];
                    if (MODE == 1) {
#pragma unroll
                        for (int j = 0; j < 4; ++j) { const float a = fmaxf(v0[j], 0.f), b = fmaxf(v1[j], 0.f); v0[j] = a * a; v1[j] = b * b; } }
                    u32x4 w; w.x = cvt_pk_bf16(v0[0], v0[1]); w.y = cvt_pk_bf16(v0[2], v0[3]); w.z = cvt_pk_bf16(v1[0], v1[1]); w.w = cvt_pk_bf16(v1[2], v1[3]);
                    *(GAS u32x4*)(rb + lo + bj * HALF * 2) = w; } }
    }
};
struct EpiGate {
    static constexpr bool PERM = true;
    bf16_t* Bo; bf16_t* Uo;
    __device__ __forceinline__ void operator()(const f32x4 (&acc)[2][2][4][2], const Unit& u, int wr, int wc, int fr, int fq) const {
        const unsigned lo = (unsigned)((wr * 64 + fr) * D + wc * 32 + 8 * fq) * 2u;
        if (u.pn < 8) {
            GAS char* ub = (GAS char*)Bo + ((size_t)u.pm * BM * D + (size_t)u.pn * BM) * 2;
#pragma unroll
            for (int ai = 0; ai < 2; ++ai)
#pragma unroll
                for (int m = 0; m < 4; ++m) { GAS char* rb = ub + (size_t)(ai * HALF + m * 16) * D * 2;
#pragma unroll
                    for (int bj = 0; bj < 2; ++bj) { const f32x4 v0 = acc[ai][bj][m][0], v1 = acc[ai][bj][m][1];
                        u32x4 w; w.x = cvt_pk_bf16(v0[0], v0[1]); w.y = cvt_pk_bf16(v0[2], v0[3]); w.z = cvt_pk_bf16(v1[0], v1[1]); w.w = cvt_pk_bf16(v1[2], v1[3]);
                        *(GAS u32x4*)(rb + lo + bj * HALF * 2) = w; } }
        } else {
            GAS char* ub = (GAS char*)Uo + ((size_t)u.pm * BM * D + (size_t)(u.pn - 8) * HALF) * 2;
#pragma unroll
            for (int ai = 0; ai < 2; ++ai)
#pragma unroll
                for (int m = 0; m < 4; ++m) { GAS char* rb = ub + (size_t)(ai * HALF + m * 16) * D * 2;
                    const f32x4 v0 = acc[ai][0][m][0] * acc[ai][1][m][0], v1 = acc[ai][0][m][1] * acc[ai][1][m][1];
                    u32x4 w; w.x = cvt_pk_bf16(v0[0], v0[1]); w.y = cvt_pk_bf16(v0[2], v0[3]); w.z = cvt_pk_bf16(v1[0], v1[1]); w.w = cvt_pk_bf16(v1[2], v1[3]);
                    *(GAS u32x4*)(rb + lo) = w; }
        }
    }
};

template <class Desc, class Epi, bool ALIGN_EPI, bool SP2>
__device__ __forceinline__ void gemm_phase(LAS unsigned char* lds, const Desc g, const StaticOrder& S, const Epi& E) {
    int tid_ = threadIdx.x; asm volatile("" : "+v"(tid_));
    const int tid = tid_, wid = __builtin_amdgcn_readfirstlane(tid >> 6), lane = tid & 63, wr = wid >> 2, wc = wid & 3, fr = lane & 15, fq = lane >> 4;
    const int K = g.K, nt = K / BK, lda = g.lda, ldb = g.ldb;
    unsigned voffA[2], voffB[2];
#pragma unroll
    for (int i = 0; i < 2; ++i) { int R, C; stage_rc(tid * 16 + i * 8192, R, C); const int Rb = Epi::PERM ? ((R & ~31) + perm32(R & 31)) : R;
        voffA[i] = (unsigned)(R * lda + C) * 2u; voffB[i] = (unsigned)(Rb * ldb + C) * 2u; }
    const size_t kstep = (size_t)(BK * 2);
    const size_t hstepA = (size_t)HALF * lda * 2, hstepB = (size_t)HALF * ldb * 2;
    const unsigned ldsw = (unsigned)wid * 1024u;
    const int aoff = lds_byte(wr * 64 + fr, fq * 8), boff = lds_byte(wc * 32 + fr, fq * 8);
#define PG8_SA(b, h) (((b) * 2 + (h)) * HTB)
#define PG8_SB(b, h) ((4 + (b) * 2 + (h)) * HTB)
#define PG8_STAGE(bufoff, gbase, voff) do { _Pragma("unroll") for (int _i = 0; _i < 2; ++_i) \
        __builtin_amdgcn_global_load_lds((const unsigned*)((const char*)(gbase) + (voff)[_i]), (LAS unsigned*)(lds + (bufoff) + ldsw + _i * 8192), 16, 0, 0); } while (0)
#define PG8_LDA(dst, b, h) do { _Pragma("unroll") for (int m = 0; m < 4; ++m) _Pragma("unroll") for (int k = 0; k < 2; ++k) dst[m][k] = *(const LAS bf16x8*)(lds + PG8_SA(b, h) + aoff + m * 2048 + k * 1024); } while (0)
#define PG8_LDB(dst, b, h) do { _Pragma("unroll") for (int n = 0; n < 2; ++n) _Pragma("unroll") for (int k = 0; k < 2; ++k) dst[n][k] = *(const LAS bf16x8*)(lds + PG8_SB(b, h) + boff + n * 2048 + k * 1024); } while (0)
#define PG8_MMA(ai, bj, At, Bt) do { __builtin_amdgcn_s_setprio(1); _Pragma("unroll") for (int m = 0; m < 4; ++m) _Pragma("unroll") for (int n = 0; n < 2; ++n) _Pragma("unroll") for (int k = 0; k < 2; ++k) \
        acc[ai][bj][m][n] = __builtin_amdgcn_mfma_f32_16x16x32_bf16(Bt[n][k], At[m][k], acc[ai][bj][m][n], 0, 0, 0); __builtin_amdgcn_s_setprio(0); } while (0)
#define PG8_WAIT_V(n) asm volatile("s_waitcnt vmcnt(" #n ")" ::: "memory")
#define PG8_WAIT_L(n) asm volatile("s_waitcnt lgkmcnt(" #n ")" ::: "memory")
#define PG8_BAR __builtin_amdgcn_s_barrier()
#define PG8_SCHED __builtin_amdgcn_sched_barrier(0)
    Unit cur, nxt; int ui = 0;
    if (!S.next(0, cur)) return;
    f32x4 acc[2][2][4][2];
#pragma unroll
    for (int a = 0; a < 2; ++a)
#pragma unroll
        for (int b = 0; b < 2; ++b)
#pragma unroll
            for (int m = 0; m < 4; ++m)
#pragma unroll
                for (int n = 0; n < 2; ++n) acc[a][b][m][n] = (f32x4){0.f, 0.f, 0.f, 0.f};
    bf16x8 At[4][2], B0[2][2], B1[2][2];
    const char* cA = g.abase(cur); const char* cB = g.bbase(cur);
    if constexpr (SP2) {
        PG8_STAGE(PG8_SB(0, 0), cB, voffB); PG8_STAGE(PG8_SB(0, 1), cB + hstepB, voffB); PG8_STAGE(PG8_SA(0, 0), cA, voffA); PG8_STAGE(PG8_SA(0, 1), cA + hstepA, voffA);
        if (wr == 1) PG8_BAR;
        PG8_WAIT_V(2); PG8_BAR;
        PG8_STAGE(PG8_SB(1, 0), cB + kstep, voffB); PG8_STAGE(PG8_SA(1, 0), cA + kstep, voffA); PG8_STAGE(PG8_SB(1, 1), cB + hstepB + kstep, voffB);
        PG8_WAIT_V(6); PG8_BAR;
    } else {
        PG8_STAGE(PG8_SB(0, 0), cB, voffB); PG8_STAGE(PG8_SA(0, 0), cA, voffA); PG8_STAGE(PG8_SB(0, 1), cB + hstepB, voffB); PG8_STAGE(PG8_SA(0, 1), cA + hstepA, voffA);
        if (wr == 1) PG8_BAR;
        PG8_WAIT_V(4); PG8_BAR;
        PG8_STAGE(PG8_SB(1, 0), cB + kstep, voffB); PG8_STAGE(PG8_SA(1, 0), cA + kstep, voffA); PG8_STAGE(PG8_SB(1, 1), cB + hstepB + kstep, voffB);
        PG8_WAIT_V(6); PG8_BAR;
    }
    for (;;) {
        const bool has_next = S.next(ui + 1, nxt);
        const char* nA = has_next ? g.abase(nxt) : cA; const char* nB = has_next ? g.bbase(nxt) : cB;
#pragma unroll 1
        for (int t = 0; t < nt; t += 2) {
            const bool last = (t == nt - 2);
            const char* a1 = cA + (size_t)(t + 1) * kstep;
            const char* a2 = last ? nA : cA + (size_t)(t + 2) * kstep; const char* b2 = last ? nB : cB + (size_t)(t + 2) * kstep;
            const char* a3 = a2 + kstep; const char* b3 = b2 + kstep;
            if constexpr (SP2) {
            PG8_LDB(B0, 0, 0); PG8_LDB(B1, 0, 1); PG8_SCHED; PG8_LDA(At, 0, 0); PG8_STAGE(PG8_SA(1, 1), a1 + hstepA, voffA);
            PG8_WAIT_V(8); PG8_WAIT_L(0); PG8_BAR; PG8_MMA(0, 0, At, B0); PG8_MMA(0, 1, At, B1); PG8_BAR; PG8_SCHED;
            PG8_LDA(At, 0, 1); PG8_STAGE(PG8_SB(0, 0), b2, voffB); PG8_STAGE(PG8_SB(0, 1), b2 + hstepB, voffB); PG8_STAGE(PG8_SA(0, 0), a2, voffA);
            PG8_WAIT_V(8); PG8_WAIT_L(0); PG8_BAR; PG8_MMA(1, 0, At, B0); PG8_MMA(1, 1, At, B1); PG8_BAR; PG8_SCHED;
            PG8_LDB(B0, 1, 0); PG8_LDB(B1, 1, 1); PG8_SCHED; PG8_LDA(At, 1, 0); PG8_STAGE(PG8_SA(0, 1), a2 + hstepA, voffA);
            PG8_WAIT_V(8); PG8_WAIT_L(0); PG8_BAR; PG8_MMA(0, 0, At, B0); PG8_MMA(0, 1, At, B1); PG8_BAR; PG8_SCHED;
            PG8_LDA(At, 1, 1); PG8_STAGE(PG8_SB(1, 0), b3, voffB); PG8_STAGE(PG8_SB(1, 1), b3 + hstepB, voffB); PG8_STAGE(PG8_SA(1, 0), a3, voffA);
            PG8_WAIT_V(8); PG8_WAIT_L(0); PG8_BAR; PG8_MMA(1, 0, At, B0); PG8_MMA(1, 1, At, B1); PG8_BAR; PG8_SCHED;
            } else {
            PG8_LDB(B0, 0, 0); PG8_SCHED; PG8_LDA(At, 0, 0); PG8_STAGE(PG8_SA(1, 1), a1 + hstepA, voffA);
            PG8_WAIT_L(8); PG8_BAR; PG8_WAIT_L(0); PG8_MMA(0, 0, At, B0); PG8_BAR; PG8_SCHED;
            PG8_LDB(B1, 0, 1); PG8_STAGE(PG8_SB(0, 0), b2, voffB);
            PG8_BAR; PG8_WAIT_L(0); PG8_MMA(0, 1, At, B1); PG8_BAR;
            PG8_LDA(At, 0, 1); PG8_STAGE(PG8_SA(0, 0), a2, voffA);
            PG8_BAR; PG8_WAIT_L(0); PG8_MMA(1, 0, At, B0); PG8_BAR; PG8_SCHED;
            PG8_STAGE(PG8_SB(0, 1), b2 + hstepB, voffB);
            PG8_WAIT_V(6); PG8_BAR; PG8_MMA(1, 1, At, B1); PG8_BAR;
            PG8_LDB(B0, 1, 0); PG8_SCHED; PG8_LDA(At, 1, 0); PG8_STAGE(PG8_SA(0, 1), a2 + hstepA, voffA);
            PG8_WAIT_L(8); PG8_BAR; PG8_WAIT_L(0); PG8_MMA(0, 0, At, B0); PG8_BAR; PG8_SCHED;
            PG8_LDB(B1, 1, 1); PG8_STAGE(PG8_SB(1, 0), b3, voffB);
            PG8_BAR; PG8_WAIT_L(0); PG8_MMA(0, 1, At, B1); PG8_BAR;
            PG8_LDA(At, 1, 1); PG8_STAGE(PG8_SA(1, 0), a3, voffA);
            PG8_BAR; PG8_WAIT_L(0); PG8_MMA(1, 0, At, B0); PG8_BAR; PG8_SCHED;
            PG8_STAGE(PG8_SB(1, 1), b3 + hstepB, voffB);
            PG8_WAIT_V(6); PG8_BAR; PG8_MMA(1, 1, At, B1); PG8_BAR;
            }
        }
        if constexpr (ALIGN_EPI) { if (wr == 0) PG8_BAR; }
        E(acc, cur, wr, wc, fr, fq);
        if (!has_next) break;
#pragma unroll
        for (int a = 0; a < 2; ++a)
#pragma unroll
            for (int b = 0; b < 2; ++b)
#pragma unroll
                for (int m = 0; m < 4; ++m)
#pragma unroll
                    for (int n = 0; n < 2; ++n) acc[a][b][m][n] = (f32x4){0.f, 0.f, 0.f, 0.f};
        cur = nxt; cA = nA; cB = nB; ++ui;
        if constexpr (ALIGN_EPI) { if (wr == 1) PG8_BAR; }
    }
    PG8_WAIT_V(0);
    if constexpr (!ALIGN_EPI) { if (wr == 0) PG8_BAR; }
    PG8_BAR;
#undef PG8_SA
#undef PG8_SB
#undef PG8_STAGE
#undef PG8_LDA
#undef PG8_LDB
#undef PG8_MMA
#undef PG8_WAIT_V
#undef PG8_WAIT_L
#undef PG8_BAR
#undef PG8_SCHED
}
}

#define XB_TMO      128
#define XB_XCNT(j)  (256  + 64 * (j))
#define XB_XSUB(j)  (1280 + 64 * (j))
#define XB_XGEN(j)  (2304 + 64 * (j))
#define XB_TOP      3328
#define XB_TOPGEN   3392
#define XCD_BAR_WORDS 3456
#define XB_SPIN_CAP (1u << 18)
__device__ __forceinline__ unsigned xb_ld(unsigned* p)              { return __hip_atomic_load(p, __ATOMIC_RELAXED, __HIP_MEMORY_SCOPE_AGENT); }
__device__ __forceinline__ unsigned xb_add(unsigned* p, unsigned v) { return __hip_atomic_fetch_add(p, v, __ATOMIC_RELAXED, __HIP_MEMORY_SCOPE_AGENT); }
__device__ __forceinline__ unsigned xb_xcc_id() { return (unsigned)__builtin_amdgcn_s_getreg((3 << 11) | 20) & 0xFu; }
#define XB_SPIN(cond, bar) do { unsigned _sp = 0; while (cond) { __builtin_amdgcn_s_sleep(1); \
    if ((++_sp & 255u) == 0u) { if (xb_ld(&(bar)[XB_TMO])) break; if (_sp > XB_SPIN_CAP) { atomicAdd(&(bar)[XB_TMO], 1u); break; } } } } while (0)
struct XcdBarrier { unsigned* bar; unsigned x; volatile LAS unsigned* st; };
__device__ __forceinline__ XcdBarrier xcd_barrier_post(unsigned* bar, volatile LAS unsigned* st) {
    XcdBarrier b; b.bar = bar; b.x = xb_xcc_id(); b.st = st;
    if (threadIdx.x == 0) (void)xb_add(&bar[XB_XCNT(b.x)], 1u);
    return b;
}
__device__ __forceinline__ void xcd_barrier_complete(unsigned* bar, unsigned x, unsigned& nloc, unsigned& nx) {
    const unsigned G = gridDim.x * gridDim.y * gridDim.z;
    unsigned sum, cnt, mine, sp = 0u;
    for (;;) {
        sum = 0u; cnt = 0u; mine = 0u;
#pragma unroll
        for (unsigned j = 0; j < 16; ++j) { const unsigned c = xb_ld(&bar[XB_XCNT(j)]); sum += c; cnt += (c > 0u) ? 1u : 0u; mine = (j == x) ? c : mine; }
        if (sum == G) break;
        __builtin_amdgcn_s_sleep(1);
        if ((++sp & 255u) == 0u) { if (xb_ld(&bar[XB_TMO])) break; if (sp > XB_SPIN_CAP) { atomicAdd(&bar[XB_TMO], 1u); break; } }
    }
    nloc = mine > 0u ? mine : 1u; nx = cnt > 0u ? cnt : 1u;
}
__device__ __forceinline__ void xcd_barrier(const XcdBarrier& b) {
    asm volatile("s_waitcnt vmcnt(0)" ::: "memory");
    __syncthreads();
    if (threadIdx.x == 0) {
        unsigned* bar = b.bar;
        __builtin_amdgcn_s_waitcnt(0);
        unsigned nloc = b.st[0], nx = b.st[1];
        if (nloc == 0u) { xcd_barrier_complete(bar, b.x, nloc, nx); b.st[0] = nloc; b.st[1] = nx; }
        const unsigned old = xb_add(&bar[XB_XSUB(b.x)], 1u);
        const unsigned gen = old / nloc;
        if (old + 1u == (gen + 1u) * nloc) {
            __builtin_amdgcn_fence(__ATOMIC_RELEASE, "agent");
            asm volatile("s_waitcnt vmcnt(0)" ::: "memory");
            const unsigned og = xb_add(&bar[XB_TOP], 1u);
            const unsigned tg = og / nx;
            if (og + 1u == (tg + 1u) * nx) xb_add(&bar[XB_TOPGEN], 1u);
            else XB_SPIN(xb_ld(&bar[XB_TOPGEN]) == tg, bar);
            __builtin_amdgcn_fence(__ATOMIC_ACQUIRE, "agent");
            xb_add(&bar[XB_XGEN(b.x)], 1u);
            asm volatile("s_waitcnt vmcnt(0)" ::: "memory");
        } else {
            XB_SPIN(xb_ld(&bar[XB_XGEN(b.x)]) == gen, bar);
            __builtin_amdgcn_fence(__ATOMIC_ACQUIRE, "agent");
            asm volatile("s_waitcnt vmcnt(0)" ::: "memory");
        }
    }
    __syncthreads();
}

__device__ __forceinline__ float wave_sum(float v) {
#pragma unroll
    for (int o = 1; o < 64; o <<= 1) v += __shfl_xor(v, o);
    return v;
}
__device__ __forceinline__ void transpose_item(const float* W, int K, int N, bf16_t* WT, int k0, int n0, int drow0, LAS float* scr, int lane) {
#pragma unroll 8
    for (int i = 0; i < 32; ++i) { const int kk = 2 * i + (lane >> 5); scr[kk * 33 + (lane & 31)] = ((const GAS float*)W)[(size_t)(k0 + kk) * N + n0 + (lane & 31)]; }
    LDS_WAIT(); asm volatile("" ::: "memory");
    const int c = lane & 7;
#pragma unroll
    for (int j = 0; j < 4; ++j) { const int n = (lane >> 3) + 8 * j; const LAS float* s = scr + (8 * c) * 33 + n;
        u32x4 o; o.x = cvt_pk_bf16(s[0 * 33], s[1 * 33]); o.y = cvt_pk_bf16(s[2 * 33], s[3 * 33]); o.z = cvt_pk_bf16(s[4 * 33], s[5 * 33]); o.w = cvt_pk_bf16(s[6 * 33], s[7 * 33]);
        *(GAS u32x4*)(WT + (size_t)(drow0 + n) * K + k0 + 8 * c) = o; }
    LDS_WAIT(); asm volatile("" ::: "memory");
}
__device__ __forceinline__ int win_row(int n) {
    if (n < D) return n;
    const int which = (n >= 2 * D) ? 1 : 0, cc = n - D - which * D;
    return D + (cc >> 7) * 256 + which * 128 + (cc & 127);
}
__device__ __forceinline__ float cas_pi(float t) { float s, c; sincospif(t, &s, &c); return c + s; }

struct Ptrs {
    const float *x_prompt, *x_sample, *norm_mix, *a_w_in, *a_conv_w, *a_w_out, *f_w_out, *norm_ffn, *w_up, *w_down, *final_norm;
    float* out; unsigned char* ws;
};

__device__ __forceinline__ void prologue(const Ptrs& P, LAS unsigned char* lds, int gw, int NGW, int wave, int lane_) {
    int lane = lane_; asm volatile("" : "+v"(lane));
    LAS float* scr = (LAS float*)(lds + wave * 16384);
    bf16_t* WIN = (bf16_t*)(P.ws + WS_WIN); bf16_t* AWO = (bf16_t*)(P.ws + WS_AWO); bf16_t* FWO = (bf16_t*)(P.ws + WS_FWO);
    bf16_t* WUP = (bf16_t*)(P.ws + WS_WUP); bf16_t* WDN = (bf16_t*)(P.ws + WS_WDN);
    constexpr int I_IN = (D / 64) * (3 * D / 32), I_SQ = (D / 64) * (D / 32), I_UP = (D / 64) * (DFF / 32), I_DN = (DFF / 64) * (D / 32);
    constexpr int NITEMS = 2 * I_IN + 4 * I_SQ + 4 * I_UP + 4 * I_DN;
    for (int it = gw; it < NITEMS; it += NGW) {
        int r = it;
        if (r < 2 * I_IN) { const int j = r / I_IN; r -= j * I_IN; const int nblk = 3 * D / 32, kb = r / nblk, nb = r % nblk;
            transpose_item(P.a_w_in + (size_t)j * D * 3 * D, D, 3 * D, WIN + (size_t)j * 3 * D * D, 64 * kb, 32 * nb, win_row(32 * nb), scr, lane); continue; }
        r -= 2 * I_IN;
        if (r < 2 * I_SQ) { const int j = r / I_SQ; r -= j * I_SQ; const int nblk = D / 32, kb = r / nblk, nb = r % nblk;
            transpose_item(P.a_w_out + (size_t)j * D * D, D, D, AWO + (size_t)j * D * D, 64 * kb, 32 * nb, 32 * nb, scr, lane); continue; }
        r -= 2 * I_SQ;
        if (r < 2 * I_SQ) { const int j = r / I_SQ; r -= j * I_SQ; const int nblk = D / 32, kb = r / nblk, nb = r % nblk;
            transpose_item(P.f_w_out + (size_t)j * D * D, D, D, FWO + (size_t)j * D * D, 64 * kb, 32 * nb, 32 * nb, scr, lane); continue; }
        r -= 2 * I_SQ;
        if (r < 4 * I_UP) { const int j = r / I_UP; r -= j * I_UP; const int nblk = DFF / 32, kb = r / nblk, nb = r % nblk;
            transpose_item(P.w_up + (size_t)j * D * DFF, D, DFF, WUP + (size_t)j * D * DFF, 64 * kb, 32 * nb, 32 * nb, scr, lane); continue; }
        r -= 4 * I_UP;
        { const int j = r / I_DN; r -= j * I_DN; const int nblk = D / 32, kb = r / nblk, nb = r % nblk;
            transpose_item(P.w_down + (size_t)j * D * DFF, DFF, D, WDN + (size_t)j * D * DFF, 64 * kb, 32 * nb, 32 * nb, scr, lane); }
    }
    const int gl = gw * 64 + lane, NGL = NGW * 64;
    for (int i = gl; i < SS * SS / 8; i += NGL) { const int k = i / (SS / 8), s0 = (i % (SS / 8)) * 8; float v[8];
#pragma unroll
        for (int e = 0; e < 8; ++e) v[e] = cas_pi((float)((k * (s0 + e)) & (SS - 1)) * (1.0f / 1024.0f));
        u32x4 o; o.x = cvt_pk_bf16(v[0], v[1]); o.y = cvt_pk_bf16(v[2], v[3]); o.z = cvt_pk_bf16(v[4], v[5]); o.w = cvt_pk_bf16(v[6], v[7]);
        *(GAS u32x4*)((bf16_t*)(P.ws + WS_HART) + (size_t)k * SS + s0) = o; }
    for (int i = gl; i < CG * CG / 8; i += NGL) { const int c = i / (CG / 8), j0 = (i % (CG / 8)) * 8; float v[8];
#pragma unroll
        for (int e = 0; e < 8; ++e) v[e] = cas_pi(-(float)((c * (j0 + e)) & (CG - 1)) * (1.0f / 128.0f));
        u32x4 o; o.x = cvt_pk_bf16(v[0], v[1]); o.y = cvt_pk_bf16(v[2], v[3]); o.z = cvt_pk_bf16(v[4], v[5]); o.w = cvt_pk_bf16(v[6], v[7]);
        *(GAS u32x4*)((bf16_t*)(P.ws + WS_PT) + (size_t)c * CG + j0) = o; }
    for (int i = gl; i < SP * RAD; i += NGL) { const int k = i >> 3, s2 = i & 7; float s, c; sincospif((float)((k * s2) & (SP - 1)) * (1.0f / 8192.0f), &s, &c);
        ((GAS f32x2*)(P.ws + WS_TW))[i] = (f32x2){c, s}; }
    for (size_t i = (size_t)gl; i < (size_t)M * D / 4; i += (size_t)NGL) {
        const f32x4 v = (i < (size_t)MP * D / 4) ? ((const GAS f32x4*)P.x_prompt)[i] : ((const GAS f32x4*)P.x_sample)[i - (size_t)MP * D / 4];
        ((GAS f32x4*)P.out)[i] = v; }
}

template <bool PERMUTE> __device__ __forceinline__ void norm_phase(const float* x, const float* gain, bf16_t* out, int gw, int NGW, int lane_) {
    int lane = lane_; asm volatile("" : "+v"(lane));
    f32x4 gv[8];
#pragma unroll
    for (int j = 0; j < 8; ++j) gv[j] = ((const GAS f32x4*)gain)[lane + 64 * j];
    for (int m = gw; m < M; m += NGW) {
        const GAS f32x4* xr = (const GAS f32x4*)(x + (size_t)m * D) + lane;
        f32x4 v[8]; float s = 0.f;
#pragma unroll
        for (int j = 0; j < 8; ++j) { v[j] = xr[64 * j]; s += (v[j].x * v[j].x + v[j].y * v[j].y) + (v[j].z * v[j].z + v[j].w * v[j].w); }
        const float rstd = 1.0f / sqrtf(wave_sum(s) * (1.0f / D) + RMS_EPS);
        int mo = m; if (PERMUTE && m < MP) mo = (m & 7) * SS + (m >> 3);
        GAS u32x2* o8 = (GAS u32x2*)(out + (size_t)mo * D) + lane;
#pragma unroll
        for (int j = 0; j < 8; ++j) { const f32x4 y = v[j] * rstd * gv[j]; u32x2 w; w.x = cvt_pk_bf16(y.x, y.y); w.y = cvt_pk_bf16(y.z, y.w); o8[64 * j] = w; }
    }
}
__device__ __forceinline__ void final_norm_phase(float* x, const float* gain, int gw, int NGW, int lane_) {
    int lane = lane_; asm volatile("" : "+v"(lane));
    f32x4 gv[8];
#pragma unroll
    for (int j = 0; j < 8; ++j) gv[j] = ((const GAS f32x4*)gain)[lane + 64 * j];
    for (int m = gw; m < M; m += NGW) {
        GAS f32x4* xr = (GAS f32x4*)(x + (size_t)m * D) + lane;
        f32x4 v[8]; float s = 0.f;
#pragma unroll
        for (int j = 0; j < 8; ++j) { v[j] = xr[64 * j]; s += (v[j].x * v[j].x + v[j].y * v[j].y) + (v[j].z * v[j].z + v[j].w * v[j].w); }
        const float rstd = 1.0f / sqrtf(wave_sum(s) * (1.0f / D) + RMS_EPS);
#pragma unroll
        for (int j = 0; j < 8; ++j) xr[64 * j] = v[j] * rstd * gv[j];
    }
}
__device__ __forceinline__ void conv_phase(const bf16_t* Bb, const bf16_t* Ub, const float* cw, bf16_t* Gb, int gw, int NGW, int lane_) {
    int lane = lane_; asm volatile("" : "+v"(lane));
    for (int chunk = gw; chunk < M / 8; chunk += NGW) {
        const int m0 = chunk * 8;
        const bool first = (m0 == 0) || (m0 >= MP && ((m0 - MP) & (SS - 1)) == 0);
        const bool last = (m0 + 8 == MP) || (m0 >= MP && ((m0 + 8 - MP) & (SS - 1)) == 0);
#pragma unroll 1
        for (int j = 0; j < 4; ++j) {
            const int ch0 = (lane + 64 * j) * 8;
            float w0[8], w1[8], w2[8];
#pragma unroll
            for (int h = 0; h < 2; ++h) { const f32x4 a = *(const GAS f32x4*)(cw + ch0 + 4 * h), b = *(const GAS f32x4*)(cw + D + ch0 + 4 * h), c = *(const GAS f32x4*)(cw + 2 * D + ch0 + 4 * h);
#pragma unroll
                for (int e = 0; e < 4; ++e) { w0[4 * h + e] = a[e]; w1[4 * h + e] = b[e]; w2[4 * h + e] = c[e]; } }
            const GAS u32x4* up = (const GAS u32x4*)(Ub + (size_t)m0 * D + ch0);
            const GAS u32x4* bp = (const GAS u32x4*)(Bb + (size_t)m0 * D + ch0);
            GAS u32x4* gp = (GAS u32x4*)(Gb + (size_t)m0 * D + ch0);
            u32x4 prev = (u32x4){0u, 0u, 0u, 0u}; if (!first) prev = *(up - D / 8);
            u32x4 cur = *up;
#pragma unroll
            for (int r = 0; r < 8; ++r) {
                u32x4 nxt = (u32x4){0u, 0u, 0u, 0u}; if (!(r == 7 && last)) nxt = up[(size_t)(r + 1) * (D / 8)];
                const u32x4 bv = bp[(size_t)r * (D / 8)];
                float o[8];
#pragma unroll
                for (int e = 0; e < 8; ++e) o[e] = bf_at(bv, e) * (w0[e] * bf_at(prev, e) + w1[e] * bf_at(cur, e) + w2[e] * bf_at(nxt, e));
                u32x4 w; w.x = cvt_pk_bf16(o[0], o[1]); w.y = cvt_pk_bf16(o[2], o[3]); w.z = cvt_pk_bf16(o[4], o[5]); w.w = cvt_pk_bf16(o[6], o[7]);
                gp[(size_t)r * (D / 8)] = w;
                prev = cur; cur = nxt;
            }
        }
    }
}
__device__ __forceinline__ void load_rev(const GAS bf16_t* rowp, int g0, int c0, float (&r)[8]) {
    const u32x4 A = *(const GAS u32x4*)(rowp + g0 + ((248 - c0) & 255)), Bv = *(const GAS u32x4*)(rowp + g0 + ((256 - c0) & 255));
    r[0] = bf_at(Bv, 0);
#pragma unroll
    for (int i = 1; i < 8; ++i) r[i] = bf_at(A, 8 - i);
}
__device__ __forceinline__ void post_phase(const bf16_t* U, const f32x2* TW, bf16_t* MX, int gw, int NGW, int lane_) {
    int lane = lane_; asm volatile("" : "+v"(lane));
    const float SC_S = 0.5f / sqrtf((float)SS * (float)CG), SC_P = 0.5f / sqrtf((float)SP * (float)CG);
    for (int r = gw; r < MS; r += NGW) {
        const int k = r & (SS - 1), nk = (SS - k) & (SS - 1);
        const GAS bf16_t* rowk = (const GAS bf16_t*)U + (size_t)(RAD * SS + r) * D;
        const GAS bf16_t* rown = (const GAS bf16_t*)U + (size_t)(RAD * SS + (r - k) + nk) * D;
#pragma unroll
        for (int j = 0; j < 4; ++j) { const int ch0 = (lane + 64 * j) * 8, g0 = ch0 & ~255, c0 = ch0 & 255;
            const u32x4 a = *(const GAS u32x4*)(rowk + ch0); float rv[8]; load_rev(rown, g0, c0, rv);
            float o[8];
#pragma unroll
            for (int e = 0; e < 8; ++e) o[e] = (bf_at(a, e) + rv[e]) * SC_S;
            u32x4 w; w.x = cvt_pk_bf16(o[0], o[1]); w.y = cvt_pk_bf16(o[2], o[3]); w.z = cvt_pk_bf16(o[4], o[5]); w.w = cvt_pk_bf16(o[6], o[7]);
            *(GAS u32x4*)(MX + (size_t)(MP + r) * D + ch0) = w; }
    }
    for (int k1 = gw; k1 < SS; k1 += NGW) {
        const int nk1 = (SS - k1) & (SS - 1);
#pragma unroll 1
        for (int j = 0; j < 4; ++j) { const int ch0 = (lane + 64 * j) * 8, g0 = ch0 & ~255, c0 = ch0 & 255;
            float acc[8][8];
#pragma unroll
            for (int a = 0; a < 8; ++a)
#pragma unroll
                for (int e = 0; e < 8; ++e) acc[a][e] = 0.f;
#pragma unroll 1
            for (int s2 = 0; s2 < RAD; ++s2) {
                const GAS bf16_t* rowk = (const GAS bf16_t*)U + (size_t)(s2 * SS + k1) * D;
                const GAS bf16_t* rown = (const GAS bf16_t*)U + (size_t)(s2 * SS + nk1) * D;
                const u32x4 a = *(const GAS u32x4*)(rowk + ch0), p = *(const GAS u32x4*)(rown + ch0);
                float bq[8], qq[8]; load_rev(rown, g0, c0, bq); load_rev(rowk, g0, c0, qq);
                float Ev[8], Ov[8];
#pragma unroll
                for (int e = 0; e < 8; ++e) { Ev[e] = bf_at(a, e) + bq[e]; Ov[e] = bf_at(p, e) - qq[e]; }
#pragma unroll
                for (int k2 = 0; k2 < 8; ++k2) { const f32x2 tw = TW[(size_t)(k1 + SS * k2) * RAD + s2];
#pragma unroll
                    for (int e = 0; e < 8; ++e) acc[k2][e] += tw.x * Ev[e] + tw.y * Ov[e]; }
            }
#pragma unroll
            for (int k2 = 0; k2 < 8; ++k2) { u32x4 w;
                w.x = cvt_pk_bf16(acc[k2][0] * SC_P, acc[k2][1] * SC_P); w.y = cvt_pk_bf16(acc[k2][2] * SC_P, acc[k2][3] * SC_P);
                w.z = cvt_pk_bf16(acc[k2][4] * SC_P, acc[k2][5] * SC_P); w.w = cvt_pk_bf16(acc[k2][6] * SC_P, acc[k2][7] * SC_P);
                *(GAS u32x4*)(MX + (size_t)(k1 + SS * k2) * D + ch0) = w; }
        }
    }
}

__global__ void __launch_bounds__(NWAVES * 64, 2) fwd_kernel(Ptrs P) {
    extern __shared__ __attribute__((aligned(16))) unsigned char lds_raw[];
    LAS unsigned char* lds = (LAS unsigned char*)lds_raw;
    const int tid = threadIdx.x, lane = tid & 63, wave = __builtin_amdgcn_readfirstlane(tid >> 6);
    const int G = gridDim.x, bx = blockIdx.x;
    const int vcu = (G % 8 == 0) ? (bx % 8) * (G / 8) + bx / 8 : bx;
    const int gw = vcu * NWAVES + wave, NGW = G * NWAVES;
    for (int u = tid; u < (LDS_BYTES - LDSCTL_OFF) / 4; u += NWAVES * 64) ((LAS unsigned*)(lds + LDSCTL_OFF))[u] = 0u;
    __syncthreads();
    volatile LAS unsigned* MISC = (volatile LAS unsigned*)(lds + MISC_OFF);
    XcdBarrier bar = xcd_barrier_post((unsigned*)(P.ws + WS_CTL) + CW_BAR, MISC + 8);

    bf16_t* WIN = (bf16_t*)(P.ws + WS_WIN); bf16_t* AWO = (bf16_t*)(P.ws + WS_AWO); bf16_t* FWO = (bf16_t*)(P.ws + WS_FWO);
    bf16_t* WUP = (bf16_t*)(P.ws + WS_WUP); bf16_t* WDN = (bf16_t*)(P.ws + WS_WDN);
    bf16_t* HART = (bf16_t*)(P.ws + WS_HART); bf16_t* PT = (bf16_t*)(P.ws + WS_PT); const f32x2* TW = (const f32x2*)(P.ws + WS_TW);
    bf16_t* B1 = (bf16_t*)(P.ws + WS_B1); bf16_t* B2 = (bf16_t*)(P.ws + WS_B2); bf16_t* B3 = (bf16_t*)(P.ws + WS_B3);
    float* X = P.out;

    prologue(P, lds, gw, NGW, wave, lane);
    xcd_barrier(bar);

#pragma unroll 1
    for (int layer = 0; layer < 4; ++layer) {
        const int j = layer >> 1;
        if ((layer & 1) == 0) {
            norm_phase<false>(X, P.norm_mix + layer * D, B1, gw, NGW, lane);
            xcd_barrier(bar);
            {
                pg8::DescPlain g{B1, WIN + (size_t)j * 3 * D * D, D, D, D}; pg8::StaticOrder S; S.init(M, 3 * D, G, bx);
                pg8::EpiGate E{B2, B3};
                pg8::gemm_phase<pg8::DescPlain, pg8::EpiGate, true, true>(lds, g, S, E);
            }
            xcd_barrier(bar);
            conv_phase(B2, B3, P.a_conv_w + (size_t)j * 3 * D, B1, gw, NGW, lane);
            xcd_barrier(bar);
            {
                pg8::DescPlain g{B1, AWO + (size_t)j * D * D, D, D, D}; pg8::StaticOrder S; S.init(M, D, G, bx);
                pg8::EpiRes E{X};
                pg8::gemm_phase<pg8::DescPlain, pg8::EpiRes, true, true>(lds, g, S, E);
            }
            xcd_barrier(bar);
        } else {
            norm_phase<true>(X, P.norm_mix + layer * D, B1, gw, NGW, lane);
            xcd_barrier(bar);
            {
                pg8::DescF0 g{PT, B1, CG, CG, D}; pg8::StaticOrder S; S.init(D, M, G, bx);
                pg8::EpiBf16<2> E{B2, SS};
                pg8::gemm_phase<pg8::DescF0, pg8::EpiBf16<2>, true, true>(lds, g, S, E);
            }
            xcd_barrier(bar);
            {
                pg8::DescF2 g{HART, B2, SS, SS, SS}; pg8::StaticOrder S; S.init(M, D, G, bx);
                pg8::EpiBf16<0> E{B3, D};
                pg8::gemm_phase<pg8::DescF2, pg8::EpiBf16<0>, true, true>(lds, g, S, E);
            }
            xcd_barrier(bar);
            post_phase(B3, TW, B1, gw, NGW, lane);
            xcd_barrier(bar);
            {
                pg8::DescPlain g{B1, FWO + (size_t)j * D * D, D, D, D}; pg8::StaticOrder S; S.init(M, D, G, bx);
                pg8::EpiRes E{X};
                pg8::gemm_phase<pg8::DescPlain, pg8::EpiRes, true, true>(lds, g, S, E);
            }
            xcd_barrier(bar);
        }
        norm_phase<false>(X, P.norm_ffn + layer * D, B1, gw, NGW, lane);
        xcd_barrier(bar);
#pragma unroll 1
        for (int ch = 0; ch < 2; ++ch) {
            {
                pg8::DescPlain g{B1 + (size_t)ch * MCH * D, WUP + (size_t)layer * D * DFF, D, D, D}; pg8::StaticOrder S; S.init(MCH, DFF, G, bx);
                pg8::EpiBf16<1> E{B2, DFF};
                pg8::gemm_phase<pg8::DescPlain, pg8::EpiBf16<1>, true, true>(lds, g, S, E);
            }
            xcd_barrier(bar);
            {
                pg8::DescPlain g{B2, WDN + (size_t)layer * D * DFF, DFF, DFF, DFF}; pg8::StaticOrder S; S.init(MCH, D, G, bx);
                pg8::EpiRes E{X + (size_t)ch * MCH * D};
                pg8::gemm_phase<pg8::DescPlain, pg8::EpiRes, true, true>(lds, g, S, E);
            }
            xcd_barrier(bar);
        }
    }
    final_norm_phase(X, P.final_norm, gw, NGW, lane);
}

extern "C" void kernel_launch(void* const* d_in, const int* in_sizes, int n_in, void* d_out, int out_size, void* d_ws, size_t ws_size, hipStream_t stream) {
    static int grid = 0;
    if (grid == 0) {
        if (n_in != 11 || out_size != M * D || ws_size < WS_END) { fprintf(stderr, "kernel_launch: unexpected shapes (n_in %d, out %d, ws %zu)\n", n_in, out_size, ws_size); grid = -1; return; }
        int dev = 0, cus = 0, per_cu = 0;
        if (hipGetDevice(&dev) != hipSuccess || hipDeviceGetAttribute(&cus, hipDeviceAttributeMultiprocessorCount, dev) != hipSuccess) { grid = -1; return; }
        if (hipFuncSetAttribute((const void*)fwd_kernel, hipFuncAttributeMaxDynamicSharedMemorySize, LDS_BYTES) != hipSuccess) { fprintf(stderr, "kernel_launch: hipFuncSetAttribute failed\n"); grid = -1; return; }
        if (hipOccupancyMaxActiveBlocksPerMultiprocessor(&per_cu, (const void*)fwd_kernel, NWAVES * 64, LDS_BYTES) != hipSuccess || per_cu < 1)
            fprintf(stderr, "kernel_launch: occupancy query reports %d workgroups per CU\n", per_cu);
        (void)hipGetLastError();
        grid = cus;
    }
    if (grid < 0) return;
    if (hipMemsetAsync((char*)d_ws + WS_CTL, 0, CTL_ZERO_BYTES, stream) != hipSuccess) return;
    Ptrs p{};
    p.x_prompt = (const float*)d_in[0]; p.x_sample = (const float*)d_in[1]; p.norm_mix = (const float*)d_in[2]; p.a_w_in = (const float*)d_in[3];
    p.a_conv_w = (const float*)d_in[4]; p.a_w_out = (const float*)d_in[5]; p.f_w_out = (const float*)d_in[6]; p.norm_ffn = (const float*)d_in[7];
    p.w_up = (const float*)d_in[8]; p.w_down = (const float*)d_in[9]; p.final_norm = (const float*)d_in[10];
    p.out = (float*)d_out; p.ws = (unsigned char*)d_ws;
    hipLaunchKernelGGL(fwd_kernel, dim3(grid), dim3(NWAVES * 64), LDS_BYTES, stream, p);
    const hipError_t le = hipPeekAtLastError();
    if (le != hipSuccess) fprintf(stderr, "kernel_launch: launch failed: %s\n", hipGetErrorName(le));
    (void)in_sizes;
}
```

```cpp
#include <hip/hip_runtime.h>
#include <cstdio>
#include <cstdint>

#ifndef PROBE_CAT
#define PROBE_CAT 0
#endif
#define PROBE_ALPHA 4
#define LAS __attribute__((address_space(3)))
#define GAS __attribute__((address_space(1)))
typedef unsigned short bf16_t;
typedef short bf16x8 __attribute__((ext_vector_type(8)));
typedef float f32x4 __attribute__((ext_vector_type(4)));
typedef double f64x2 __attribute__((ext_vector_type(2)));
typedef float f32x2 __attribute__((ext_vector_type(2)));
typedef unsigned u32x4 __attribute__((ext_vector_type(4)));
typedef unsigned u32x2 __attribute__((ext_vector_type(2)));
typedef GAS unsigned gu32;
typedef unsigned long long u64;

constexpr int D = 2048, DFF = 8192, SP = 16384, SS = 2048, NB = 16;
constexpr int MP = SP, MS = NB * SS, M = MP + MS;
constexpr int CG = 256, NGRP = 8, RAD = SP / SS;
constexpr int NSEQ = RAD + NB;
constexpr int MCH = M / 2, BMT = 256;
constexpr float RMS_EPS = 1e-6f;

constexpr size_t MiB = 1u << 20;
constexpr size_t WS_CTL = 0, CTL_ZERO_BYTES = 5 * MiB;
constexpr size_t WS_RS = 1 * MiB, RS_STRIDE = 384 * 1024;
constexpr size_t WS_WIN = 5 * MiB;
constexpr size_t WS_AWO = WS_WIN + 48 * MiB;
constexpr size_t WS_FWO = WS_AWO + 16 * MiB;
constexpr size_t WS_WUP = WS_FWO + 16 * MiB;
constexpr size_t WS_WDN = WS_WUP + 128 * MiB;
constexpr size_t WS_HART = WS_WDN + 128 * MiB;
constexpr size_t WS_PT = WS_HART + 8 * MiB;
constexpr size_t WS_TW = WS_PT + 2 * MiB;
constexpr size_t WS_H256 = WS_TW + 2 * MiB;
constexpr size_t WS_B1 = WS_H256 + 1 * MiB;
constexpr size_t WS_B2 = WS_B1 + 192 * MiB;
constexpr size_t WS_B3 = WS_B2 + 192 * MiB;
constexpr size_t WS_END = WS_B3 + 192 * MiB;
static_assert((size_t)M * D * 2 == 192 * MiB && (size_t)MCH * DFF * 2 == 384 * MiB && (size_t)M * 8 == RS_STRIDE && WS_RS + 9 * RS_STRIDE <= CTL_ZERO_BYTES, "buffer sizes");
constexpr int CW_BAR = 4096;

constexpr int RING_BYTES = 131072, LDSCTL_OFF = RING_BYTES, MISC_OFF = LDSCTL_OFF + 320, LDS_BYTES = 147456;
constexpr int NWAVES = 8;

__device__ __forceinline__ unsigned cvt_pk_bf16(float lo, float hi) { unsigned r; asm("v_cvt_pk_bf16_f32 %0, %1, %2" : "=v"(r) : "v"(lo), "v"(hi)); return r; }
__device__ __forceinline__ float bf_lo(unsigned w) { return __builtin_bit_cast(float, w << 16); }
__device__ __forceinline__ float bf_hi(unsigned w) { return __builtin_bit_cast(float, w & 0xffff0000u); }
typedef float f32x2 __attribute__((ext_vector_type(2)));
__device__ __forceinline__ float dot2_bf16(unsigned a, unsigned b, float c) { typedef __bf16 bf2 __attribute__((ext_vector_type(2))); return __builtin_amdgcn_fdot2_f32_bf16(__builtin_bit_cast(bf2, a), __builtin_bit_cast(bf2, b), c, false); }
__device__ __forceinline__ float relu1(float x) { float r; asm("v_max_f32 %0, 0, %1" : "=v"(r) : "v"(x)); return r; }
__device__ __forceinline__ float bf_at(const u32x4& v, int i) { const unsigned w = v[i >> 1]; return (i & 1) ? bf_hi(w) : bf_lo(w); }
#define LDS_WAIT() asm volatile("s_waitcnt lgkmcnt(0)" ::: "memory")

namespace pg8 {
constexpr int BM = 256, BK = 64, HALF = 128, HTB = HALF * BK * 2, STAGE_BYTES = 8 * HTB, NXCD = 8, WGM = 8;
__host__ __device__ __forceinline__ int lds_byte(int r, int c) { const int st = (r >> 4) * 2 + (c >> 5), rr = r & 15, cc = c & 31, ob = rr * 64 + cc * 2; return st * 1024 + (ob ^ (((ob >> 9) & 1) << 5)); }
__host__ __device__ __forceinline__ void stage_rc(int b, int& R, int& C) { const int st = b / 1024, sb = b % 1024, swz = sb ^ (((sb >> 9) & 1) << 5); R = (st >> 1) * 16 + swz / 64; C = (st & 1) * 32 + (swz % 64) / 2; }
__host__ __device__ __forceinline__ int perm32(int rho) { const int n = rho >> 4, i = rho & 15; return 8 * (i >> 2) + 4 * n + (i & 3); }

__host__ __device__ __forceinline__ size_t paired_off(int row, int k, int K) { return (size_t)(row >> 4) * 16 * K + (size_t)((row & 7) * (K >> 5) + (k >> 5)) * 64 + ((row >> 3) & 1) * 32 + (k & 31); }
struct Unit { int pm, pn; };
struct StaticOrder {
    int nM, nN, nwg, G, c, wgm, rev;
    __device__ __forceinline__ void init(int M_, int N_, int G_, int c_, int wgm_ = WGM, int rev_ = 0) { nM = M_ / BM; nN = N_ / BM; nwg = nM * nN; G = G_; c = c_; wgm = wgm_; rev = (rev_ && nwg % G_ == 0) ? 1 : 0; }
    __device__ __forceinline__ bool next(int i, Unit& u) const {
        if (i * G >= nwg) return false;
        const long L = (long)(rev ? nwg / G - 1 - i : i) * G + c; if (L >= nwg) return false;
        int wgid = (int)L; { const int q = nwg / NXCD, r = nwg % NXCD, xcd = wgid % NXCD, off = wgid / NXCD; wgid = (xcd < r ? xcd * (q + 1) : r * (q + 1) + (xcd - r) * q) + off; }
        const int nig = wgm * nN, gid = wgid / nig, fm = gid * wgm, gsz = (nM - fm) < wgm ? (nM - fm) : wgm;
        u.pm = fm + ((wgid % nig) % gsz); u.pn = (wgid % nig) / gsz; return true;
    }
};
struct DescPlain { const bf16_t* A; const bf16_t* Bt; int K, lda, ldb;
    __device__ __forceinline__ unsigned voffa(int R, int C) const { return (unsigned)paired_off(R, C, lda) * 2u; }
    __device__ __forceinline__ unsigned voffb(int Rb, int C) const { return (unsigned)paired_off(Rb, C, ldb) * 2u; }
    __device__ __forceinline__ size_t kstepa() const { return 4 * BK; }
    __device__ __forceinline__ size_t hstepa() const { return (size_t)HALF * lda * 2; }
    __device__ __forceinline__ size_t kstepb() const { return 4 * BK; }
    __device__ __forceinline__ const char* abase(const Unit& u) const { return (const char*)A + (size_t)u.pm * BM * lda * 2; }
    __device__ __forceinline__ const char* bbase(const Unit& u) const { return (const char*)Bt + (size_t)u.pn * BM * ldb * 2; } };
struct DescSplit { const bf16_t* A; const bf16_t* Ahi; int msplit; const bf16_t* Bt; int K, lda, ldb, ap;
    __device__ __forceinline__ unsigned voffa(int R, int C) const { return ap ? (unsigned)(((R >> 4) * 2 + (C >> 5)) * 1024 + (R & 7) * 128 + ((R >> 3) & 1) * 64 + (C & 31) * 2) : (unsigned)(R * lda + C) * 2u; }
    __device__ __forceinline__ size_t hstepa() const { return ap ? (size_t)16384 : (size_t)HALF * lda * 2; }
    __device__ __forceinline__ unsigned voffb(int Rb, int C) const { return (unsigned)paired_off(Rb, C, ldb) * 2u; }
    __device__ __forceinline__ size_t kstepa() const { return ap ? 32768 : 2 * BK; }
    __device__ __forceinline__ size_t kstepb() const { return 4 * BK; }
    __device__ __forceinline__ const char* abase(const Unit& u) const { return u.pm < msplit ? (const char*)A + (size_t)u.pm * BM * lda * 2 : (const char*)Ahi + (size_t)(u.pm - msplit) * BM * lda * 2; }
    __device__ __forceinline__ const char* bbase(const Unit& u) const { return (const char*)Bt + (size_t)u.pn * BM * ldb * 2; } };
struct DescF0 { const bf16_t* A; const bf16_t* Bt; int K, lda, ldb, prompt;
    __device__ __forceinline__ const char* abase(const Unit& u) const { return (const char*)A + (size_t)u.pm * CG * CG * 2; }
    __device__ __forceinline__ const char* bbase(const Unit& u) const {
        const int row0 = prompt ? u.pn : (u.pn >> 3) * SS + (u.pn & 7);
        return (const char*)Bt + paired_off(row0, u.pm * CG, D) * 2; }
    __device__ __forceinline__ unsigned voffa(int R, int C) const { return (unsigned)(R * lda + C) * 2u; }
    __device__ __forceinline__ unsigned voffb(int Rb, int C) const {
        const unsigned rp = prompt ? (unsigned)Rb * 64u * D : (unsigned)(Rb >> 1) * 16u * D + (unsigned)(Rb & 1) * 32u;
        return (rp + (unsigned)((C >> 5) * 64 + (C & 31))) * 2u; }
    __device__ __forceinline__ size_t kstepa() const { return 2 * BK; }
    __device__ __forceinline__ size_t hstepa() const { return (size_t)HALF * lda * 2; }
    __device__ __forceinline__ size_t kstepb() const { return 4 * BK; } };
struct DescF2 { const bf16_t* A; const bf16_t* Bt; int K, lda, ldb, amask, ashift;
    __device__ __forceinline__ unsigned voffa(int R, int C) const { return (unsigned)(R * lda + C) * 2u; }
    __device__ __forceinline__ unsigned voffb(int Rb, int C) const { return (unsigned)(Rb * ldb + C) * 2u; }
    __device__ __forceinline__ size_t kstepa() const { return 2 * BK; }
    __device__ __forceinline__ size_t hstepa() const { return (size_t)HALF * lda * 2; }
    __device__ __forceinline__ size_t kstepb() const { return 2 * BK; }
    __device__ __forceinline__ const char* abase(const Unit& u) const { return (const char*)A + (size_t)(u.pm & amask) * BM * lda * 2; }
    __device__ __forceinline__ const char* bbase(const Unit& u) const { return (const char*)Bt + ((size_t)(u.pm >> ashift) * D + (size_t)u.pn * BM) * ldb * 2; } };

__device__ __forceinline__ float rstd_of(float ss) { return 1.0f / sqrtf(ss * (1.0f / D) + RMS_EPS); }
constexpr float RS_FIX = 1048576.0f;
__device__ __forceinline__ u64 rs_fix(float s) { return (u64)(s * RS_FIX); }
__device__ __forceinline__ float row_rstd(const u64* p) { return rstd_of((float)__hip_atomic_load((GAS u64*)p, __ATOMIC_RELAXED, __HIP_MEMORY_SCOPE_AGENT) * (1.0f / RS_FIX)); }
__device__ __forceinline__ unsigned dpp_ror8(unsigned old, unsigned src, int bank_mask) {
    return bank_mask == 0xC ? (unsigned)__builtin_amdgcn_update_dpp((int)old, (int)src, 0x128, 0xf, 0xC, false) : (unsigned)__builtin_amdgcn_update_dpp((int)old, (int)src, 0x128, 0xf, 0x3, false); }
__device__ __forceinline__ void widen(const u32x4& own0, const u32x4& own1, u32x4& r1, u32x4& r2) {
#pragma unroll
    for (int e = 0; e < 4; ++e) { r1[e] = dpp_ror8(own0[e], own1[e], 0xC); r2[e] = dpp_ror8(own1[e], own0[e], 0x3); }
}
template <bool SCALE> struct EpiRes {
    static constexpr bool PERM = true;
    bf16_t* XS; u64* RS; int row0; const u64* RSin;
    __device__ __forceinline__ void operator()(const f32x4 (&acc)[2][2][4][2], const Unit& u, int wr, int wc, int fr, int fq) const {
        const int rt = row0 + u.pm * BM;
        GAS char* ub = (GAS char*)XS + (size_t)rt * D * 2 + (size_t)(8 * u.pn + 2 * wc) * 128 + (size_t)wr * 64 * D * 2;
        const unsigned lp = (unsigned)((fr & 7) * (D >> 5) * 64 + (fr >> 3) * 32 + 8 * fq) * 2u;
        u32x4 xv[2][4][2];
#pragma unroll
        for (int ai = 0; ai < 2; ++ai)
#pragma unroll
            for (int m = 0; m < 4; ++m) { const GAS char* rb = ub + (size_t)(ai * HALF + m * 16) * D * 2;
#pragma unroll
                for (int h = 0; h < 2; ++h) xv[ai][m][h] = *(const GAS u32x4*)(rb + lp + h * 128); }
        float rsc[2][4];
#pragma unroll
        for (int ai = 0; ai < 2; ++ai)
#pragma unroll
            for (int m = 0; m < 4; ++m) { rsc[ai][m] = 1.f;
                if (SCALE) { const float r = row_rstd(RSin + (rt + ai * HALF + wr * 64 + m * 16 + fr)); rsc[ai][m] = r * r; } }
#pragma unroll
        for (int ai = 0; ai < 2; ++ai)
#pragma unroll
            for (int m = 0; m < 4; ++m) { GAS char* rb = ub + (size_t)(ai * HALF + m * 16) * D * 2;
                const float sc = rsc[ai][m];
                float s = 0.f, s1 = 0.f;
                u32x4 w[2];
                const f32x2 sc2 = (f32x2){sc, sc};
#pragma unroll
                for (int bj = 0; bj < 2; ++bj) {
#pragma unroll
                    for (int n = 0; n < 2; ++n) { const f32x4 a = acc[ai][bj][m][n]; const unsigned x0 = xv[ai][m][bj][2 * n], x1 = xv[ai][m][bj][2 * n + 1];
                        f32x2 p0 = (f32x2){bf_lo(x0), bf_hi(x0)}, p1 = (f32x2){bf_lo(x1), bf_hi(x1)};
                        const f32x2 a0 = (f32x2){a[0], a[1]}, a1 = (f32x2){a[2], a[3]};
                        if (SCALE) { p0 = __builtin_elementwise_fma(a0, sc2, p0); p1 = __builtin_elementwise_fma(a1, sc2, p1); } else { p0 += a0; p1 += a1; }
                        const unsigned w0 = cvt_pk_bf16(p0[0], p0[1]), w1 = cvt_pk_bf16(p1[0], p1[1]);
                        w[bj][2 * n] = w0; w[bj][2 * n + 1] = w1;
                        s = dot2_bf16(w0, w0, s); s1 = dot2_bf16(w1, w1, s1); } }
                s += s1;
                *(GAS u32x4*)(rb + lp) = w[0]; *(GAS u32x4*)(rb + lp + 128) = w[1];
                s += __shfl_xor(s, 16); s += __shfl_xor(s, 32);
                if (fq == 0) __hip_atomic_fetch_add((GAS u64*)RS + (rt + ai * HALF + wr * 64 + m * 16 + fr), rs_fix(s), __ATOMIC_RELAXED, __HIP_MEMORY_SCOPE_AGENT);
                __builtin_amdgcn_sched_barrier(0);
            }
    }
};
template <int MODE  > struct EpiBf16 {
    static constexpr bool PERM = true;
    bf16_t* O; int ldc; const u64* RS; int row0; bf16_t* Ohi; int msplit;
    __device__ __forceinline__ void operator()(const f32x4 (&acc)[2][2][4][2], const Unit& u, int wr, int wc, int fr, int fq) const {
        GAS char* ub;
        if (MODE == 2) ub = (GAS char*)O + ((size_t)u.pn * D + (size_t)u.pm * BM) * BM * 2;
        else if (MODE == 1 && u.pm >= msplit) ub = (GAS char*)Ohi + ((size_t)(u.pm - msplit) * BM * ldc + (size_t)u.pn * BM) * 2;
        else ub = (GAS char*)O + ((size_t)u.pm * BM * ldc + (size_t)u.pn * BM) * 2;
        const unsigned lo = (unsigned)((wr * 64 + (fr & 7)) * ldc + wc * 64) * 2u + (unsigned)(4 * (fr >> 3) + fq) * 16u;
        f32x4 cs[2][2];
        if (MODE == 2) {
            const int ln = fq * 16 + fr, tc = wc * 64 + ln;
            const u64* tp = RS + (row0 ? u.pn + 64 * tc : MP + (u.pn >> 3) * SS + (u.pn & 7) + 8 * tc);
            const float tr = row_rstd(tp);
#pragma unroll
            for (int bj = 0; bj < 2; ++bj)
#pragma unroll
                for (int n = 0; n < 2; ++n)
#pragma unroll
                    for (int j = 0; j < 4; ++j) cs[bj][n][j] = __shfl(tr, bj * 32 + 8 * fq + 4 * n + j);
        } else {
#pragma unroll
            for (int bj = 0; bj < 2; ++bj)
#pragma unroll
                for (int n = 0; n < 2; ++n)
#pragma unroll
                    for (int j = 0; j < 4; ++j) cs[bj][n][j] = 0.f;
        }
        float rsc[2][4];
#pragma unroll
        for (int ai = 0; ai < 2; ++ai)
#pragma unroll
            for (int m = 0; m < 4; ++m) { rsc[ai][m] = 1.f;
            }
#pragma unroll
        for (int ai = 0; ai < 2; ++ai)
#pragma unroll
            for (int m = 0; m < 4; ++m) { GAS char* rb = ub + (size_t)(ai * HALF + m * 16) * ldc * 2;
                const float sc = rsc[ai][m];
                u32x4 w[2];
#pragma unroll
                for (int bj = 0; bj < 2; ++bj) { f32x4 v0 = acc[ai][bj][m][0], v1 = acc[ai][bj][m][1];
                    if (MODE == 1) { const f32x4 a = (f32x4){relu1(v0[0]), relu1(v0[1]), relu1(v0[2]), relu1(v0[3])}, b = (f32x4){relu1(v1[0]), relu1(v1[1]), relu1(v1[2]), relu1(v1[3])}; v0 = a * a; v1 = b * b; }
                    if (MODE == 2) { v0 = v0 * cs[bj][0]; v1 = v1 * cs[bj][1]; }
                    w[bj].x = cvt_pk_bf16(v0[0], v0[1]); w[bj].y = cvt_pk_bf16(v0[2], v0[3]); w[bj].z = cvt_pk_bf16(v1[0], v1[1]); w[bj].w = cvt_pk_bf16(v1[2], v1[3]); }
                if (MODE == 1) {
                    GAS char* hb = u.pm >= msplit ? (GAS char*)Ohi + (size_t)(u.pm - msplit) * BM * ldc * 2 : (GAS char*)O + (size_t)u.pm * BM * ldc * 2;
                    GAS char* gb = hb + (size_t)(4 * u.pn + wc) * 32768 + (size_t)(ai * 8 + wr * 4 + m) * 2048;
                    const unsigned lp = (unsigned)((fr & 7) * 128 + (fr >> 3) * 64 + fq * 16);
                    __builtin_nontemporal_store(w[0], (GAS u32x4*)(gb + lp)); __builtin_nontemporal_store(w[1], (GAS u32x4*)(gb + lp + 1024));
                } else { u32x4 r1, r2; widen(w[0], w[1], r1, r2); *(GAS u32x4*)(rb + lo) = r1; *(GAS u32x4*)(rb + lo + 8 * ldc * 2) = r2; } }
    }
};
struct EpiGate {
    static constexpr bool PERM = true;
    bf16_t* Bo; bf16_t* Uo;
    __device__ __forceinline__ void operator()(const f32x4 (&acc)[2][2][4][2], const Unit& u, int wr, int wc, int fr, int fq) const {
        if (u.pn < 8) {
            GAS char* ub = (GAS char*)Bo + ((size_t)u.pm * BM * D + (size_t)u.pn * BM) * 2;
            const unsigned lo = (unsigned)((wr * 64 + (fr & 7)) * D + wc * 64) * 2u + (unsigned)(4 * (fr >> 3) + fq) * 16u;
#pragma unroll
            for (int ai = 0; ai < 2; ++ai)
#pragma unroll
                for (int m = 0; m < 4; ++m) { GAS char* rb = ub + (size_t)(ai * HALF + m * 16) * D * 2;
                    u32x4 w[2];
#pragma unroll
                    for (int bj = 0; bj < 2; ++bj) { const f32x4 v0 = acc[ai][bj][m][0], v1 = acc[ai][bj][m][1];
                        w[bj].x = cvt_pk_bf16(v0[0], v0[1]); w[bj].y = cvt_pk_bf16(v0[2], v0[3]); w[bj].z = cvt_pk_bf16(v1[0], v1[1]); w[bj].w = cvt_pk_bf16(v1[2], v1[3]); }
                    u32x4 r1, r2; widen(w[0], w[1], r1, r2);
                    *(GAS u32x4*)(rb + lo) = r1; *(GAS u32x4*)(rb + lo + 8 * D * 2) = r2; }
        } else {
            GAS char* ub = (GAS char*)Uo + ((size_t)u.pm * BM * D + (size_t)(u.pn - 8) * HALF) * 2;
            const unsigned lo = (unsigned)((wr * 64 + fr) * D + wc * 32 + 8 * fq) * 2u;
#pragma unroll
            for (int ai = 0; ai < 2; ++ai)
#pragma unroll
                for (int m = 0; m < 4; ++m) { GAS char* rb = ub + (size_t)(ai * HALF + m * 16) * D * 2;
                    const f32x4 v0 = acc[ai][0][m][0] * acc[ai][1][m][0], v1 = acc[ai][0][m][1] * acc[ai][1][m][1];
                    u32x4 w; w.x = cvt_pk_bf16(v0[0], v0[1]); w.y = cvt_pk_bf16(v0[2], v0[3]); w.z = cvt_pk_bf16(v1[0], v1[1]); w.w = cvt_pk_bf16(v1[2], v1[3]);
                    *(GAS u32x4*)(rb + lo) = w; }
        }
    }
};

template <class Desc, class Epi, bool ALIGN_EPI, bool SP2>
__device__ __forceinline__ void gemm_phase(LAS unsigned char* lds, const Desc g, const StaticOrder& S, const Epi& E, unsigned long long& pacc) {
    int tid_ = threadIdx.x; asm volatile("" : "+v"(tid_));
    const int tid = tid_, wid = __builtin_amdgcn_readfirstlane(tid >> 6), lane = tid & 63, wr = wid >> 2, wc = wid & 3, fr = lane & 15, fq = lane >> 4;
    const int K = g.K, nt = K / BK, lda = g.lda, ldb = g.ldb;
    unsigned voffA[2], voffB[2];
#pragma unroll
    for (int i = 0; i < 2; ++i) { int R, C; stage_rc(tid * 16 + i * 8192, R, C); const int Rb = 2 * (R & ~31) + perm32(R & 31);
        voffA[i] = g.voffa(R, C); voffB[i] = g.voffb(Rb, C); }
    const size_t kstep = g.kstepa(), kstepB = g.kstepb();
    const size_t hstepA = g.hstepa(), hstepB = (size_t)32 * ldb * 2;
    const unsigned ldsw = (unsigned)wid * 1024u;
    const int aoff = lds_byte(wr * 64 + fr, fq * 8), boff = lds_byte(wc * 32 + fr, fq * 8);
#define PG8_SA(b, h) (((b) * 2 + (h)) * HTB)
#define PG8_SB(b, h) ((4 + (b) * 2 + (h)) * HTB)
#define PG8_STAGE(bufoff, gbase, voff) do { _Pragma("unroll") for (int _i = 0; _i < 2; ++_i) { unsigned _vo = (voff)[_i]; asm("" : "+v"(_vo));     \
        __builtin_amdgcn_global_load_lds((const GAS unsigned*)((const GAS char*)(gbase) + _vo), (LAS unsigned*)(lds + (bufoff) + ldsw + _i * 8192), 16, 0, 0); } } while (0)
#define PG8_LDA(dst, b, h) do { _Pragma("unroll") for (int m = 0; m < 4; ++m) _Pragma("unroll") for (int k = 0; k < 2; ++k) dst[m][k] = *(const LAS bf16x8*)(lds + PG8_SA(b, h) + aoff + m * 2048 + k * 1024); } while (0)
#define PG8_LDB(dst, b, h) do { _Pragma("unroll") for (int n = 0; n < 2; ++n) _Pragma("unroll") for (int k = 0; k < 2; ++k) dst[n][k] = *(const LAS bf16x8*)(lds + PG8_SB(b, h) + boff + n * 2048 + k * 1024); } while (0)
#define PG8_MMA(ai, bj, At, Bt) do { __builtin_amdgcn_s_setprio(1); _Pragma("unroll") for (int p = 0; p < 8; ++p) _Pragma("unroll") for (int q = 0; q < 2; ++q) { const int n = p >> 2, m = (n ? 3 - (p & 3) : (p & 3)), k = (p ^ q) & 1; \
        asm volatile("v_mfma_f32_16x16x32_bf16 %0, %1, %2, %0" : "+v"(acc[ai][bj][m][n]) : "v"(Bt[n][k]), "v"(At[m][k])); }     __builtin_amdgcn_s_setprio(0); } while (0)
#define PG8_WAIT_V(n) asm volatile("s_waitcnt vmcnt(" #n ")" ::: "memory")
#define PG8_WAIT_L(n) asm volatile("s_waitcnt lgkmcnt(" #n ")" ::: "memory")
#define PG8_BAR __builtin_amdgcn_s_barrier()
#define PG8_SCHED __builtin_amdgcn_sched_barrier(0)
    Unit cur, nxt; int ui = 0;
    if (!S.next(0, cur)) return;
    f32x4 acc[2][2][4][2];
#pragma unroll
    for (int a = 0; a < 2; ++a)
#pragma unroll
        for (int b = 0; b < 2; ++b)
#pragma unroll
            for (int m = 0; m < 4; ++m)
#pragma unroll
                for (int n = 0; n < 2; ++n) { f64x2 z_; asm volatile("v_mov_b64 %0, 0" : "=v"(z_.x)); asm volatile("v_mov_b64 %0, 0" : "=v"(z_.y)); acc[a][b][m][n] = __builtin_bit_cast(f32x4, z_); }
    bf16x8 At[4][2], B0[2][2], B1[2][2];
    const char* cA = g.abase(cur); const char* cB = g.bbase(cur);
    if constexpr (SP2) {
        PG8_STAGE(PG8_SB(0, 0), cB, voffB); PG8_STAGE(PG8_SB(0, 1), cB + hstepB, voffB); PG8_STAGE(PG8_SA(0, 0), cA, voffA); PG8_STAGE(PG8_SA(0, 1), cA + hstepA, voffA);
        if (wr == 1) PG8_BAR;
        PG8_WAIT_V(2); PG8_BAR;
        PG8_STAGE(PG8_SB(1, 0), cB + kstepB, voffB); PG8_STAGE(PG8_SA(1, 0), cA + kstep, voffA); PG8_STAGE(PG8_SB(1, 1), cB + hstepB + kstepB, voffB);
        PG8_WAIT_V(6); PG8_BAR;
    } else {
        PG8_STAGE(PG8_SB(0, 0), cB, voffB); PG8_STAGE(PG8_SA(0, 0), cA, voffA); PG8_STAGE(PG8_SB(0, 1), cB + hstepB, voffB); PG8_STAGE(PG8_SA(0, 1), cA + hstepA, voffA);
        if (wr == 1) PG8_BAR;
        PG8_WAIT_V(4); PG8_BAR;
        PG8_STAGE(PG8_SB(1, 0), cB + kstepB, voffB); PG8_STAGE(PG8_SA(1, 0), cA + kstep, voffA); PG8_STAGE(PG8_SB(1, 1), cB + hstepB + kstepB, voffB);
        PG8_WAIT_V(6); PG8_BAR;
    }
    for (;;) {
        const bool has_next = S.next(ui + 1, nxt);
        const char* nA = has_next ? g.abase(nxt) : cA; const char* nB = has_next ? g.bbase(nxt) : cB;
#pragma unroll 1
        for (int t = 0; t < nt; t += 2) {
            const bool last = (t == nt - 2);
            unsigned long long pk0 = 0ull; if (PROBE_CAT == 4 || PROBE_CAT == 5) pk0 = __builtin_amdgcn_s_memrealtime();
            const char* a1 = cA + (size_t)(t + 1) * kstep;
            const char* a2 = last ? nA : cA + (size_t)(t + 2) * kstep; const char* b2 = last ? nB : cB + (size_t)(t + 2) * kstepB;
            const char* a3 = a2 + kstep; const char* b3 = b2 + kstepB;
            if constexpr (SP2) {
            PG8_LDB(B0, 0, 0); PG8_LDB(B1, 0, 1); PG8_SCHED; PG8_LDA(At, 0, 0); PG8_STAGE(PG8_SA(1, 1), a1 + hstepA, voffA);
            PG8_WAIT_V(8); PG8_WAIT_L(0); PG8_BAR; PG8_MMA(0, 0, At, B0); PG8_MMA(0, 1, At, B1); PG8_BAR; PG8_SCHED;
            PG8_LDA(At, 0, 1); PG8_STAGE(PG8_SB(0, 0), b2, voffB); PG8_STAGE(PG8_SB(0, 1), b2 + hstepB, voffB); PG8_STAGE(PG8_SA(0, 0), a2, voffA);
            PG8_WAIT_V(8); PG8_WAIT_L(0); PG8_BAR; PG8_MMA(1, 0, At, B0); PG8_MMA(1, 1, At, B1); PG8_BAR; PG8_SCHED;
            PG8_LDB(B0, 1, 0); PG8_LDB(B1, 1, 1); PG8_SCHED; PG8_LDA(At, 1, 0); PG8_STAGE(PG8_SA(0, 1), a2 + hstepA, voffA);
            PG8_WAIT_V(8); PG8_WAIT_L(0); PG8_BAR; PG8_MMA(0, 0, At, B0); PG8_MMA(0, 1, At, B1); PG8_BAR; PG8_SCHED;
            PG8_LDA(At, 1, 1); PG8_STAGE(PG8_SB(1, 0), b3, voffB); PG8_STAGE(PG8_SB(1, 1), b3 + hstepB, voffB); PG8_STAGE(PG8_SA(1, 0), a3, voffA);
            PG8_WAIT_V(8); PG8_WAIT_L(0); PG8_BAR; PG8_MMA(1, 0, At, B0); PG8_MMA(1, 1, At, B1); PG8_BAR; PG8_SCHED;
            } else {
            PG8_LDB(B0, 0, 0); PG8_SCHED; PG8_LDA(At, 0, 0); PG8_STAGE(PG8_SA(1, 1), a1 + hstepA, voffA);
            PG8_WAIT_L(8); PG8_BAR; PG8_WAIT_L(0); PG8_MMA(0, 0, At, B0); PG8_BAR; PG8_SCHED;
            PG8_LDB(B1, 0, 1); PG8_STAGE(PG8_SB(0, 0), b2, voffB);
            PG8_BAR; PG8_WAIT_L(0); PG8_MMA(0, 1, At, B1); PG8_BAR;
            PG8_LDA(At, 0, 1); PG8_STAGE(PG8_SA(0, 0), a2, voffA);
            PG8_BAR; PG8_WAIT_L(0); PG8_MMA(1, 0, At, B0); PG8_BAR; PG8_SCHED;
            PG8_STAGE(PG8_SB(0, 1), b2 + hstepB, voffB);
            PG8_WAIT_V(6); PG8_BAR; PG8_MMA(1, 1, At, B1); PG8_BAR;
            PG8_LDB(B0, 1, 0); PG8_SCHED; PG8_LDA(At, 1, 0); PG8_STAGE(PG8_SA(0, 1), a2 + hstepA, voffA);
            PG8_WAIT_L(8); PG8_BAR; PG8_WAIT_L(0); PG8_MMA(0, 0, At, B0); PG8_BAR; PG8_SCHED;
            PG8_LDB(B1, 1, 1); PG8_STAGE(PG8_SB(1, 0), b3, voffB);
            PG8_BAR; PG8_WAIT_L(0); PG8_MMA(0, 1, At, B1); PG8_BAR;
            PG8_LDA(At, 1, 1); PG8_STAGE(PG8_SA(1, 0), a3, voffA);
            PG8_BAR; PG8_WAIT_L(0); PG8_MMA(1, 0, At, B0); PG8_BAR; PG8_SCHED;
            PG8_STAGE(PG8_SB(1, 1), b3 + hstepB, voffB);
            PG8_WAIT_V(6); PG8_BAR; PG8_MMA(1, 1, At, B1); PG8_BAR;
            }
            if (PROBE_CAT == 4 && t == 0 && ui > 0) pacc += __builtin_amdgcn_s_memrealtime() - pk0;
            if (PROBE_CAT == 5 && t == 2) pacc += __builtin_amdgcn_s_memrealtime() - pk0;
        }
        if constexpr (ALIGN_EPI) { if (wr == 0) PG8_BAR; }
        asm volatile("s_nop 15\n\ts_nop 15" ::: "memory");
        E(acc, cur, wr, wc, fr, fq);
        if (!has_next) break;
#pragma unroll
        for (int a = 0; a < 2; ++a)
#pragma unroll
            for (int b = 0; b < 2; ++b)
#pragma unroll
                for (int m = 0; m < 4; ++m)
#pragma unroll
                    for (int n = 0; n < 2; ++n) { f64x2 z_; asm volatile("v_mov_b64 %0, 0" : "=v"(z_.x)); asm volatile("v_mov_b64 %0, 0" : "=v"(z_.y)); acc[a][b][m][n] = __builtin_bit_cast(f32x4, z_); }
        cur = nxt; cA = nA; cB = nB; ++ui;
        if constexpr (ALIGN_EPI) { if (wr == 1) PG8_BAR; }
    }
    PG8_WAIT_V(0);
    if constexpr (!ALIGN_EPI) { if (wr == 0) PG8_BAR; }
    PG8_BAR;
#undef PG8_SA
#undef PG8_SB
#undef PG8_STAGE
#undef PG8_LDA
#undef PG8_LDB
#undef PG8_MMA
#undef PG8_WAIT_V
#undef PG8_WAIT_L
#undef PG8_BAR
#undef PG8_SCHED
}
}

#define XB_TMO      128
#define XB_XCNT(j)  (256  + 64 * (j))
#define XB_XSUB(j)  (1280 + 64 * (j))
#define XB_XGEN(j)  (2304 + 64 * (j))
#define XB_TOP      3328
#define XB_TOPGEN   3392
#define XCD_BAR_WORDS 3456
#define XB_SPIN_CAP (1u << 18)
__device__ __forceinline__ unsigned xb_ld(unsigned* p)              { return __hip_atomic_load(p, __ATOMIC_RELAXED, __HIP_MEMORY_SCOPE_AGENT); }
__device__ __forceinline__ unsigned xb_add(unsigned* p, unsigned v) { return __hip_atomic_fetch_add(p, v, __ATOMIC_RELAXED, __HIP_MEMORY_SCOPE_AGENT); }
__device__ __forceinline__ unsigned xb_xcc_id() { return (unsigned)__builtin_amdgcn_s_getreg((3 << 11) | 20) & 0xFu; }
#define XB_SPIN(cond, bar) do { unsigned _sp = 0; while (cond) { __builtin_amdgcn_s_sleep(1); \
    if ((++_sp & 255u) == 0u) { if (xb_ld(&(bar)[XB_TMO])) break; if (_sp > XB_SPIN_CAP) { atomicAdd(&(bar)[XB_TMO], 1u); break; } } } } while (0)
struct XcdBarrier { unsigned* bar; unsigned x; volatile LAS unsigned* st; };
__device__ __forceinline__ XcdBarrier xcd_barrier_post(unsigned* bar, volatile LAS unsigned* st) {
    XcdBarrier b; b.bar = bar; b.x = (unsigned)__builtin_amdgcn_readfirstlane((int)xb_xcc_id()); b.st = st;
    if (threadIdx.x == 0) (void)xb_add(&bar[XB_XCNT(b.x)], 1u);
    return b;
}
__device__ __forceinline__ void xcd_barrier_complete(unsigned* bar, unsigned x, unsigned& nloc, unsigned& nx) {
    const unsigned G = gridDim.x * gridDim.y * gridDim.z;
    unsigned sum, cnt, mine, sp = 0u;
    for (;;) {
        sum = 0u; cnt = 0u; mine = 0u;
#pragma unroll
        for (unsigned j = 0; j < 16; ++j) { const unsigned c = xb_ld(&bar[XB_XCNT(j)]); sum += c; cnt += (c > 0u) ? 1u : 0u; mine = (j == x) ? c : mine; }
        if (sum == G) break;
        __builtin_amdgcn_s_sleep(1);
        if ((++sp & 255u) == 0u) { if (xb_ld(&bar[XB_TMO])) break; if (sp > XB_SPIN_CAP) { atomicAdd(&bar[XB_TMO], 1u); break; } }
    }
    nloc = mine > 0u ? mine : 1u; nx = cnt > 0u ? cnt : 1u;
}
__device__ __forceinline__ void xcd_barrier(const XcdBarrier& b) {
    asm volatile("s_waitcnt vmcnt(0)" ::: "memory");
    __syncthreads();
    if (threadIdx.x == 0) {
        unsigned* bar = b.bar; unsigned bx_ = b.x; asm volatile("" : "+s"(bx_));
        __builtin_amdgcn_s_waitcnt(0);
        unsigned nloc = b.st[0], nx = b.st[1];
        if (nloc == 0u) { xcd_barrier_complete(bar, bx_, nloc, nx); b.st[0] = nloc; b.st[1] = nx; }
        const unsigned old = xb_add(&bar[XB_XSUB(bx_)], 1u);
        const unsigned gen = old / nloc;
        if (old + 1u == (gen + 1u) * nloc) {
            __builtin_amdgcn_fence(__ATOMIC_RELEASE, "agent");
            asm volatile("s_waitcnt vmcnt(0)" ::: "memory");
            const unsigned og = xb_add(&bar[XB_TOP], 1u);
            const unsigned tg = og / nx;
            if (og + 1u == (tg + 1u) * nx) xb_add(&bar[XB_TOPGEN], 1u);
            else XB_SPIN(xb_ld(&bar[XB_TOPGEN]) == tg, bar);
            __builtin_amdgcn_fence(__ATOMIC_ACQUIRE, "agent");
            xb_add(&bar[XB_XGEN(bx_)], 1u);
            asm volatile("s_waitcnt vmcnt(0)" ::: "memory");
        } else {
            XB_SPIN(xb_ld(&bar[XB_XGEN(bx_)]) == gen, bar);
            __builtin_amdgcn_fence(__ATOMIC_ACQUIRE, "agent");
            asm volatile("s_waitcnt vmcnt(0)" ::: "memory");
        }
    }
    __syncthreads();
}

__device__ __forceinline__ float wave_sum(float v) {
#pragma unroll
    for (int o = 1; o < 64; o <<= 1) v += __shfl_xor(v, o);
    return v;
}
__device__ __forceinline__ void transpose_item(const float* W, int K, int N, bf16_t* WT, int k0, int n0, int drow0, const float* gain, LAS float* scr, int lane) {
    float tv[32];
#pragma unroll
    for (int i = 0; i < 32; ++i) tv[i] = ((const GAS float*)W)[(size_t)(k0 + 2 * i + (lane >> 5)) * N + n0 + (lane & 31)];
#pragma unroll
    for (int i = 0; i < 32; ++i) { const int kk = 2 * i + (lane >> 5); float v = tv[i]; if (gain) v *= ((const GAS float*)gain)[k0 + kk]; scr[kk * 33 + (lane & 31)] = v; }
    LDS_WAIT(); asm volatile("" ::: "memory");
    const int c = lane & 7;
#pragma unroll
    for (int j = 0; j < 4; ++j) { const int n = (lane >> 3) + 8 * j; const LAS float* s = scr + (8 * c) * 33 + n;
        u32x4 o; o.x = cvt_pk_bf16(s[0 * 33], s[1 * 33]); o.y = cvt_pk_bf16(s[2 * 33], s[3 * 33]); o.z = cvt_pk_bf16(s[4 * 33], s[5 * 33]); o.w = cvt_pk_bf16(s[6 * 33], s[7 * 33]);
        *(GAS u32x4*)(WT + pg8::paired_off(drow0 + n, k0 + 8 * c, K)) = o; }
    LDS_WAIT(); asm volatile("" ::: "memory");
}
__device__ __forceinline__ int win_row(int n) {
    if (n < D) return n;
    const int which = (n >= 2 * D) ? 1 : 0, cc = n - D - which * D;
    return D + (cc >> 5) * 64 + which * 32 + (cc & 31);
}
__device__ __forceinline__ float cas_pi(float t) { float s, c; sincospif(t, &s, &c); return c + s; }

__device__ __forceinline__ unsigned char* wsp(unsigned char* ws, size_t off) { asm volatile("" : "+s"(ws)); return ws + off; }

struct Ptrs {
    const float *x_prompt, *x_sample, *norm_mix, *a_w_in, *a_conv_w, *a_w_out, *f_w_out, *norm_ffn, *w_up, *w_down, *final_norm;
    float* out; unsigned char* ws;
};

__device__ __forceinline__ void prologue(const Ptrs& P, LAS unsigned char* lds, int gw, int NGW, int wave, int lane_) {
    int lane = lane_; asm volatile("" : "+v"(lane));
    LAS float* scr = (LAS float*)(lds + wave * 16384);
    bf16_t* WIN = (bf16_t*)(P.ws + WS_WIN); bf16_t* AWO = (bf16_t*)(P.ws + WS_AWO); bf16_t* FWO = (bf16_t*)(P.ws + WS_FWO);
    bf16_t* WUP = (bf16_t*)(P.ws + WS_WUP); bf16_t* WDN = (bf16_t*)(P.ws + WS_WDN);
    constexpr int I_IN = (D / 64) * (3 * D / 32), I_SQ = (D / 64) * (D / 32), I_UP = (D / 64) * (DFF / 32), I_DN = (DFF / 64) * (D / 32);
    constexpr int NITEMS = 2 * I_IN + 4 * I_SQ + 4 * I_UP + 4 * I_DN;
    for (int it = gw; it < NITEMS; it += NGW) {
        int r = it;
        if (r < 2 * I_IN) { const int j = r / I_IN; r -= j * I_IN; const int nblk = 3 * D / 32, kb = r / nblk, nb = r % nblk;
            transpose_item(P.a_w_in + (size_t)j * D * 3 * D, D, 3 * D, WIN + (size_t)j * 3 * D * D, 64 * kb, 32 * nb, win_row(32 * nb), P.norm_mix + (2 * j) * D, scr, lane); continue; }
        r -= 2 * I_IN;
        if (r < 2 * I_SQ) { const int j = r / I_SQ; r -= j * I_SQ; const int nblk = D / 32, kb = r / nblk, nb = r % nblk;
            transpose_item(P.a_w_out + (size_t)j * D * D, D, D, AWO + (size_t)j * D * D, 64 * kb, 32 * nb, 32 * nb, nullptr, scr, lane); continue; }
        r -= 2 * I_SQ;
        if (r < 2 * I_SQ) { const int j = r / I_SQ; r -= j * I_SQ; const int nblk = D / 32, kb = r / nblk, nb = r % nblk;
            transpose_item(P.f_w_out + (size_t)j * D * D, D, D, FWO + (size_t)j * D * D, 64 * kb, 32 * nb, 32 * nb, nullptr, scr, lane); continue; }
        r -= 2 * I_SQ;
        if (r < 4 * I_UP) { const int j = r / I_UP; r -= j * I_UP; const int nblk = DFF / 32, kb = r / nblk, nb = r % nblk;
            transpose_item(P.w_up + (size_t)j * D * DFF, D, DFF, WUP + (size_t)j * D * DFF, 64 * kb, 32 * nb, 32 * nb, P.norm_ffn + j * D, scr, lane); continue; }
        r -= 4 * I_UP;
        { const int j = r / I_DN; r -= j * I_DN; const int nblk = D / 32, kb = r / nblk, nb = r % nblk;
            transpose_item(P.w_down + (size_t)j * D * DFF, DFF, D, WDN + (size_t)j * D * DFF, 64 * kb, 32 * nb, 32 * nb, nullptr, scr, lane); }
    }
    const int gl = gw * 64 + lane, NGL = NGW * 64;
    for (int i = gl; i < 2 * NGRP * CG * CG / 8; i += NGL) { const int jl = i / (NGRP * CG * CG / 8), r = i % (NGRP * CG * CG / 8), g = r / (CG * CG / 8), q = r % (CG * CG / 8), c = q / (CG / 8), j0 = (q % (CG / 8)) * 8; float v[8];
        const GAS float* gn = (const GAS float*)P.norm_mix + (2 * jl + 1) * D + g * CG + j0;
#pragma unroll
        for (int e = 0; e < 8; ++e) v[e] = cas_pi(-(float)((c * (j0 + e)) & (CG - 1)) * (1.0f / 128.0f)) * gn[e];
        u32x4 o; o.x = cvt_pk_bf16(v[0], v[1]); o.y = cvt_pk_bf16(v[2], v[3]); o.z = cvt_pk_bf16(v[4], v[5]); o.w = cvt_pk_bf16(v[6], v[7]);
        *(GAS u32x4*)((bf16_t*)(P.ws + WS_PT) + (size_t)i * 8) = o; }
    for (int i = gl; i < SP * RAD; i += NGL) { const int k = i >> 3, s2 = i & 7; float s, c; sincospif((float)((k * s2) & (SP - 1)) * (1.0f / 8192.0f), &s, &c);
        ((GAS f32x2*)(P.ws + WS_TW))[i] = (f32x2){c, s}; }
    for (int i = gl; i < CG * CG / 8; i += NGL) { const int k = i / (CG / 8), s0 = (i % (CG / 8)) * 8; float v[8];
#pragma unroll
        for (int e = 0; e < 8; ++e) v[e] = cas_pi((float)((k * (s0 + e)) & (CG - 1)) * (1.0f / 128.0f));
        u32x4 o; o.x = cvt_pk_bf16(v[0], v[1]); o.y = cvt_pk_bf16(v[2], v[3]); o.z = cvt_pk_bf16(v[4], v[5]); o.w = cvt_pk_bf16(v[6], v[7]);
        *(GAS u32x4*)((bf16_t*)(P.ws + WS_H256) + (size_t)k * CG + s0) = o; }
    for (int i = gl; i < SS * RAD; i += NGL) { const int k = i >> 3, s2 = i & 7; float s, c; sincospif((float)((k * s2) & (SS - 1)) * (1.0f / 1024.0f), &s, &c);
        ((GAS f32x2*)(P.ws + WS_TW + 1 * MiB))[i] = (f32x2){c, s}; }
    for (int q = gw; q < M / 2; q += NGW) {
        const int m = (q >> 3) * 16 + (q & 7), hh = (lane >> 2) & 1, mr = m + 8 * hh;
        const GAS f32x4* xr = (const GAS f32x4*)(mr < MP ? P.x_prompt + (size_t)mr * D : P.x_sample + (size_t)(mr - MP) * D) + (lane >> 3) * 8 + (lane & 3) * 2;
        f32x4 v[8][2]; float s = 0.f;
#pragma unroll
        for (int j = 0; j < 8; ++j) { v[j][0] = xr[64 * j]; v[j][1] = xr[64 * j + 1]; }
        GAS u32x4* o16 = (GAS u32x4*)((bf16_t*)(P.ws + WS_B1) + pg8::paired_off(m, 0, D)) + lane;
#pragma unroll
        for (int j = 0; j < 8; ++j) { u32x4 w; w[0] = cvt_pk_bf16(v[j][0].x, v[j][0].y); w[1] = cvt_pk_bf16(v[j][0].z, v[j][0].w); w[2] = cvt_pk_bf16(v[j][1].x, v[j][1].y); w[3] = cvt_pk_bf16(v[j][1].z, v[j][1].w); o16[64 * j] = w;
#pragma unroll
            for (int e = 0; e < 4; ++e) { const float y0 = bf_lo(w[e]), y1 = bf_hi(w[e]); s += y0 * y0 + y1 * y1; } }
        s += __shfl_xor(s, 1); s += __shfl_xor(s, 2); s += __shfl_xor(s, 8); s += __shfl_xor(s, 16); s += __shfl_xor(s, 32);
        if ((lane & ~4) == 0) ((GAS u64*)(P.ws + WS_RS))[mr] = pg8::rs_fix(s);
    }
}

__device__ __forceinline__ void final_norm_phase(const bf16_t* xs, float* out, const u64* RS, const float* gain, int gw, int NGW, int lane_) {
    int lane = lane_; asm volatile("" : "+v"(lane));
    const int col4 = (lane >> 3) * 8 + (lane & 3) * 2, hh = (lane >> 2) & 1;
    f32x4 gv[8][2];
#pragma unroll
    for (int j = 0; j < 8; ++j) { gv[j][0] = ((const GAS f32x4*)gain)[col4 + 64 * j]; gv[j][1] = ((const GAS f32x4*)gain)[col4 + 64 * j + 1]; }
    for (int q = gw; q < M / 2; q += NGW) {
        const int m = (q >> 3) * 16 + (q & 7), mr = m + 8 * hh;
        const GAS u32x4* xr = (const GAS u32x4*)(xs + pg8::paired_off(m, 0, D)) + lane;
        GAS f32x4* orow = (GAS f32x4*)(out + (size_t)mr * D) + col4;
        const float rstd = pg8::row_rstd(RS + mr);
        u32x4 v[8];
#pragma unroll
        for (int j = 0; j < 8; ++j) v[j] = xr[64 * j];
#pragma unroll
        for (int j = 0; j < 8; ++j) { f32x4 y0, y1; y0.x = bf_lo(v[j][0]); y0.y = bf_hi(v[j][0]); y0.z = bf_lo(v[j][1]); y0.w = bf_hi(v[j][1]); y1.x = bf_lo(v[j][2]); y1.y = bf_hi(v[j][2]); y1.z = bf_lo(v[j][3]); y1.w = bf_hi(v[j][3]);
            orow[64 * j] = y0 * rstd * gv[j][0]; orow[64 * j + 1] = y1 * rstd * gv[j][1]; }
    }
}
__device__ __forceinline__ void conv_phase(const bf16_t* Bb, const bf16_t* Ub, const float* cw, const u64* RS, bf16_t* Gb, int gw, int NGW, int lane_) {
    int lane = lane_; asm volatile("" : "+v"(lane));
    for (int chunk = gw; chunk < M / 8; chunk += NGW) {
        const int m0 = chunk * 8;
        const bool first = (m0 == 0) || (m0 >= MP && ((m0 - MP) & (SS - 1)) == 0);
        const bool last = (m0 + 8 == MP) || (m0 >= MP && ((m0 + 8 - MP) & (SS - 1)) == 0);
        float rr[10];
#pragma unroll
        for (int q = 0; q < 10; ++q) { const bool ok = !((q == 0 && first) || (q == 9 && last)); rr[q] = ok ? pg8::row_rstd(RS + (m0 - 1 + q)) : 0.f; }
#pragma unroll 1
        for (int j = 0; j < 4; ++j) {
            const int ch0 = (lane + 64 * j) * 8;
            float w0[8], w1[8], w2[8];
#pragma unroll
            for (int h = 0; h < 2; ++h) { const f32x4 a = *(const GAS f32x4*)(cw + ch0 + 4 * h), b = *(const GAS f32x4*)(cw + D + ch0 + 4 * h), c = *(const GAS f32x4*)(cw + 2 * D + ch0 + 4 * h);
#pragma unroll
                for (int e = 0; e < 4; ++e) { w0[4 * h + e] = a[e]; w1[4 * h + e] = b[e]; w2[4 * h + e] = c[e]; } }
            const GAS u32x4* up = (const GAS u32x4*)(Ub + (size_t)m0 * D + ch0);
            const GAS u32x4* bp = (const GAS u32x4*)(Bb + (size_t)m0 * D + ch0);
            GAS u32x4* gp = (GAS u32x4*)(Gb + (size_t)m0 * D + ch0);
            u32x4 uu[10], bb[8];
#pragma unroll
            for (int q = 0; q < 10; ++q) { const bool ok = !((q == 0 && first) || (q == 9 && last)); uu[q] = (u32x4){0u, 0u, 0u, 0u}; if (ok) uu[q] = *(up + (ptrdiff_t)(q - 1) * (D / 8)); }
#pragma unroll
            for (int r = 0; r < 8; ++r) bb[r] = bp[(size_t)r * (D / 8)];
#pragma unroll
            for (int r = 0; r < 8; ++r) {
                const float rp = rr[r] * rr[r], rc = rr[r + 1] * rr[r + 1], rn = rr[r + 2] * rr[r + 2], rb = rr[r + 1];
                float o[8];
#pragma unroll
                for (int e = 0; e < 8; ++e) o[e] = rb * bf_at(bb[r], e) * (w0[e] * rp * bf_at(uu[r], e) + w1[e] * rc * bf_at(uu[r + 1], e) + w2[e] * rn * bf_at(uu[r + 2], e));
                u32x4 w; w.x = cvt_pk_bf16(o[0], o[1]); w.y = cvt_pk_bf16(o[2], o[3]); w.z = cvt_pk_bf16(o[4], o[5]); w.w = cvt_pk_bf16(o[6], o[7]);
                gp[(size_t)r * (D / 8)] = w;
            }
        }
    }
}
__device__ __forceinline__ void load_rev(const GAS bf16_t* rowp, int g0, int c0, float (&r)[8]) {
    const u32x4 A = *(const GAS u32x4*)(rowp + g0 + ((248 - c0) & 255)), Bv = *(const GAS u32x4*)(rowp + g0 + ((256 - c0) & 255));
    r[0] = bf_at(Bv, 0);
#pragma unroll
    for (int i = 1; i < 8; ++i) r[i] = bf_at(A, 8 - i);
}
__device__ __forceinline__ void post_phase(int mode, const bf16_t* UP, const bf16_t* US, const f32x2* TWP, const f32x2* TWS, bf16_t* MXP, bf16_t* MXS, const bf16_t* HP256, bf16_t* H2048, int gw, int NGW, int lane_) {
    int lane = lane_; asm volatile("" : "+v"(lane));
    const float SC_S = 0.5f / sqrtf((float)SS * (float)CG), SC_P = 0.5f / sqrtf((float)SP * (float)CG);
    for (int it = gw + (mode == 1 ? SS : 0); it < (mode == 1 ? SS + NB * CG : SS); it += NGW) {
        const bool pr = it < SS;
        const int L = pr ? SS : CG, b = pr ? 0 : (it - SS) >> 8, k1 = pr ? it : (it - SS) & (CG - 1), nk1 = (L - k1) & (L - 1);
        const GAS bf16_t* H = pr ? (const GAS bf16_t*)UP : (const GAS bf16_t*)US + (size_t)b * SS * D;
        GAS bf16_t* O = pr ? (GAS bf16_t*)MXP : (GAS bf16_t*)MXS + (size_t)(MP + b * SS) * D;
        const f32x2* TW = pr ? TWP : TWS; const float sc = pr ? SC_P : SC_S;
        f32x2 st[8];
#pragma unroll
        for (int k2 = 0; k2 < 8; ++k2) st[k2] = TW[(size_t)(k1 + L * k2) * RAD + 1];
#pragma unroll 1
        for (int j = 0; j < 4; ++j) { const int ch0 = (lane + 64 * j) * 8, g0 = ch0 & ~255, c0 = ch0 & 255;
            const int ra = g0 + ((248 - c0) & 255), rb = g0 + ((256 - c0) & 255);
            f32x2 acc[8][4], cw[8];
#pragma unroll
            for (int a = 0; a < 8; ++a) { cw[a] = (f32x2){1.f, 0.f};
#pragma unroll
                for (int e = 0; e < 4; ++e) acc[a][e] = (f32x2){0.f, 0.f}; }
#pragma unroll 1
            for (int hf = 0; hf < 4; ++hf) {
                u32x4 va[2], vp[2], nA[2], nB[2], kA[2], kB[2];
#pragma unroll
                for (int q = 0; q < 2; ++q) { const int s2 = hf * 2 + q;
                    const GAS bf16_t* rowk = H + ((size_t)s2 * L + k1) * D;
                    const GAS bf16_t* rown = H + ((size_t)s2 * L + nk1) * D;
                    va[q] = *(const GAS u32x4*)(rowk + ch0); vp[q] = *(const GAS u32x4*)(rown + ch0);
                    nA[q] = *(const GAS u32x4*)(rown + ra); nB[q] = *(const GAS u32x4*)(rown + rb);
                    kA[q] = *(const GAS u32x4*)(rowk + ra); kB[q] = *(const GAS u32x4*)(rowk + rb); }
#pragma unroll
                for (int q = 0; q < 2; ++q) {
                    float Ev[8], Ov[8];
                    Ev[0] = bf_at(va[q], 0) + bf_at(nB[q], 0); Ov[0] = bf_at(vp[q], 0) - bf_at(kB[q], 0);
#pragma unroll
                    for (int e = 1; e < 8; ++e) { Ev[e] = bf_at(va[q], e) + bf_at(nA[q], 8 - e); Ov[e] = bf_at(vp[q], e) - bf_at(kA[q], 8 - e); }
#pragma unroll
                    for (int k2 = 0; k2 < 8; ++k2) { const f32x2 cc = (f32x2){cw[k2].x, cw[k2].x}, ss = (f32x2){cw[k2].y, cw[k2].y};
#pragma unroll
                        for (int e = 0; e < 4; ++e) { acc[k2][e] = __builtin_elementwise_fma((f32x2){Ev[2 * e], Ev[2 * e + 1]}, cc, acc[k2][e]);
                                                      acc[k2][e] = __builtin_elementwise_fma((f32x2){Ov[2 * e], Ov[2 * e + 1]}, ss, acc[k2][e]); }
                        const float nc = cw[k2].x * st[k2].x - cw[k2].y * st[k2].y, ns = cw[k2].y * st[k2].x + cw[k2].x * st[k2].y; cw[k2] = (f32x2){nc, ns}; }
                }
            }
#pragma unroll
            for (int k2 = 0; k2 < 8; ++k2) { u32x4 w;
                w.x = cvt_pk_bf16(acc[k2][0].x * sc, acc[k2][0].y * sc); w.y = cvt_pk_bf16(acc[k2][1].x * sc, acc[k2][1].y * sc);
                w.z = cvt_pk_bf16(acc[k2][2].x * sc, acc[k2][2].y * sc); w.w = cvt_pk_bf16(acc[k2][3].x * sc, acc[k2][3].y * sc);
                *(GAS u32x4*)(O + (size_t)(k1 + L * k2) * D + ch0) = w; }
        }
    }
    if (mode == 1) {
        for (int it = gw; it < RAD * CG; it += NGW) {
            const int t = it >> 8, k1 = it & (CG - 1), nk1 = (CG - k1) & (CG - 1);
            f32x2 st[8];
#pragma unroll
            for (int k2 = 0; k2 < 8; ++k2) st[k2] = TWS[(size_t)(k1 + CG * k2) * RAD + 1];
#pragma unroll 1
            for (int j = 0; j < 4; ++j) { const int ch0 = (lane + 64 * j) * 8;
                f32x2 acc[8][4], cw[8];
#pragma unroll
                for (int a = 0; a < 8; ++a) { cw[a] = (f32x2){1.f, 0.f};
#pragma unroll
                    for (int e = 0; e < 4; ++e) acc[a][e] = (f32x2){0.f, 0.f}; }
#pragma unroll 1
                for (int hf = 0; hf < 2; ++hf) {
                    u32x4 va[4], vp[4];
#pragma unroll
                    for (int q = 0; q < 4; ++q) { const int s2 = t + 8 * (hf * 4 + q);
                        va[q] = *(const GAS u32x4*)((const GAS bf16_t*)HP256 + ((size_t)s2 * CG + k1) * D + ch0);
                        vp[q] = *(const GAS u32x4*)((const GAS bf16_t*)HP256 + ((size_t)s2 * CG + nk1) * D + ch0); }
#pragma unroll
                    for (int q = 0; q < 4; ++q) {
#pragma unroll
                        for (int k2 = 0; k2 < 8; ++k2) { const f32x2 cc = (f32x2){cw[k2].x, cw[k2].x}, ss = (f32x2){cw[k2].y, cw[k2].y};
#pragma unroll
                            for (int e = 0; e < 4; ++e) { acc[k2][e] = __builtin_elementwise_fma((f32x2){bf_at(va[q], 2 * e), bf_at(va[q], 2 * e + 1)}, cc, acc[k2][e]);
                                                          acc[k2][e] = __builtin_elementwise_fma((f32x2){bf_at(vp[q], 2 * e), bf_at(vp[q], 2 * e + 1)}, ss, acc[k2][e]); }
                            const float nc = cw[k2].x * st[k2].x - cw[k2].y * st[k2].y, ns = cw[k2].y * st[k2].x + cw[k2].x * st[k2].y; cw[k2] = (f32x2){nc, ns}; }
                    }
                }
#pragma unroll
                for (int k2 = 0; k2 < 8; ++k2) { u32x4 w;
                    w.x = cvt_pk_bf16(acc[k2][0].x, acc[k2][0].y); w.y = cvt_pk_bf16(acc[k2][1].x, acc[k2][1].y);
                    w.z = cvt_pk_bf16(acc[k2][2].x, acc[k2][2].y); w.w = cvt_pk_bf16(acc[k2][3].x, acc[k2][3].y);
                    *(GAS u32x4*)((GAS bf16_t*)H2048 + ((size_t)t * SS + k1 + CG * k2) * D + ch0) = w; }
            }
        }
    }
}

#define TIC() do { if (PROBE_CAT) pt0 = __builtin_amdgcn_s_memrealtime(); } while (0)
#define TOC(cat) do { if (PROBE_CAT == (cat)) pacc += __builtin_amdgcn_s_memrealtime() - pt0; } while (0)
#define GRID_BAR() do { TIC(); xcd_barrier(bar); TOC(2); } while (0)
__global__ void __launch_bounds__(NWAVES * 64, 2) fwd_kernel(Ptrs P) {
    extern __shared__ __attribute__((aligned(16))) unsigned char lds_raw[];
    LAS unsigned char* lds = (LAS unsigned char*)lds_raw;
    const int tid = threadIdx.x, lane = tid & 63, wave = __builtin_amdgcn_readfirstlane(tid >> 6);
    const int G = gridDim.x, bx = blockIdx.x;
    const int vcu = (G % 8 == 0) ? (bx % 8) * (G / 8) + bx / 8 : bx;
    const int gw = vcu * NWAVES + wave, NGW = G * NWAVES;
    for (int u = tid; u < (LDS_BYTES - LDSCTL_OFF) / 4; u += NWAVES * 64) ((LAS unsigned*)(lds + LDSCTL_OFF))[u] = 0u;
    __syncthreads();
    volatile LAS unsigned* MISC = (volatile LAS unsigned*)(lds + MISC_OFF);
    XcdBarrier bar = xcd_barrier_post((unsigned*)(P.ws + WS_CTL) + CW_BAR, MISC + 8);

#define WIN ((bf16_t*)wsp(P.ws, WS_WIN))
#define AWO ((bf16_t*)wsp(P.ws, WS_AWO))
#define FWO ((bf16_t*)wsp(P.ws, WS_FWO))
#define WUP ((bf16_t*)wsp(P.ws, WS_WUP))
#define WDN ((bf16_t*)wsp(P.ws, WS_WDN))
#define HART ((bf16_t*)wsp(P.ws, WS_HART))
#define PT ((bf16_t*)wsp(P.ws, WS_PT))
#define TW ((const f32x2*)wsp(P.ws, WS_TW))
#define TWS ((const f32x2*)wsp(P.ws, WS_TW + 1 * MiB))
#define H256 ((bf16_t*)wsp(P.ws, WS_H256))
#define B1 ((bf16_t*)wsp(P.ws, WS_B1))
#define B2 ((bf16_t*)wsp(P.ws, WS_B2))
#define B3 ((bf16_t*)wsp(P.ws, WS_B3))

    unsigned long long pacc = 0ull, pt0 = 0ull;
    TIC(); prologue(P, lds, gw, NGW, wave, lane); TOC(1);
    GRID_BAR();

#define PTG PT
#define RSB ((u64*)wsp(P.ws, WS_RS))
#define XS B1
#pragma unroll 1
    for (int layer = 0; layer < 4; ++layer) {
        const int j = layer >> 1;
        u64* RS0 = RSB + (size_t)(2 * layer) * (RS_STRIDE / 8);
        u64* RS1 = RS0 + RS_STRIDE / 8;
        u64* RS2 = RS1 + RS_STRIDE / 8;
        if ((layer & 1) == 0) {
            {
                pg8::DescPlain g{XS, WIN + (size_t)j * 3 * D * D, D, D, D}; pg8::StaticOrder S; S.init(M, 3 * D, G, bx, 4, 1);
                pg8::EpiGate E{B2, B3};
                pg8::gemm_phase<pg8::DescPlain, pg8::EpiGate, true, true>(lds, g, S, E, pacc);
            }
            GRID_BAR();
            TIC(); conv_phase(B2, B3, P.a_conv_w + (size_t)j * 3 * D, RS0, B2, gw, NGW, lane); TOC(1);
            GRID_BAR();
        } else {
            bf16_t* VTS = B2 + (size_t)RAD * D * SS; bf16_t* USM = B3 + (size_t)RAD * SS * D;
#pragma unroll 1
            for (int pr = 1; pr >= 0; --pr) {
                pg8::DescF0 g{PTG + (size_t)j * NGRP * CG * CG, pr ? XS : XS + (size_t)MP * D, CG, CG, pr ? 64 * D : 8 * D, pr}; pg8::StaticOrder S; S.init(D, pr ? MP : MS, G, bx);
                pg8::EpiBf16<2> E{pr ? B2 : VTS, CG, RS0, pr, nullptr, 0};
                pg8::gemm_phase<pg8::DescF0, pg8::EpiBf16<2>, true, true>(lds, g, S, E, pacc);
            }
            GRID_BAR();
            {
                pg8::DescF2 g{H256, B2, CG, CG, CG, 0, 0}; pg8::StaticOrder S; S.init(M, D, G, bx);
                pg8::EpiBf16<0> E{B3, D, nullptr, 0, nullptr, 0};
                pg8::gemm_phase<pg8::DescF2, pg8::EpiBf16<0>, true, true>(lds, g, S, E, pacc);
            }
            GRID_BAR();
#pragma unroll 1
            for (int mode = 1; mode <= 2; ++mode) {
                TIC(); post_phase(mode, B2, USM, TW, TWS, B3, B2, B3, B2, gw, NGW, lane); TOC(1);
                GRID_BAR();
            }
        }
        {
            pg8::DescSplit g{(layer & 1) ? B3 : B2, B2 + (size_t)MP * D, MP / BMT, ((layer & 1) == 0 ? AWO : FWO) + (size_t)j * D * D, D, D, D, 0}; pg8::StaticOrder S; S.init(M, D, G, bx, 4);
            pg8::EpiRes<false> E{XS, RS1, 0, nullptr};
            pg8::gemm_phase<pg8::DescSplit, pg8::EpiRes<false>, true, true>(lds, g, S, E, pacc);
        }
        GRID_BAR();
        {
            pg8::DescPlain g{XS, WUP + (size_t)layer * D * DFF, D, D, D}; pg8::StaticOrder S; S.init(M, DFF, G, bx, 4, 1);
            pg8::EpiBf16<1> E{B2, DFF, nullptr, 0, (bf16_t*)P.out, MCH / BMT};
            pg8::gemm_phase<pg8::DescPlain, pg8::EpiBf16<1>, true, true>(lds, g, S, E, pacc);
        }
        GRID_BAR();
        {
            pg8::DescSplit g{B2, (const bf16_t*)P.out, MCH / BMT, WDN + (size_t)layer * D * DFF, DFF, DFF, DFF, 1}; pg8::StaticOrder S; S.init(M, D, G, bx, 4);
            pg8::EpiRes<true> E{XS, RS2, 0, RS1};
            pg8::gemm_phase<pg8::DescSplit, pg8::EpiRes<true>, true, true>(lds, g, S, E, pacc);
        }
        GRID_BAR();
    }
    TIC(); final_norm_phase(XS, P.out, RSB + (size_t)8 * (RS_STRIDE / 8), P.final_norm, gw, NGW, lane); TOC(1);
    if (PROBE_CAT && bx == 0 && wave == 0) { const unsigned long long te = __builtin_amdgcn_s_memrealtime() + PROBE_ALPHA * pacc; while (__builtin_amdgcn_s_memrealtime() < te) __builtin_amdgcn_s_sleep(8); }
}

#undef WIN
#undef AWO
#undef FWO
#undef WUP
#undef WDN
#undef HART
#undef PT
#undef TW
#undef TWS
#undef H256
#undef B1
#undef B2
#undef B3
#undef PTG
#undef RSB
#undef XS
extern "C" void kernel_launch(void* const* d_in, const int* in_sizes, int n_in, void* d_out, int out_size, void* d_ws, size_t ws_size, hipStream_t stream) {
    static int grid = 0;
    if (grid == 0) {
        if (n_in != 11 || out_size != M * D || ws_size < WS_END) { fprintf(stderr, "kernel_launch: unexpected shapes (n_in %d, out %d, ws %zu)\n", n_in, out_size, ws_size); grid = -1; return; }
        int dev = 0, cus = 0, per_cu = 0;
        if (hipGetDevice(&dev) != hipSuccess || hipDeviceGetAttribute(&cus, hipDeviceAttributeMultiprocessorCount, dev) != hipSuccess) { grid = -1; return; }
        if (hipFuncSetAttribute((const void*)fwd_kernel, hipFuncAttributeMaxDynamicSharedMemorySize, LDS_BYTES) != hipSuccess) { fprintf(stderr, "kernel_launch: hipFuncSetAttribute failed\n"); grid = -1; return; }
        if (hipOccupancyMaxActiveBlocksPerMultiprocessor(&per_cu, (const void*)fwd_kernel, NWAVES * 64, LDS_BYTES) != hipSuccess || per_cu < 1)
            fprintf(stderr, "kernel_launch: occupancy query reports %d workgroups per CU\n", per_cu);
        (void)hipGetLastError();
        grid = cus;
    }
    if (grid < 0) return;
    if (hipMemsetAsync((char*)d_ws + WS_CTL, 0, CTL_ZERO_BYTES, stream) != hipSuccess) return;
    Ptrs p{};
    p.x_prompt = (const float*)d_in[0]; p.x_sample = (const float*)d_in[1]; p.norm_mix = (const float*)d_in[2]; p.a_w_in = (const float*)d_in[3];
    p.a_conv_w = (const float*)d_in[4]; p.a_w_out = (const float*)d_in[5]; p.f_w_out = (const float*)d_in[6]; p.norm_ffn = (const float*)d_in[7];
    p.w_up = (const float*)d_in[8]; p.w_down = (const float*)d_in[9]; p.final_norm = (const float*)d_in[10];
    p.out = (float*)d_out; p.ws = (unsigned char*)d_ws;
    hipLaunchKernelGGL(fwd_kernel, dim3(grid), dim3(NWAVES * 64), LDS_BYTES, stream, p);
    const hipError_t le = hipPeekAtLastError();
    if (le != hipSuccess) fprintf(stderr, "kernel_launch: launch failed: %s\n", hipGetErrorName(le));
    (void)in_sizes;
}
```

```cpp
#include <hip/hip_runtime.h>
#include <cstdio>
#include <cstdint>

#ifndef PROBE_CAT
#define PROBE_CAT 0
#endif
#define PROBE_ALPHA 4
#define LAS __attribute__((address_space(3)))
#define GAS __attribute__((address_space(1)))
typedef unsigned short bf16_t;
typedef short bf16x8 __attribute__((ext_vector_type(8)));
typedef float f32x4 __attribute__((ext_vector_type(4)));
typedef float f32x2 __attribute__((ext_vector_type(2)));
typedef unsigned u32x4 __attribute__((ext_vector_type(4)));
typedef unsigned u32x2 __attribute__((ext_vector_type(2)));
typedef GAS unsigned gu32;
typedef unsigned long long u64;

constexpr int D = 2048, DFF = 8192, SP = 16384, SS = 2048, NB = 16;
constexpr int MP = SP, MS = NB * SS, M = MP + MS;
constexpr int CG = 256, NGRP = 8, RAD = SP / SS;
constexpr int NSEQ = RAD + NB;
constexpr int MCH = M / 2, BMT = 256;
constexpr float RMS_EPS = 1e-6f;

constexpr size_t MiB = 1u << 20;
constexpr size_t WS_CTL = 0, CTL_ZERO_BYTES = 5 * MiB;
constexpr size_t WS_RS = 1 * MiB, RS_STRIDE = 384 * 1024;
constexpr size_t WS_WIN = 5 * MiB;
constexpr size_t WS_AWO = WS_WIN + 48 * MiB;
constexpr size_t WS_FWO = WS_AWO + 16 * MiB;
constexpr size_t WS_WUP = WS_FWO + 16 * MiB;
constexpr size_t WS_WDN = WS_WUP + 128 * MiB;
constexpr size_t WS_HART = WS_WDN + 128 * MiB;
constexpr size_t WS_PT = WS_HART + 8 * MiB;
constexpr size_t WS_TW = WS_PT + 2 * MiB;
constexpr size_t WS_H256 = WS_TW + 2 * MiB;
constexpr size_t WS_B1 = WS_H256 + 1 * MiB;
constexpr size_t WS_B2 = WS_B1 + 192 * MiB;
constexpr size_t WS_B3 = WS_B2 + 192 * MiB;
constexpr size_t WS_END = WS_B3 + 192 * MiB;
static_assert((size_t)M * D * 2 == 192 * MiB && (size_t)MCH * DFF * 2 == 384 * MiB && (size_t)M * 8 == RS_STRIDE && WS_RS + 9 * RS_STRIDE <= CTL_ZERO_BYTES, "buffer sizes");
constexpr int CW_BAR = 4096;

constexpr int RING_BYTES = 131072, LDSCTL_OFF = RING_BYTES, MISC_OFF = LDSCTL_OFF + 320, LDS_BYTES = 147456;
constexpr int NWAVES = 8;

__device__ __forceinline__ unsigned cvt_pk_bf16(float lo, float hi) { unsigned r; asm("v_cvt_pk_bf16_f32 %0, %1, %2" : "=v"(r) : "v"(lo), "v"(hi)); return r; }
__device__ __forceinline__ float bf_lo(unsigned w) { return __builtin_bit_cast(float, w << 16); }
__device__ __forceinline__ float bf_hi(unsigned w) { return __builtin_bit_cast(float, w & 0xffff0000u); }
typedef float f32x2 __attribute__((ext_vector_type(2)));
__device__ __forceinline__ float dot2_bf16(unsigned a, unsigned b, float c) { typedef __bf16 bf2 __attribute__((ext_vector_type(2))); return __builtin_amdgcn_fdot2_f32_bf16(__builtin_bit_cast(bf2, a), __builtin_bit_cast(bf2, b), c, false); }
__device__ __forceinline__ float relu1(float x) { float r; asm("v_max_f32 %0, 0, %1" : "=v"(r) : "v"(x)); return r; }
__device__ __forceinline__ float quad_rows_sum(float s) {
    float a = s, b = s;
    asm volatile("s_nop 1\n\tv_permlane16_swap_b32 %0, %1" : "+v"(a), "+v"(b));
    const float t = a + b; a = t; b = t;
    asm volatile("s_nop 1\n\tv_permlane32_swap_b32 %0, %1" : "+v"(a), "+v"(b));
    return a + b;
}
__device__ __forceinline__ float bf_at(const u32x4& v, int i) { const unsigned w = v[i >> 1]; return (i & 1) ? bf_hi(w) : bf_lo(w); }
#define LDS_WAIT() asm volatile("s_waitcnt lgkmcnt(0)" ::: "memory")

namespace pg8 {
constexpr int BM = 256, BK = 64, HALF = 128, HTB = HALF * BK * 2, STAGE_BYTES = 8 * HTB, NXCD = 8, WGM = 8;
__host__ __device__ __forceinline__ int lds_byte(int r, int c) { const int st = (r >> 4) * 2 + (c >> 5), rr = r & 15, cc = c & 31, ob = rr * 64 + cc * 2; return st * 1024 + (ob ^ (((ob >> 9) & 1) << 5)); }
__host__ __device__ __forceinline__ void stage_rc(int b, int& R, int& C) { const int st = b / 1024, sb = b % 1024, swz = sb ^ (((sb >> 9) & 1) << 5); R = (st >> 1) * 16 + swz / 64; C = (st & 1) * 32 + (swz % 64) / 2; }
__host__ __device__ __forceinline__ int perm32(int rho) { const int n = rho >> 4, i = rho & 15; return 8 * (i >> 2) + 4 * n + (i & 3); }

__host__ __device__ __forceinline__ size_t paired_off(int row, int k, int K) { return (size_t)(row >> 4) * 16 * K + (size_t)((row & 7) * (K >> 5) + (k >> 5)) * 64 + ((row >> 3) & 1) * 32 + (k & 31); }
struct Unit { int pm, pn; };
struct StaticOrder {
    int nM, nN, nwg, G, c, wgm, rev;
    __device__ __forceinline__ void init(int M_, int N_, int G_, int c_, int wgm_ = WGM, int rev_ = 0) { nM = M_ / BM; nN = N_ / BM; nwg = nM * nN; G = G_; c = c_; wgm = wgm_; rev = (rev_ && nwg % G_ == 0) ? 1 : 0; }
    __device__ __forceinline__ bool next(int i, Unit& u) const {
        if (i * G >= nwg) return false;
        const long L = (long)(rev ? nwg / G - 1 - i : i) * G + c; if (L >= nwg) return false;
        int wgid = (int)L; { const int q = nwg / NXCD, r = nwg % NXCD, xcd = wgid % NXCD, off = wgid / NXCD; wgid = (xcd < r ? xcd * (q + 1) : r * (q + 1) + (xcd - r) * q) + off; }
        const int nig = wgm * nN, gid = wgid / nig, fm = gid * wgm, gsz = (nM - fm) < wgm ? (nM - fm) : wgm;
        u.pm = fm + ((wgid % nig) % gsz); u.pn = (wgid % nig) / gsz; return true;
    }
};
struct DescPlain { const bf16_t* A; const bf16_t* Bt; int K, lda, ldb;
    __device__ __forceinline__ unsigned voffa(int R, int C) const { return (unsigned)paired_off(R, C, lda) * 2u; }
    __device__ __forceinline__ unsigned voffb(int Rb, int C) const { return (unsigned)paired_off(Rb, C, ldb) * 2u; }
    __device__ __forceinline__ size_t kstepa() const { return 4 * BK; }
    __device__ __forceinline__ size_t hstepa() const { return (size_t)HALF * lda * 2; }
    __device__ __forceinline__ size_t kstepb() const { return 4 * BK; }
    __device__ __forceinline__ const char* abase(const Unit& u) const { return (const char*)A + (size_t)u.pm * BM * lda * 2; }
    __device__ __forceinline__ const char* bbase(const Unit& u) const { return (const char*)Bt + (size_t)u.pn * BM * ldb * 2; } };
struct DescSplit { const bf16_t* A; const bf16_t* Ahi; int msplit; const bf16_t* Bt; int K, lda, ldb, ap;
    __device__ __forceinline__ unsigned voffa(int R, int C) const { return ap ? (unsigned)(((R >> 4) * 2 + (C >> 5)) * 1024 + (R & 7) * 128 + ((R >> 3) & 1) * 64 + (C & 31) * 2) : (unsigned)(R * lda + C) * 2u; }
    __device__ __forceinline__ size_t hstepa() const { return ap ? (size_t)16384 : (size_t)HALF * lda * 2; }
    __device__ __forceinline__ unsigned voffb(int Rb, int C) const { return (unsigned)paired_off(Rb, C, ldb) * 2u; }
    __device__ __forceinline__ size_t kstepa() const { return ap ? 32768 : 2 * BK; }
    __device__ __forceinline__ size_t kstepb() const { return 4 * BK; }
    __device__ __forceinline__ const char* abase(const Unit& u) const { return u.pm < msplit ? (const char*)A + (size_t)u.pm * BM * lda * 2 : (const char*)Ahi + (size_t)(u.pm - msplit) * BM * lda * 2; }
    __device__ __forceinline__ const char* bbase(const Unit& u) const { return (const char*)Bt + (size_t)u.pn * BM * ldb * 2; } };
struct DescF0 { const bf16_t* A; const bf16_t* Bt; int K, lda, ldb, prompt;
    __device__ __forceinline__ const char* abase(const Unit& u) const { return (const char*)A + (size_t)u.pm * CG * CG * 2; }
    __device__ __forceinline__ const char* bbase(const Unit& u) const {
        const int row0 = prompt ? u.pn : (u.pn >> 3) * SS + (u.pn & 7);
        return (const char*)Bt + paired_off(row0, u.pm * CG, D) * 2; }
    __device__ __forceinline__ unsigned voffa(int R, int C) const { return (unsigned)(R * lda + C) * 2u; }
    __device__ __forceinline__ unsigned voffb(int Rb, int C) const {
        const unsigned rp = prompt ? (unsigned)Rb * 64u * D : (unsigned)(Rb >> 1) * 16u * D + (unsigned)(Rb & 1) * 32u;
        return (rp + (unsigned)((C >> 5) * 64 + (C & 31))) * 2u; }
    __device__ __forceinline__ size_t kstepa() const { return 2 * BK; }
    __device__ __forceinline__ size_t hstepa() const { return (size_t)HALF * lda * 2; }
    __device__ __forceinline__ size_t kstepb() const { return 4 * BK; } };
struct DescF2 { const bf16_t* A; const bf16_t* Bt; int K, lda, ldb, amask, ashift;
    __device__ __forceinline__ unsigned voffa(int R, int C) const { return (unsigned)(R * lda + C) * 2u; }
    __device__ __forceinline__ unsigned voffb(int Rb, int C) const { return (unsigned)(Rb * ldb + C) * 2u; }
    __device__ __forceinline__ size_t kstepa() const { return 2 * BK; }
    __device__ __forceinline__ size_t hstepa() const { return (size_t)HALF * lda * 2; }
    __device__ __forceinline__ size_t kstepb() const { return 2 * BK; }
    __device__ __forceinline__ const char* abase(const Unit& u) const { return (const char*)A + (size_t)(u.pm & amask) * BM * lda * 2; }
    __device__ __forceinline__ const char* bbase(const Unit& u) const { return (const char*)Bt + ((size_t)(u.pm >> ashift) * D + (size_t)u.pn * BM) * ldb * 2; } };

__device__ __forceinline__ float rstd_of(float ss) { return 1.0f / sqrtf(ss * (1.0f / D) + RMS_EPS); }
constexpr float RS_FIX = 1048576.0f;
__device__ __forceinline__ u64 rs_fix(float s) { return (u64)(s * RS_FIX); }
__device__ __forceinline__ float row_rstd(const u64* p) { return rstd_of((float)__hip_atomic_load((GAS u64*)p, __ATOMIC_RELAXED, __HIP_MEMORY_SCOPE_AGENT) * (1.0f / RS_FIX)); }
__device__ __forceinline__ unsigned dpp_ror8(unsigned old, unsigned src, int bank_mask) {
    return bank_mask == 0xC ? (unsigned)__builtin_amdgcn_update_dpp((int)old, (int)src, 0x128, 0xf, 0xC, false) : (unsigned)__builtin_amdgcn_update_dpp((int)old, (int)src, 0x128, 0xf, 0x3, false); }
__device__ __forceinline__ void widen(const u32x4& own0, const u32x4& own1, u32x4& r1, u32x4& r2) {
#pragma unroll
    for (int e = 0; e < 4; ++e) { r1[e] = dpp_ror8(own0[e], own1[e], 0xC); r2[e] = dpp_ror8(own1[e], own0[e], 0x3); }
}
template <bool SCALE> struct EpiRes {
    static constexpr bool PERM = true;
    bf16_t* XS; u64* RS; int row0; const u64* RSin;
    __device__ __forceinline__ void operator()(const f32x4 (&acc)[2][2][4][2], const Unit& u, int wr, int wc, int fr, int fq) const {
        const int rt = row0 + u.pm * BM;
        GAS char* ub = (GAS char*)XS + (size_t)rt * D * 2 + (size_t)(8 * u.pn + 2 * wc) * 128 + (size_t)wr * 64 * D * 2;
        const unsigned lp = (unsigned)((fr & 7) * (D >> 5) * 64 + (fr >> 3) * 32 + 8 * fq) * 2u;
        u32x4 xv[2][4][2];
#pragma unroll
        for (int ai = 0; ai < 2; ++ai)
#pragma unroll
            for (int m = 0; m < 4; ++m) { const GAS char* rb = ub + (size_t)(ai * HALF + m * 16) * D * 2;
#pragma unroll
                for (int h = 0; h < 2; ++h) xv[ai][m][h] = *(const GAS u32x4*)(rb + lp + h * 128); }
        float rsc[2][4];
#pragma unroll
        for (int ai = 0; ai < 2; ++ai)
#pragma unroll
            for (int m = 0; m < 4; ++m) { rsc[ai][m] = 1.f;
                if (SCALE) { const float r = row_rstd(RSin + (rt + ai * HALF + wr * 64 + m * 16 + fr)); rsc[ai][m] = r * r; } }
#pragma unroll
        for (int ai = 0; ai < 2; ++ai)
#pragma unroll
            for (int m = 0; m < 4; ++m) { GAS char* rb = ub + (size_t)(ai * HALF + m * 16) * D * 2;
                const float sc = rsc[ai][m];
                float s = 0.f, s1 = 0.f;
                u32x4 w[2];
                const f32x2 sc2 = (f32x2){sc, sc};
#pragma unroll
                for (int bj = 0; bj < 2; ++bj) {
#pragma unroll
                    for (int n = 0; n < 2; ++n) { const f32x4 a = acc[ai][bj][m][n]; const unsigned x0 = xv[ai][m][bj][2 * n], x1 = xv[ai][m][bj][2 * n + 1];
                        f32x2 p0 = (f32x2){bf_lo(x0), bf_hi(x0)}, p1 = (f32x2){bf_lo(x1), bf_hi(x1)};
                        const f32x2 a0 = (f32x2){a[0], a[1]}, a1 = (f32x2){a[2], a[3]};
                        if (SCALE) { p0 = __builtin_elementwise_fma(a0, sc2, p0); p1 = __builtin_elementwise_fma(a1, sc2, p1); } else { p0 += a0; p1 += a1; }
                        const unsigned w0 = cvt_pk_bf16(p0[0], p0[1]), w1 = cvt_pk_bf16(p1[0], p1[1]);
                        w[bj][2 * n] = w0; w[bj][2 * n + 1] = w1;
                        s = dot2_bf16(w0, w0, s); s1 = dot2_bf16(w1, w1, s1); } }
                s += s1;
                *(GAS u32x4*)(rb + lp) = w[0]; *(GAS u32x4*)(rb + lp + 128) = w[1];
                s = quad_rows_sum(s);
                if (fq == 0) __hip_atomic_fetch_add((GAS u64*)RS + (rt + ai * HALF + wr * 64 + m * 16 + fr), rs_fix(s), __ATOMIC_RELAXED, __HIP_MEMORY_SCOPE_AGENT);
                __builtin_amdgcn_sched_barrier(0);
            }
    }
};
template <int MODE  > struct EpiBf16 {
    static constexpr bool PERM = true;
    bf16_t* O; int ldc; const u64* RS; int row0; bf16_t* Ohi; int msplit;
    __device__ __forceinline__ void operator()(const f32x4 (&acc)[2][2][4][2], const Unit& u, int wr, int wc, int fr, int fq) const {
        GAS char* ub;
        if (MODE == 2) ub = (GAS char*)O + ((size_t)u.pn * D + (size_t)u.pm * BM) * BM * 2;
        else if (MODE == 1 && u.pm >= msplit) ub = (GAS char*)Ohi + ((size_t)(u.pm - msplit) * BM * ldc + (size_t)u.pn * BM) * 2;
        else ub = (GAS char*)O + ((size_t)u.pm * BM * ldc + (size_t)u.pn * BM) * 2;
        const unsigned lo = (unsigned)((wr * 64 + (fr & 7)) * ldc + wc * 64) * 2u + (unsigned)(4 * (fr >> 3) + fq) * 16u;
        f32x4 cs[2][2];
        if (MODE == 2) {
            const int ln = fq * 16 + fr, tc = wc * 64 + ln;
            const u64* tp = RS + (row0 ? u.pn + 64 * tc : MP + (u.pn >> 3) * SS + (u.pn & 7) + 8 * tc);
            const float tr = row_rstd(tp);
#pragma unroll
            for (int bj = 0; bj < 2; ++bj)
#pragma unroll
                for (int n = 0; n < 2; ++n)
#pragma unroll
                    for (int j = 0; j < 4; ++j) cs[bj][n][j] = __shfl(tr, bj * 32 + 8 * fq + 4 * n + j);
        } else {
#pragma unroll
            for (int bj = 0; bj < 2; ++bj)
#pragma unroll
                for (int n = 0; n < 2; ++n)
#pragma unroll
                    for (int j = 0; j < 4; ++j) cs[bj][n][j] = 0.f;
        }
        float rsc[2][4];
#pragma unroll
        for (int ai = 0; ai < 2; ++ai)
#pragma unroll
            for (int m = 0; m < 4; ++m) { rsc[ai][m] = 1.f;
            }
#pragma unroll
        for (int ai = 0; ai < 2; ++ai)
#pragma unroll
            for (int m = 0; m < 4; ++m) { GAS char* rb = ub + (size_t)(ai * HALF + m * 16) * ldc * 2;
                const float sc = rsc[ai][m];
                u32x4 w[2];
#pragma unroll
                for (int bj = 0; bj < 2; ++bj) { f32x4 v0 = acc[ai][bj][m][0], v1 = acc[ai][bj][m][1];
                    if (MODE == 1) { const f32x4 a = (f32x4){relu1(v0[0]), relu1(v0[1]), relu1(v0[2]), relu1(v0[3])}, b = (f32x4){relu1(v1[0]), relu1(v1[1]), relu1(v1[2]), relu1(v1[3])}; v0 = a * a; v1 = b * b; }
                    if (MODE == 2) { v0 = v0 * cs[bj][0]; v1 = v1 * cs[bj][1]; }
                    w[bj].x = cvt_pk_bf16(v0[0], v0[1]); w[bj].y = cvt_pk_bf16(v0[2], v0[3]); w[bj].z = cvt_pk_bf16(v1[0], v1[1]); w[bj].w = cvt_pk_bf16(v1[2], v1[3]); }
                if (MODE == 1) {
                    GAS char* hb = u.pm >= msplit ? (GAS char*)Ohi + (size_t)(u.pm - msplit) * BM * ldc * 2 : (GAS char*)O + (size_t)u.pm * BM * ldc * 2;
                    GAS char* gb = hb + (size_t)(4 * u.pn + wc) * 32768 + (size_t)(ai * 8 + wr * 4 + m) * 2048;
                    const unsigned lp = (unsigned)((fr & 7) * 128 + (fr >> 3) * 64 + fq * 16);
                    __builtin_nontemporal_store(w[0], (GAS u32x4*)(gb + lp)); __builtin_nontemporal_store(w[1], (GAS u32x4*)(gb + lp + 1024));
                } else { u32x4 r1, r2; widen(w[0], w[1], r1, r2); *(GAS u32x4*)(rb + lo) = r1; *(GAS u32x4*)(rb + lo + 8 * ldc * 2) = r2; } }
    }
};
struct EpiGate {
    static constexpr bool PERM = true;
    bf16_t* Bo; bf16_t* Uo;
    __device__ __forceinline__ void operator()(const f32x4 (&acc)[2][2][4][2], const Unit& u, int wr, int wc, int fr, int fq) const {
        if (u.pn < 8) {
            GAS char* ub = (GAS char*)Bo + ((size_t)u.pm * BM * D + (size_t)u.pn * BM) * 2;
            const unsigned lo = (unsigned)((wr * 64 + (fr & 7)) * D + wc * 64) * 2u + (unsigned)(4 * (fr >> 3) + fq) * 16u;
#pragma unroll
            for (int ai = 0; ai < 2; ++ai)
#pragma unroll
                for (int m = 0; m < 4; ++m) { GAS char* rb = ub + (size_t)(ai * HALF + m * 16) * D * 2;
                    u32x4 w[2];
#pragma unroll
                    for (int bj = 0; bj < 2; ++bj) { const f32x4 v0 = acc[ai][bj][m][0], v1 = acc[ai][bj][m][1];
                        w[bj].x = cvt_pk_bf16(v0[0], v0[1]); w[bj].y = cvt_pk_bf16(v0[2], v0[3]); w[bj].z = cvt_pk_bf16(v1[0], v1[1]); w[bj].w = cvt_pk_bf16(v1[2], v1[3]); }
                    u32x4 r1, r2; widen(w[0], w[1], r1, r2);
                    *(GAS u32x4*)(rb + lo) = r1; *(GAS u32x4*)(rb + lo + 8 * D * 2) = r2; }
        } else {
            GAS char* ub = (GAS char*)Uo + ((size_t)u.pm * BM * D + (size_t)(u.pn - 8) * HALF) * 2;
            const unsigned lo = (unsigned)((wr * 64 + fr) * D + wc * 32 + 8 * fq) * 2u;
#pragma unroll
            for (int ai = 0; ai < 2; ++ai)
#pragma unroll
                for (int m = 0; m < 4; ++m) { GAS char* rb = ub + (size_t)(ai * HALF + m * 16) * D * 2;
                    const f32x4 v0 = acc[ai][0][m][0] * acc[ai][1][m][0], v1 = acc[ai][0][m][1] * acc[ai][1][m][1];
                    u32x4 w; w.x = cvt_pk_bf16(v0[0], v0[1]); w.y = cvt_pk_bf16(v0[2], v0[3]); w.z = cvt_pk_bf16(v1[0], v1[1]); w.w = cvt_pk_bf16(v1[2], v1[3]);
                    *(GAS u32x4*)(rb + lo) = w; }
        }
    }
};

template <class Desc, class Epi, bool ALIGN_EPI, bool SP2>
__device__ __forceinline__ void gemm_phase(LAS unsigned char* lds, const Desc g, const StaticOrder& S, const Epi& E, unsigned long long& pacc) {
    int tid_ = threadIdx.x; asm volatile("" : "+v"(tid_));
    const int tid = tid_, wid = __builtin_amdgcn_readfirstlane(tid >> 6), lane = tid & 63, wr = wid >> 2, wc = wid & 3, fr = lane & 15, fq = lane >> 4;
    const int K = g.K, nt = K / BK, lda = g.lda, ldb = g.ldb;
    unsigned voffA[2], voffB[2];
#pragma unroll
    for (int i = 0; i < 2; ++i) { int R, C; stage_rc(tid * 16 + i * 8192, R, C); const int Rb = 2 * (R & ~31) + perm32(R & 31);
        voffA[i] = g.voffa(R, C); voffB[i] = g.voffb(Rb, C); }
    const size_t kstep = g.kstepa(), kstepB = g.kstepb();
    const size_t hstepA = g.hstepa(), hstepB = (size_t)32 * ldb * 2;
    const unsigned ldsw = (unsigned)wid * 1024u;
    const int aoff = lds_byte(wr * 64 + fr, fq * 8), boff = lds_byte(wc * 32 + fr, fq * 8);
#define PG8_SA(b, h) (((b) * 2 + (h)) * HTB)
#define PG8_SB(b, h) ((4 + (b) * 2 + (h)) * HTB)
#define PG8_STAGE(bufoff, gbase, voff) do { _Pragma("unroll") for (int _i = 0; _i < 2; ++_i) { unsigned _vo = (voff)[_i]; asm("" : "+v"(_vo));     \
        __builtin_amdgcn_global_load_lds((const GAS unsigned*)((const GAS char*)(gbase) + _vo), (LAS unsigned*)(lds + (bufoff) + ldsw + _i * 8192), 16, 0, 0); } } while (0)
#define PG8_LDA(dst, b, h) do { _Pragma("unroll") for (int m = 0; m < 4; ++m) _Pragma("unroll") for (int k = 0; k < 2; ++k) dst[m][k] = *(const LAS bf16x8*)(lds + PG8_SA(b, h) + aoff + m * 2048 + k * 1024); } while (0)
#define PG8_LDB(dst, b, h) do { _Pragma("unroll") for (int n = 0; n < 2; ++n) _Pragma("unroll") for (int k = 0; k < 2; ++k) dst[n][k] = *(const LAS bf16x8*)(lds + PG8_SB(b, h) + boff + n * 2048 + k * 1024); } while (0)
#define PG8_MMA(ai, bj, At, Bt) do { __builtin_amdgcn_s_setprio(1); _Pragma("unroll") for (int p = 0; p < 8; ++p) _Pragma("unroll") for (int q = 0; q < 2; ++q) { const int n = p >> 2, m = (n ? 3 - (p & 3) : (p & 3)), k = (p ^ q) & 1; \
        asm volatile("v_mfma_f32_16x16x32_bf16 %0, %1, %2, %0" : "+v"(acc[ai][bj][m][n]) : "v"(Bt[n][k]), "v"(At[m][k])); }     __builtin_amdgcn_s_setprio(0); } while (0)
#define PG8_WAIT_V(n) asm volatile("s_waitcnt vmcnt(" #n ")" ::: "memory")
#define PG8_WAIT_L(n) asm volatile("s_waitcnt lgkmcnt(" #n ")" ::: "memory")
#define PG8_BAR __builtin_amdgcn_s_barrier()
#define PG8_SCHED __builtin_amdgcn_sched_barrier(0)
    Unit cur, nxt; int ui = 0;
    if (!S.next(0, cur)) return;
    f32x4 acc[2][2][4][2];
#pragma unroll
    for (int a = 0; a < 2; ++a)
#pragma unroll
        for (int b = 0; b < 2; ++b)
#pragma unroll
            for (int m = 0; m < 4; ++m)
#pragma unroll
                for (int n = 0; n < 2; ++n) acc[a][b][m][n] = (f32x4){0.f, 0.f, 0.f, 0.f};
    bf16x8 At[4][2], B0[2][2], B1[2][2];
    const char* cA = g.abase(cur); const char* cB = g.bbase(cur);
    if constexpr (SP2) {
        PG8_STAGE(PG8_SB(0, 0), cB, voffB); PG8_STAGE(PG8_SB(0, 1), cB + hstepB, voffB); PG8_STAGE(PG8_SA(0, 0), cA, voffA); PG8_STAGE(PG8_SA(0, 1), cA + hstepA, voffA);
        if (wr == 1) PG8_BAR;
        PG8_WAIT_V(2); PG8_BAR;
        PG8_STAGE(PG8_SB(1, 0), cB + kstepB, voffB); PG8_STAGE(PG8_SA(1, 0), cA + kstep, voffA); PG8_STAGE(PG8_SB(1, 1), cB + hstepB + kstepB, voffB);
        PG8_WAIT_V(6); PG8_BAR;
    } else {
        PG8_STAGE(PG8_SB(0, 0), cB, voffB); PG8_STAGE(PG8_SA(0, 0), cA, voffA); PG8_STAGE(PG8_SB(0, 1), cB + hstepB, voffB); PG8_STAGE(PG8_SA(0, 1), cA + hstepA, voffA);
        if (wr == 1) PG8_BAR;
        PG8_WAIT_V(4); PG8_BAR;
        PG8_STAGE(PG8_SB(1, 0), cB + kstepB, voffB); PG8_STAGE(PG8_SA(1, 0), cA + kstep, voffA); PG8_STAGE(PG8_SB(1, 1), cB + hstepB + kstepB, voffB);
        PG8_WAIT_V(6); PG8_BAR;
    }
    for (;;) {
        const bool has_next = S.next(ui + 1, nxt);
        const char* nA = has_next ? g.abase(nxt) : cA; const char* nB = has_next ? g.bbase(nxt) : cB;
#pragma unroll 1
        for (int t = 0; t < nt; t += 2) {
            const bool last = (t == nt - 2);
            unsigned long long pk0 = 0ull; if (PROBE_CAT == 4 || PROBE_CAT == 5) pk0 = __builtin_amdgcn_s_memrealtime();
            const char* a1 = cA + (size_t)(t + 1) * kstep;
            const char* a2 = last ? nA : cA + (size_t)(t + 2) * kstep; const char* b2 = last ? nB : cB + (size_t)(t + 2) * kstepB;
            const char* a3 = a2 + kstep; const char* b3 = b2 + kstepB;
            if constexpr (SP2) {
            PG8_LDB(B0, 0, 0); PG8_LDB(B1, 0, 1); PG8_SCHED; PG8_LDA(At, 0, 0); PG8_STAGE(PG8_SA(1, 1), a1 + hstepA, voffA);
            PG8_WAIT_V(8); PG8_WAIT_L(0); PG8_BAR; PG8_MMA(0, 0, At, B0); PG8_MMA(0, 1, At, B1); PG8_BAR; PG8_SCHED;
            PG8_LDA(At, 0, 1); PG8_STAGE(PG8_SB(0, 0), b2, voffB); PG8_STAGE(PG8_SB(0, 1), b2 + hstepB, voffB); PG8_STAGE(PG8_SA(0, 0), a2, voffA);
            PG8_WAIT_V(8); PG8_WAIT_L(0); PG8_BAR; PG8_MMA(1, 0, At, B0); PG8_MMA(1, 1, At, B1); PG8_BAR; PG8_SCHED;
            PG8_LDB(B0, 1, 0); PG8_LDB(B1, 1, 1); PG8_SCHED; PG8_LDA(At, 1, 0); PG8_STAGE(PG8_SA(0, 1), a2 + hstepA, voffA);
            PG8_WAIT_V(8); PG8_WAIT_L(0); PG8_BAR; PG8_MMA(0, 0, At, B0); PG8_MMA(0, 1, At, B1); PG8_BAR; PG8_SCHED;
            PG8_LDA(At, 1, 1); PG8_STAGE(PG8_SB(1, 0), b3, voffB); PG8_STAGE(PG8_SB(1, 1), b3 + hstepB, voffB); PG8_STAGE(PG8_SA(1, 0), a3, voffA);
            PG8_WAIT_V(8); PG8_WAIT_L(0); PG8_BAR; PG8_MMA(1, 0, At, B0); PG8_MMA(1, 1, At, B1); PG8_BAR; PG8_SCHED;
            } else {
            PG8_LDB(B0, 0, 0); PG8_SCHED; PG8_LDA(At, 0, 0); PG8_STAGE(PG8_SA(1, 1), a1 + hstepA, voffA);
            PG8_WAIT_L(8); PG8_BAR; PG8_WAIT_L(0); PG8_MMA(0, 0, At, B0); PG8_BAR; PG8_SCHED;
            PG8_LDB(B1, 0, 1); PG8_STAGE(PG8_SB(0, 0), b2, voffB);
            PG8_BAR; PG8_WAIT_L(0); PG8_MMA(0, 1, At, B1); PG8_BAR;
            PG8_LDA(At, 0, 1); PG8_STAGE(PG8_SA(0, 0), a2, voffA);
            PG8_BAR; PG8_WAIT_L(0); PG8_MMA(1, 0, At, B0); PG8_BAR; PG8_SCHED;
            PG8_STAGE(PG8_SB(0, 1), b2 + hstepB, voffB);
            PG8_WAIT_V(6); PG8_BAR; PG8_MMA(1, 1, At, B1); PG8_BAR;
            PG8_LDB(B0, 1, 0); PG8_SCHED; PG8_LDA(At, 1, 0); PG8_STAGE(PG8_SA(0, 1), a2 + hstepA, voffA);
            PG8_WAIT_L(8); PG8_BAR; PG8_WAIT_L(0); PG8_MMA(0, 0, At, B0); PG8_BAR; PG8_SCHED;
            PG8_LDB(B1, 1, 1); PG8_STAGE(PG8_SB(1, 0), b3, voffB);
            PG8_BAR; PG8_WAIT_L(0); PG8_MMA(0, 1, At, B1); PG8_BAR;
            PG8_LDA(At, 1, 1); PG8_STAGE(PG8_SA(1, 0), a3, voffA);
            PG8_BAR; PG8_WAIT_L(0); PG8_MMA(1, 0, At, B0); PG8_BAR; PG8_SCHED;
            PG8_STAGE(PG8_SB(1, 1), b3 + hstepB, voffB);
            PG8_WAIT_V(6); PG8_BAR; PG8_MMA(1, 1, At, B1); PG8_BAR;
            }
            if (PROBE_CAT == 4 && t == 0 && ui > 0) pacc += __builtin_amdgcn_s_memrealtime() - pk0;
            if (PROBE_CAT == 5 && t == 2) pacc += __builtin_amdgcn_s_memrealtime() - pk0;
        }
        if constexpr (ALIGN_EPI) { if (wr == 0) PG8_BAR; }
        asm volatile("s_nop 15\n\ts_nop 15" ::: "memory");
        E(acc, cur, wr, wc, fr, fq);
        if (!has_next) break;
#pragma unroll
        for (int a = 0; a < 2; ++a)
#pragma unroll
            for (int b = 0; b < 2; ++b)
#pragma unroll
                for (int m = 0; m < 4; ++m)
#pragma unroll
                    for (int n = 0; n < 2; ++n) acc[a][b][m][n] = (f32x4){0.f, 0.f, 0.f, 0.f};
        cur = nxt; cA = nA; cB = nB; ++ui;
        if constexpr (ALIGN_EPI) { if (wr == 1) PG8_BAR; }
    }
    PG8_WAIT_V(0);
    if constexpr (!ALIGN_EPI) { if (wr == 0) PG8_BAR; }
    PG8_BAR;
#undef PG8_SA
#undef PG8_SB
#undef PG8_STAGE
#undef PG8_LDA
#undef PG8_LDB
#undef PG8_MMA
#undef PG8_WAIT_V
#undef PG8_WAIT_L
#undef PG8_BAR
#undef PG8_SCHED
}
}

#define XB_TMO      128
#define XB_XCNT(j)  (256  + 64 * (j))
#define XB_XSUB(j)  (1280 + 64 * (j))
#define XB_XGEN(j)  (2304 + 64 * (j))
#define XB_TOP      3328
#define XB_TOPGEN   3392
#define XCD_BAR_WORDS 3456
#define XB_SPIN_CAP (1u << 18)
__device__ __forceinline__ unsigned xb_ld(unsigned* p)              { return __hip_atomic_load(p, __ATOMIC_RELAXED, __HIP_MEMORY_SCOPE_AGENT); }
__device__ __forceinline__ unsigned xb_add(unsigned* p, unsigned v) { return __hip_atomic_fetch_add(p, v, __ATOMIC_RELAXED, __HIP_MEMORY_SCOPE_AGENT); }
__device__ __forceinline__ unsigned xb_xcc_id() { return (unsigned)__builtin_amdgcn_s_getreg((3 << 11) | 20) & 0xFu; }
#define XB_SPIN(cond, bar) do { unsigned _sp = 0; while (cond) { __builtin_amdgcn_s_sleep(1); \
    if ((++_sp & 255u) == 0u) { if (xb_ld(&(bar)[XB_TMO])) break; if (_sp > XB_SPIN_CAP) { atomicAdd(&(bar)[XB_TMO], 1u); break; } } } } while (0)
struct XcdBarrier { unsigned* bar; unsigned x; volatile LAS unsigned* st; };
__device__ __forceinline__ XcdBarrier xcd_barrier_post(unsigned* bar, volatile LAS unsigned* st) {
    XcdBarrier b; b.bar = bar; b.x = (unsigned)__builtin_amdgcn_readfirstlane((int)xb_xcc_id()); b.st = st;
    if (threadIdx.x == 0) (void)xb_add(&bar[XB_XCNT(b.x)], 1u);
    return b;
}
__device__ __forceinline__ void xcd_barrier_complete(unsigned* bar, unsigned x, unsigned& nloc, unsigned& nx) {
    const unsigned G = gridDim.x * gridDim.y * gridDim.z;
    unsigned sum, cnt, mine, sp = 0u;
    for (;;) {
        sum = 0u; cnt = 0u; mine = 0u;
#pragma unroll
        for (unsigned j = 0; j < 16; ++j) { const unsigned c = xb_ld(&bar[XB_XCNT(j)]); sum += c; cnt += (c > 0u) ? 1u : 0u; mine = (j == x) ? c : mine; }
        if (sum == G) break;
        __builtin_amdgcn_s_sleep(1);
        if ((++sp & 255u) == 0u) { if (xb_ld(&bar[XB_TMO])) break; if (sp > XB_SPIN_CAP) { atomicAdd(&bar[XB_TMO], 1u); break; } }
    }
    nloc = mine > 0u ? mine : 1u; nx = cnt > 0u ? cnt : 1u;
}
__device__ __forceinline__ void xcd_barrier(const XcdBarrier& b) {
    asm volatile("s_waitcnt vmcnt(0)" ::: "memory");
    __syncthreads();
    if (threadIdx.x == 0) {
        unsigned* bar = b.bar; unsigned bx_ = b.x; asm volatile("" : "+s"(bx_));
        __builtin_amdgcn_s_waitcnt(0);
        unsigned nloc = b.st[0], nx = b.st[1];
        if (nloc == 0u) { xcd_barrier_complete(bar, bx_, nloc, nx); b.st[0] = nloc; b.st[1] = nx; }
        const unsigned old = xb_add(&bar[XB_XSUB(bx_)], 1u);
        const unsigned gen = old / nloc;
        if (old + 1u == (gen + 1u) * nloc) {
            __builtin_amdgcn_fence(__ATOMIC_RELEASE, "agent");
            asm volatile("s_waitcnt vmcnt(0)" ::: "memory");
            const unsigned og = xb_add(&bar[XB_TOP], 1u);
            const unsigned tg = og / nx;
            if (og + 1u == (tg + 1u) * nx) xb_add(&bar[XB_TOPGEN], 1u);
            else XB_SPIN(xb_ld(&bar[XB_TOPGEN]) == tg, bar);
            __builtin_amdgcn_fence(__ATOMIC_ACQUIRE, "agent");
            xb_add(&bar[XB_XGEN(bx_)], 1u);
            asm volatile("s_waitcnt vmcnt(0)" ::: "memory");
        } else {
            XB_SPIN(xb_ld(&bar[XB_XGEN(bx_)]) == gen, bar);
            __builtin_amdgcn_fence(__ATOMIC_ACQUIRE, "agent");
            asm volatile("s_waitcnt vmcnt(0)" ::: "memory");
        }
    }
    __syncthreads();
}

__device__ __forceinline__ float wave_sum(float v) {
#pragma unroll
    for (int o = 1; o < 64; o <<= 1) v += __shfl_xor(v, o);
    return v;
}
__device__ __forceinline__ void transpose_item(const float* W, int K, int N, bf16_t* WT, int k0, int n0, int drow0, const float* gain, LAS float* scr, int lane) {
    float tv[32];
#pragma unroll
    for (int i = 0; i < 32; ++i) tv[i] = ((const GAS float*)W)[(size_t)(k0 + 2 * i + (lane >> 5)) * N + n0 + (lane & 31)];
#pragma unroll
    for (int i = 0; i < 32; ++i) { const int kk = 2 * i + (lane >> 5); float v = tv[i]; if (gain) v *= ((const GAS float*)gain)[k0 + kk]; scr[kk * 33 + (lane & 31)] = v; }
    LDS_WAIT(); asm volatile("" ::: "memory");
    const int c = lane & 7;
#pragma unroll
    for (int j = 0; j < 4; ++j) { const int n = (lane >> 3) + 8 * j; const LAS float* s = scr + (8 * c) * 33 + n;
        u32x4 o; o.x = cvt_pk_bf16(s[0 * 33], s[1 * 33]); o.y = cvt_pk_bf16(s[2 * 33], s[3 * 33]); o.z = cvt_pk_bf16(s[4 * 33], s[5 * 33]); o.w = cvt_pk_bf16(s[6 * 33], s[7 * 33]);
        *(GAS u32x4*)(WT + pg8::paired_off(drow0 + n, k0 + 8 * c, K)) = o; }
    LDS_WAIT(); asm volatile("" ::: "memory");
}
__device__ __forceinline__ int win_row(int n) {
    if (n < D) return n;
    const int which = (n >= 2 * D) ? 1 : 0, cc = n - D - which * D;
    return D + (cc >> 5) * 64 + which * 32 + (cc & 31);
}
__device__ __forceinline__ float cas_pi(float t) { float s, c; sincospif(t, &s, &c); return c + s; }

__device__ __forceinline__ unsigned char* wsp(unsigned char* ws, size_t off) { asm volatile("" : "+s"(ws)); return ws + off; }

struct Ptrs {
    const float *x_prompt, *x_sample, *norm_mix, *a_w_in, *a_conv_w, *a_w_out, *f_w_out, *norm_ffn, *w_up, *w_down, *final_norm;
    float* out; unsigned char* ws;
};

__device__ __forceinline__ void prologue(const Ptrs& P, LAS unsigned char* lds, int gw, int NGW, int wave, int lane_) {
    int lane = lane_; asm volatile("" : "+v"(lane));
    LAS float* scr = (LAS float*)(lds + wave * 16384);
    bf16_t* WIN = (bf16_t*)(P.ws + WS_WIN); bf16_t* AWO = (bf16_t*)(P.ws + WS_AWO); bf16_t* FWO = (bf16_t*)(P.ws + WS_FWO);
    bf16_t* WUP = (bf16_t*)(P.ws + WS_WUP); bf16_t* WDN = (bf16_t*)(P.ws + WS_WDN);
    constexpr int I_IN = (D / 64) * (3 * D / 32), I_SQ = (D / 64) * (D / 32), I_UP = (D / 64) * (DFF / 32), I_DN = (DFF / 64) * (D / 32);
    constexpr int NITEMS = 2 * I_IN + 4 * I_SQ + 4 * I_UP + 4 * I_DN;
    for (int it = gw; it < NITEMS; it += NGW) {
        int r = it;
        if (r < 2 * I_IN) { const int j = r / I_IN; r -= j * I_IN; const int nblk = 3 * D / 32, kb = r / nblk, nb = r % nblk;
            transpose_item(P.a_w_in + (size_t)j * D * 3 * D, D, 3 * D, WIN + (size_t)j * 3 * D * D, 64 * kb, 32 * nb, win_row(32 * nb), P.norm_mix + (2 * j) * D, scr, lane); continue; }
        r -= 2 * I_IN;
        if (r < 2 * I_SQ) { const int j = r / I_SQ; r -= j * I_SQ; const int nblk = D / 32, kb = r / nblk, nb = r % nblk;
            transpose_item(P.a_w_out + (size_t)j * D * D, D, D, AWO + (size_t)j * D * D, 64 * kb, 32 * nb, 32 * nb, nullptr, scr, lane); continue; }
        r -= 2 * I_SQ;
        if (r < 2 * I_SQ) { const int j = r / I_SQ; r -= j * I_SQ; const int nblk = D / 32, kb = r / nblk, nb = r % nblk;
            transpose_item(P.f_w_out + (size_t)j * D * D, D, D, FWO + (size_t)j * D * D, 64 * kb, 32 * nb, 32 * nb, nullptr, scr, lane); continue; }
        r -= 2 * I_SQ;
        if (r < 4 * I_UP) { const int j = r / I_UP; r -= j * I_UP; const int nblk = DFF / 32, kb = r / nblk, nb = r % nblk;
            transpose_item(P.w_up + (size_t)j * D * DFF, D, DFF, WUP + (size_t)j * D * DFF, 64 * kb, 32 * nb, 32 * nb, P.norm_ffn + j * D, scr, lane); continue; }
        r -= 4 * I_UP;
        { const int j = r / I_DN; r -= j * I_DN; const int nblk = D / 32, kb = r / nblk, nb = r % nblk;
            transpose_item(P.w_down + (size_t)j * D * DFF, DFF, D, WDN + (size_t)j * D * DFF, 64 * kb, 32 * nb, 32 * nb, nullptr, scr, lane); }
    }
    const int gl = gw * 64 + lane, NGL = NGW * 64;
    for (int i = gl; i < 2 * NGRP * CG * CG / 8; i += NGL) { const int jl = i / (NGRP * CG * CG / 8), r = i % (NGRP * CG * CG / 8), g = r / (CG * CG / 8), q = r % (CG * CG / 8), c = q / (CG / 8), j0 = (q % (CG / 8)) * 8; float v[8];
        const GAS float* gn = (const GAS float*)P.norm_mix + (2 * jl + 1) * D + g * CG + j0;
#pragma unroll
        for (int e = 0; e < 8; ++e) v[e] = cas_pi(-(float)((c * (j0 + e)) & (CG - 1)) * (1.0f / 128.0f)) * gn[e];
        u32x4 o; o.x = cvt_pk_bf16(v[0], v[1]); o.y = cvt_pk_bf16(v[2], v[3]); o.z = cvt_pk_bf16(v[4], v[5]); o.w = cvt_pk_bf16(v[6], v[7]);
        *(GAS u32x4*)((bf16_t*)(P.ws + WS_PT) + (size_t)i * 8) = o; }
    for (int i = gl; i < SP * RAD; i += NGL) { const int k = i >> 3, s2 = i & 7; float s, c; sincospif((float)((k * s2) & (SP - 1)) * (1.0f / 8192.0f), &s, &c);
        ((GAS f32x2*)(P.ws + WS_TW))[i] = (f32x2){c, s}; }
    for (int i = gl; i < CG * CG / 8; i += NGL) { const int k = i / (CG / 8), s0 = (i % (CG / 8)) * 8; float v[8];
#pragma unroll
        for (int e = 0; e < 8; ++e) v[e] = cas_pi((float)((k * (s0 + e)) & (CG - 1)) * (1.0f / 128.0f));
        u32x4 o; o.x = cvt_pk_bf16(v[0], v[1]); o.y = cvt_pk_bf16(v[2], v[3]); o.z = cvt_pk_bf16(v[4], v[5]); o.w = cvt_pk_bf16(v[6], v[7]);
        *(GAS u32x4*)((bf16_t*)(P.ws + WS_H256) + (size_t)k * CG + s0) = o; }
    for (int i = gl; i < SS * RAD; i += NGL) { const int k = i >> 3, s2 = i & 7; float s, c; sincospif((float)((k * s2) & (SS - 1)) * (1.0f / 1024.0f), &s, &c);
        ((GAS f32x2*)(P.ws + WS_TW + 1 * MiB))[i] = (f32x2){c, s}; }
    for (int q = gw; q < M / 2; q += NGW) {
        const int m = (q >> 3) * 16 + (q & 7), hh = (lane >> 2) & 1, mr = m + 8 * hh;
        const GAS f32x4* xr = (const GAS f32x4*)(mr < MP ? P.x_prompt + (size_t)mr * D : P.x_sample + (size_t)(mr - MP) * D) + (lane >> 3) * 8 + (lane & 3) * 2;
        f32x4 v[8][2]; float s = 0.f;
#pragma unroll
        for (int j = 0; j < 8; ++j) { v[j][0] = xr[64 * j]; v[j][1] = xr[64 * j + 1]; }
        GAS u32x4* o16 = (GAS u32x4*)((bf16_t*)(P.ws + WS_B1) + pg8::paired_off(m, 0, D)) + lane;
#pragma unroll
        for (int j = 0; j < 8; ++j) { u32x4 w; w[0] = cvt_pk_bf16(v[j][0].x, v[j][0].y); w[1] = cvt_pk_bf16(v[j][0].z, v[j][0].w); w[2] = cvt_pk_bf16(v[j][1].x, v[j][1].y); w[3] = cvt_pk_bf16(v[j][1].z, v[j][1].w); o16[64 * j] = w;
#pragma unroll
            for (int e = 0; e < 4; ++e) { const float y0 = bf_lo(w[e]), y1 = bf_hi(w[e]); s += y0 * y0 + y1 * y1; } }
        s += __shfl_xor(s, 1); s += __shfl_xor(s, 2); s += __shfl_xor(s, 8); s += __shfl_xor(s, 16); s += __shfl_xor(s, 32);
        if ((lane & ~4) == 0) ((GAS u64*)(P.ws + WS_RS))[mr] = pg8::rs_fix(s);
    }
}

__device__ __forceinline__ void final_norm_phase(const bf16_t* xs, float* out, const u64* RS, const float* gain, int gw, int NGW, int lane_) {
    int lane = lane_; asm volatile("" : "+v"(lane));
    const int col4 = (lane >> 3) * 8 + (lane & 3) * 2, hh = (lane >> 2) & 1;
    f32x4 gv[8][2];
#pragma unroll
    for (int j = 0; j < 8; ++j) { gv[j][0] = ((const GAS f32x4*)gain)[col4 + 64 * j]; gv[j][1] = ((const GAS f32x4*)gain)[col4 + 64 * j + 1]; }
    for (int q = gw; q < M / 2; q += NGW) {
        const int m = (q >> 3) * 16 + (q & 7), mr = m + 8 * hh;
        const GAS u32x4* xr = (const GAS u32x4*)(xs + pg8::paired_off(m, 0, D)) + lane;
        GAS f32x4* orow = (GAS f32x4*)(out + (size_t)mr * D) + col4;
        const float rstd = pg8::row_rstd(RS + mr);
        u32x4 v[8];
#pragma unroll
        for (int j = 0; j < 8; ++j) v[j] = xr[64 * j];
#pragma unroll
        for (int j = 0; j < 8; ++j) { f32x4 y0, y1; y0.x = bf_lo(v[j][0]); y0.y = bf_hi(v[j][0]); y0.z = bf_lo(v[j][1]); y0.w = bf_hi(v[j][1]); y1.x = bf_lo(v[j][2]); y1.y = bf_hi(v[j][2]); y1.z = bf_lo(v[j][3]); y1.w = bf_hi(v[j][3]);
            orow[64 * j] = y0 * rstd * gv[j][0]; orow[64 * j + 1] = y1 * rstd * gv[j][1]; }
    }
}
__device__ __forceinline__ void conv_phase(const bf16_t* Bb, const bf16_t* Ub, const float* cw, const u64* RS, bf16_t* Gb, int gw, int NGW, int lane_) {
    int lane = lane_; asm volatile("" : "+v"(lane));
    for (int chunk = gw; chunk < M / 8; chunk += NGW) {
        const int m0 = chunk * 8;
        const bool first = (m0 == 0) || (m0 >= MP && ((m0 - MP) & (SS - 1)) == 0);
        const bool last = (m0 + 8 == MP) || (m0 >= MP && ((m0 + 8 - MP) & (SS - 1)) == 0);
        float rr[10];
#pragma unroll
        for (int q = 0; q < 10; ++q) { const bool ok = !((q == 0 && first) || (q == 9 && last)); rr[q] = ok ? pg8::row_rstd(RS + (m0 - 1 + q)) : 0.f; }
#pragma unroll 1
        for (int j = 0; j < 4; ++j) {
            const int ch0 = (lane + 64 * j) * 8;
            float w0[8], w1[8], w2[8];
#pragma unroll
            for (int h = 0; h < 2; ++h) { const f32x4 a = *(const GAS f32x4*)(cw + ch0 + 4 * h), b = *(const GAS f32x4*)(cw + D + ch0 + 4 * h), c = *(const GAS f32x4*)(cw + 2 * D + ch0 + 4 * h);
#pragma unroll
                for (int e = 0; e < 4; ++e) { w0[4 * h + e] = a[e]; w1[4 * h + e] = b[e]; w2[4 * h + e] = c[e]; } }
            const GAS u32x4* up = (const GAS u32x4*)(Ub + (size_t)m0 * D + ch0);
            const GAS u32x4* bp = (const GAS u32x4*)(Bb + (size_t)m0 * D + ch0);
            GAS u32x4* gp = (GAS u32x4*)(Gb + (size_t)m0 * D + ch0);
            u32x4 uu[10], bb[8];
#pragma unroll
            for (int q = 0; q < 10; ++q) { const bool ok = !((q == 0 && first) || (q == 9 && last)); uu[q] = (u32x4){0u, 0u, 0u, 0u}; if (ok) uu[q] = *(up + (ptrdiff_t)(q - 1) * (D / 8)); }
#pragma unroll
            for (int r = 0; r < 8; ++r) bb[r] = bp[(size_t)r * (D / 8)];
#pragma unroll
            for (int r = 0; r < 8; ++r) {
                const float rp = rr[r] * rr[r], rc = rr[r + 1] * rr[r + 1], rn = rr[r + 2] * rr[r + 2], rb = rr[r + 1];
                float o[8];
#pragma unroll
                for (int e = 0; e < 8; ++e) o[e] = rb * bf_at(bb[r], e) * (w0[e] * rp * bf_at(uu[r], e) + w1[e] * rc * bf_at(uu[r + 1], e) + w2[e] * rn * bf_at(uu[r + 2], e));
                u32x4 w; w.x = cvt_pk_bf16(o[0], o[1]); w.y = cvt_pk_bf16(o[2], o[3]); w.z = cvt_pk_bf16(o[4], o[5]); w.w = cvt_pk_bf16(o[6], o[7]);
                gp[(size_t)r * (D / 8)] = w;
            }
        }
    }
}
__device__ __forceinline__ void load_rev(const GAS bf16_t* rowp, int g0, int c0, float (&r)[8]) {
    const u32x4 A = *(const GAS u32x4*)(rowp + g0 + ((248 - c0) & 255)), Bv = *(const GAS u32x4*)(rowp + g0 + ((256 - c0) & 255));
    r[0] = bf_at(Bv, 0);
#pragma unroll
    for (int i = 1; i < 8; ++i) r[i] = bf_at(A, 8 - i);
}
__device__ __forceinline__ void post_phase(int mode, const bf16_t* UP, const bf16_t* US, const f32x2* TWP, const f32x2* TWS, bf16_t* MXP, bf16_t* MXS, const bf16_t* HP256, bf16_t* H2048, int gw, int NGW, int lane_) {
    int lane = lane_; asm volatile("" : "+v"(lane));
    const float SC_S = 0.5f / sqrtf((float)SS * (float)CG), SC_P = 0.5f / sqrtf((float)SP * (float)CG);
    for (int it = gw + (mode == 1 ? SS : 0); it < (mode == 1 ? SS + NB * CG : SS); it += NGW) {
        const bool pr = it < SS;
        const int L = pr ? SS : CG, b = pr ? 0 : (it - SS) >> 8, k1 = pr ? it : (it - SS) & (CG - 1), nk1 = (L - k1) & (L - 1);
        const GAS bf16_t* H = pr ? (const GAS bf16_t*)UP : (const GAS bf16_t*)US + (size_t)b * SS * D;
        GAS bf16_t* O = pr ? (GAS bf16_t*)MXP : (GAS bf16_t*)MXS + (size_t)(MP + b * SS) * D;
        const f32x2* TW = pr ? TWP : TWS; const float sc = pr ? SC_P : SC_S;
        f32x2 st[8];
#pragma unroll
        for (int k2 = 0; k2 < 8; ++k2) st[k2] = TW[(size_t)(k1 + L * k2) * RAD + 1];
#pragma unroll 1
        for (int j = 0; j < 4; ++j) { const int ch0 = (lane + 64 * j) * 8, g0 = ch0 & ~255, c0 = ch0 & 255;
            const int ra = g0 + ((248 - c0) & 255), rb = g0 + ((256 - c0) & 255);
            f32x2 acc[8][4], cw[8];
#pragma unroll
            for (int a = 0; a < 8; ++a) { cw[a] = (f32x2){1.f, 0.f};
#pragma unroll
                for (int e = 0; e < 4; ++e) acc[a][e] = (f32x2){0.f, 0.f}; }
#pragma unroll 1
            for (int hf = 0; hf < 4; ++hf) {
                u32x4 va[2], vp[2], nA[2], nB[2], kA[2], kB[2];
#pragma unroll
                for (int q = 0; q < 2; ++q) { const int s2 = hf * 2 + q;
                    const GAS bf16_t* rowk = H + ((size_t)s2 * L + k1) * D;
                    const GAS bf16_t* rown = H + ((size_t)s2 * L + nk1) * D;
                    va[q] = *(const GAS u32x4*)(rowk + ch0); vp[q] = *(const GAS u32x4*)(rown + ch0);
                    nA[q] = *(const GAS u32x4*)(rown + ra); nB[q] = *(const GAS u32x4*)(rown + rb);
                    kA[q] = *(const GAS u32x4*)(rowk + ra); kB[q] = *(const GAS u32x4*)(rowk + rb); }
#pragma unroll
                for (int q = 0; q < 2; ++q) {
                    float Ev[8], Ov[8];
                    Ev[0] = bf_at(va[q], 0) + bf_at(nB[q], 0); Ov[0] = bf_at(vp[q], 0) - bf_at(kB[q], 0);
#pragma unroll
                    for (int e = 1; e < 8; ++e) { Ev[e] = bf_at(va[q], e) + bf_at(nA[q], 8 - e); Ov[e] = bf_at(vp[q], e) - bf_at(kA[q], 8 - e); }
#pragma unroll
                    for (int k2 = 0; k2 < 8; ++k2) { const f32x2 cc = (f32x2){cw[k2].x, cw[k2].x}, ss = (f32x2){cw[k2].y, cw[k2].y};
#pragma unroll
                        for (int e = 0; e < 4; ++e) { acc[k2][e] = __builtin_elementwise_fma((f32x2){Ev[2 * e], Ev[2 * e + 1]}, cc, acc[k2][e]);
                                                      acc[k2][e] = __builtin_elementwise_fma((f32x2){Ov[2 * e], Ov[2 * e + 1]}, ss, acc[k2][e]); }
                        const float nc = cw[k2].x * st[k2].x - cw[k2].y * st[k2].y, ns = cw[k2].y * st[k2].x + cw[k2].x * st[k2].y; cw[k2] = (f32x2){nc, ns}; }
                }
            }
#pragma unroll
            for (int k2 = 0; k2 < 8; ++k2) { u32x4 w;
                w.x = cvt_pk_bf16(acc[k2][0].x * sc, acc[k2][0].y * sc); w.y = cvt_pk_bf16(acc[k2][1].x * sc, acc[k2][1].y * sc);
                w.z = cvt_pk_bf16(acc[k2][2].x * sc, acc[k2][2].y * sc); w.w = cvt_pk_bf16(acc[k2][3].x * sc, acc[k2][3].y * sc);
                *(GAS u32x4*)(O + (size_t)(k1 + L * k2) * D + ch0) = w; }
        }
    }
    if (mode == 1) {
        for (int it = gw; it < RAD * CG; it += NGW) {
            const int t = it >> 8, k1 = it & (CG - 1), nk1 = (CG - k1) & (CG - 1);
            f32x2 st[8];
#pragma unroll
            for (int k2 = 0; k2 < 8; ++k2) st[k2] = TWS[(size_t)(k1 + CG * k2) * RAD + 1];
#pragma unroll 1
            for (int j = 0; j < 4; ++j) { const int ch0 = (lane + 64 * j) * 8;
                f32x2 acc[8][4], cw[8];
#pragma unroll
                for (int a = 0; a < 8; ++a) { cw[a] = (f32x2){1.f, 0.f};
#pragma unroll
                    for (int e = 0; e < 4; ++e) acc[a][e] = (f32x2){0.f, 0.f}; }
#pragma unroll 1
                for (int hf = 0; hf < 2; ++hf) {
                    u32x4 va[4], vp[4];
#pragma unroll
                    for (int q = 0; q < 4; ++q) { const int s2 = t + 8 * (hf * 4 + q);
                        va[q] = *(const GAS u32x4*)((const GAS bf16_t*)HP256 + ((size_t)s2 * CG + k1) * D + ch0);
                        vp[q] = *(const GAS u32x4*)((const GAS bf16_t*)HP256 + ((size_t)s2 * CG + nk1) * D + ch0); }
#pragma unroll
                    for (int q = 0; q < 4; ++q) {
#pragma unroll
                        for (int k2 = 0; k2 < 8; ++k2) { const f32x2 cc = (f32x2){cw[k2].x, cw[k2].x}, ss = (f32x2){cw[k2].y, cw[k2].y};
#pragma unroll
                            for (int e = 0; e < 4; ++e) { acc[k2][e] = __builtin_elementwise_fma((f32x2){bf_at(va[q], 2 * e), bf_at(va[q], 2 * e + 1)}, cc, acc[k2][e]);
                                                          acc[k2][e] = __builtin_elementwise_fma((f32x2){bf_at(vp[q], 2 * e), bf_at(vp[q], 2 * e + 1)}, ss, acc[k2][e]); }
                            const float nc = cw[k2].x * st[k2].x - cw[k2].y * st[k2].y, ns = cw[k2].y * st[k2].x + cw[k2].x * st[k2].y; cw[k2] = (f32x2){nc, ns}; }
                    }
                }
#pragma unroll
                for (int k2 = 0; k2 < 8; ++k2) { u32x4 w;
                    w.x = cvt_pk_bf16(acc[k2][0].x, acc[k2][0].y); w.y = cvt_pk_bf16(acc[k2][1].x, acc[k2][1].y);
                    w.z = cvt_pk_bf16(acc[k2][2].x, acc[k2][2].y); w.w = cvt_pk_bf16(acc[k2][3].x, acc[k2][3].y);
                    *(GAS u32x4*)((GAS bf16_t*)H2048 + ((size_t)t * SS + k1 + CG * k2) * D + ch0) = w; }
            }
        }
    }
}

#define TIC() do { if (PROBE_CAT) pt0 = __builtin_amdgcn_s_memrealtime(); } while (0)
#define TOC(cat) do { if (PROBE_CAT == (cat)) pacc += __builtin_amdgcn_s_memrealtime() - pt0; } while (0)
#define GRID_BAR() do { TIC(); xcd_barrier(bar); TOC(2); } while (0)
__global__ void __launch_bounds__(NWAVES * 64, 2) fwd_kernel(Ptrs P) {
    extern __shared__ __attribute__((aligned(16))) unsigned char lds_raw[];
    LAS unsigned char* lds = (LAS unsigned char*)lds_raw;
    const int tid = threadIdx.x, lane = tid & 63, wave = __builtin_amdgcn_readfirstlane(tid >> 6);
    const int G = gridDim.x, bx = blockIdx.x;
    const int vcu = (G % 8 == 0) ? (bx % 8) * (G / 8) + bx / 8 : bx;
    const int gw = vcu * NWAVES + wave, NGW = G * NWAVES;
    for (int u = tid; u < (LDS_BYTES - LDSCTL_OFF) / 4; u += NWAVES * 64) ((LAS unsigned*)(lds + LDSCTL_OFF))[u] = 0u;
    __syncthreads();
    volatile LAS unsigned* MISC = (volatile LAS unsigned*)(lds + MISC_OFF);
    XcdBarrier bar = xcd_barrier_post((unsigned*)(P.ws + WS_CTL) + CW_BAR, MISC + 8);

#define WIN ((bf16_t*)wsp(P.ws, WS_WIN))
#define AWO ((bf16_t*)wsp(P.ws, WS_AWO))
#define FWO ((bf16_t*)wsp(P.ws, WS_FWO))
#define WUP ((bf16_t*)wsp(P.ws, WS_WUP))
#define WDN ((bf16_t*)wsp(P.ws, WS_WDN))
#define HART ((bf16_t*)wsp(P.ws, WS_HART))
#define PT ((bf16_t*)wsp(P.ws, WS_PT))
#define TW ((const f32x2*)wsp(P.ws, WS_TW))
#define TWS ((const f32x2*)wsp(P.ws, WS_TW + 1 * MiB))
#define H256 ((bf16_t*)wsp(P.ws, WS_H256))
#define B1 ((bf16_t*)wsp(P.ws, WS_B1))
#define B2 ((bf16_t*)wsp(P.ws, WS_B2))
#define B3 ((bf16_t*)wsp(P.ws, WS_B3))

    unsigned long long pacc = 0ull, pt0 = 0ull;
    TIC(); prologue(P, lds, gw, NGW, wave, lane); TOC(1);
    GRID_BAR();

#define PTG PT
#define RSB ((u64*)wsp(P.ws, WS_RS))
#define XS B1
#pragma unroll 1
    for (int layer = 0; layer < 4; ++layer) {
        const int j = layer >> 1;
        u64* RS0 = RSB + (size_t)(2 * layer) * (RS_STRIDE / 8);
        u64* RS1 = RS0 + RS_STRIDE / 8;
        u64* RS2 = RS1 + RS_STRIDE / 8;
        if ((layer & 1) == 0) {
            {
                pg8::DescPlain g{XS, WIN + (size_t)j * 3 * D * D, D, D, D}; pg8::StaticOrder S; S.init(M, 3 * D, G, bx, 4, 1);
                pg8::EpiGate E{B2, B3};
                pg8::gemm_phase<pg8::DescPlain, pg8::EpiGate, true, true>(lds, g, S, E, pacc);
            }
            GRID_BAR();
            TIC(); conv_phase(B2, B3, P.a_conv_w + (size_t)j * 3 * D, RS0, B2, gw, NGW, lane); TOC(1);
            GRID_BAR();
        } else {
            bf16_t* VTS = B2 + (size_t)RAD * D * SS; bf16_t* USM = B3 + (size_t)RAD * SS * D;
#pragma unroll 1
            for (int pr = 1; pr >= 0; --pr) {
                pg8::DescF0 g{PTG + (size_t)j * NGRP * CG * CG, pr ? XS : XS + (size_t)MP * D, CG, CG, pr ? 64 * D : 8 * D, pr}; pg8::StaticOrder S; S.init(D, pr ? MP : MS, G, bx);
                pg8::EpiBf16<2> E{pr ? B2 : VTS, CG, RS0, pr, nullptr, 0};
                pg8::gemm_phase<pg8::DescF0, pg8::EpiBf16<2>, true, true>(lds, g, S, E, pacc);
            }
            GRID_BAR();
            {
                pg8::DescF2 g{H256, B2, CG, CG, CG, 0, 0}; pg8::StaticOrder S; S.init(M, D, G, bx);
                pg8::EpiBf16<0> E{B3, D, nullptr, 0, nullptr, 0};
                pg8::gemm_phase<pg8::DescF2, pg8::EpiBf16<0>, true, true>(lds, g, S, E, pacc);
            }
            GRID_BAR();
#pragma unroll 1
            for (int mode = 1; mode <= 2; ++mode) {
                TIC(); post_phase(mode, B2, USM, TW, TWS, B3, B2, B3, B2, gw, NGW, lane); TOC(1);
                GRID_BAR();
            }
        }
        {
            pg8::DescSplit g{(layer & 1) ? B3 : B2, B2 + (size_t)MP * D, MP / BMT, ((layer & 1) == 0 ? AWO : FWO) + (size_t)j * D * D, D, D, D, 0}; pg8::StaticOrder S; S.init(M, D, G, bx, 4);
            pg8::EpiRes<false> E{XS, RS1, 0, nullptr};
            pg8::gemm_phase<pg8::DescSplit, pg8::EpiRes<false>, true, true>(lds, g, S, E, pacc);
        }
        GRID_BAR();
        {
            pg8::DescPlain g{XS, WUP + (size_t)layer * D * DFF, D, D, D}; pg8::StaticOrder S; S.init(M, DFF, G, bx, 4, 1);
            pg8::EpiBf16<1> E{B2, DFF, nullptr, 0, (bf16_t*)P.out, MCH / BMT};
            pg8::gemm_phase<pg8::DescPlain, pg8::EpiBf16<1>, true, true>(lds, g, S, E, pacc);
        }
        GRID_BAR();
        {
            pg8::DescSplit g{B2, (const bf16_t*)P.out, MCH / BMT, WDN + (size_t)layer * D * DFF, DFF, DFF, DFF, 1}; pg8::StaticOrder S; S.init(M, D, G, bx, 4);
            pg8::EpiRes<true> E{XS, RS2, 0, RS1};
            pg8::gemm_phase<pg8::DescSplit, pg8::EpiRes<true>, true, true>(lds, g, S, E, pacc);
        }
        GRID_BAR();
    }
    TIC(); final_norm_phase(XS, P.out, RSB + (size_t)8 * (RS_STRIDE / 8), P.final_norm, gw, NGW, lane); TOC(1);
    if (PROBE_CAT && bx == 0 && wave == 0) { const unsigned long long te = __builtin_amdgcn_s_memrealtime() + PROBE_ALPHA * pacc; while (__builtin_amdgcn_s_memrealtime() < te) __builtin_amdgcn_s_sleep(8); }
}

#undef WIN
#undef AWO
#undef FWO
#undef WUP
#undef WDN
#undef HART
#undef PT
#undef TW
#undef TWS
#undef H256
#undef B1
#undef B2
#undef B3
#undef PTG
#undef RSB
#undef XS
extern "C" void kernel_launch(void* const* d_in, const int* in_sizes, int n_in, void* d_out, int out_size, void* d_ws, size_t ws_size, hipStream_t stream) {
    static int grid = 0;
    if (grid == 0) {
        if (n_in != 11 || out_size != M * D || ws_size < WS_END) { fprintf(stderr, "kernel_launch: unexpected shapes (n_in %d, out %d, ws %zu)\n", n_in, out_size, ws_size); grid = -1; return; }
        int dev = 0, cus = 0, per_cu = 0;
        if (hipGetDevice(&dev) != hipSuccess || hipDeviceGetAttribute(&cus, hipDeviceAttributeMultiprocessorCount, dev) != hipSuccess) { grid = -1; return; }
        if (hipFuncSetAttribute((const void*)fwd_kernel, hipFuncAttributeMaxDynamicSharedMemorySize, LDS_BYTES) != hipSuccess) { fprintf(stderr, "kernel_launch: hipFuncSetAttribute failed\n"); grid = -1; return; }
        if (hipOccupancyMaxActiveBlocksPerMultiprocessor(&per_cu, (const void*)fwd_kernel, NWAVES * 64, LDS_BYTES) != hipSuccess || per_cu < 1)
            fprintf(stderr, "kernel_launch: occupancy query reports %d workgroups per CU\n", per_cu);
        (void)hipGetLastError();
        grid = cus;
    }
    if (grid < 0) return;
    if (hipMemsetAsync((char*)d_ws + WS_CTL, 0, CTL_ZERO_BYTES, stream) != hipSuccess) return;
    Ptrs p{};
    p.x_prompt = (const float*)d_in[0]; p.x_sample = (const float*)d_in[1]; p.norm_mix = (const float*)d_in[2]; p.a_w_in = (const float*)d_in[3];
    p.a_conv_w = (const float*)d_in[4]; p.a_w_out = (const float*)d_in[5]; p.f_w_out = (const float*)d_in[6]; p.norm_ffn = (const float*)d_in[7];
    p.w_up = (const float*)d_in[8]; p.w_down = (const float*)d_in[9]; p.final_norm = (const float*)d_in[10];
    p.out = (float*)d_out; p.ws = (unsigned char*)d_ws;
    hipLaunchKernelGGL(fwd_kernel, dim3(grid), dim3(NWAVES * 64), LDS_BYTES, stream, p);
    const hipError_t le = hipPeekAtLastError();
    if (le != hipSuccess) fprintf(stderr, "kernel_launch: launch failed: %s\n", hipGetErrorName(le));
    (void)in_sizes;
}
```

```cpp
#include <hip/hip_runtime.h>
#include <cstdio>
#include <cstdint>

#ifndef PROBE_CAT
#define PROBE_CAT 0
#endif
#define PROBE_ALPHA 4
#define LAS __attribute__((address_space(3)))
#define GAS __attribute__((address_space(1)))
typedef unsigned short bf16_t;
typedef short bf16x8 __attribute__((ext_vector_type(8)));
typedef float f32x4 __attribute__((ext_vector_type(4)));
typedef float f32x2 __attribute__((ext_vector_type(2)));
typedef unsigned u32x4 __attribute__((ext_vector_type(4)));
typedef unsigned u32x2 __attribute__((ext_vector_type(2)));
typedef GAS unsigned gu32;
typedef unsigned long long u64;

constexpr int D = 2048, DFF = 8192, SP = 16384, SS = 2048, NB = 16;
constexpr int MP = SP, MS = NB * SS, M = MP + MS;
constexpr int CG = 256, NGRP = 8, RAD = SP / SS;
constexpr int NSEQ = RAD + NB;
constexpr int MCH = M / 2, BMT = 256;
constexpr float RMS_EPS = 1e-6f;

constexpr size_t MiB = 1u << 20;
constexpr size_t WS_CTL = 0, CTL_ZERO_BYTES = 5 * MiB;
constexpr size_t WS_RS = 1 * MiB, RS_STRIDE = 384 * 1024;
constexpr size_t WS_WIN = 5 * MiB;
constexpr size_t WS_AWO = WS_WIN + 48 * MiB;
constexpr size_t WS_FWO = WS_AWO + 16 * MiB;
constexpr size_t WS_WUP = WS_FWO + 16 * MiB;
constexpr size_t WS_WDN = WS_WUP + 128 * MiB;
constexpr size_t WS_HART = WS_WDN + 128 * MiB;
constexpr size_t WS_PT = WS_HART + 8 * MiB;
constexpr size_t WS_TW = WS_PT + 2 * MiB;
constexpr size_t WS_H256 = WS_TW + 2 * MiB;
constexpr size_t WS_B1 = WS_H256 + 1 * MiB;
constexpr size_t WS_B2 = WS_B1 + 192 * MiB;
constexpr size_t WS_B3 = WS_B2 + 192 * MiB;
constexpr size_t WS_END = WS_B3 + 192 * MiB;
static_assert((size_t)M * D * 2 == 192 * MiB && (size_t)MCH * DFF * 2 == 384 * MiB && (size_t)M * 8 == RS_STRIDE && WS_RS + 9 * RS_STRIDE <= CTL_ZERO_BYTES, "buffer sizes");
constexpr int CW_BAR = 4096;

constexpr int RING_BYTES = 131072, LDSCTL_OFF = RING_BYTES, MISC_OFF = LDSCTL_OFF + 320, LDS_BYTES = 147456;
constexpr int NWAVES = 8;

__device__ __forceinline__ unsigned cvt_pk_bf16(float lo, float hi) { unsigned r; asm("v_cvt_pk_bf16_f32 %0, %1, %2" : "=v"(r) : "v"(lo), "v"(hi)); return r; }
__device__ __forceinline__ float bf_lo(unsigned w) { return __builtin_bit_cast(float, w << 16); }
__device__ __forceinline__ float bf_hi(unsigned w) { return __builtin_bit_cast(float, w & 0xffff0000u); }
typedef float f32x2 __attribute__((ext_vector_type(2)));
__device__ __forceinline__ float dot2_bf16(unsigned a, unsigned b, float c) { typedef __bf16 bf2 __attribute__((ext_vector_type(2))); return __builtin_amdgcn_fdot2_f32_bf16(__builtin_bit_cast(bf2, a), __builtin_bit_cast(bf2, b), c, false); }
__device__ __forceinline__ float relu1(float x) { float r; asm("v_max_f32 %0, 0, %1" : "=v"(r) : "v"(x)); return r; }
__device__ __forceinline__ float bf_at(const u32x4& v, int i) { const unsigned w = v[i >> 1]; return (i & 1) ? bf_hi(w) : bf_lo(w); }
#define LDS_WAIT() asm volatile("s_waitcnt lgkmcnt(0)" ::: "memory")

namespace pg8 {
constexpr int BM = 256, BK = 64, HALF = 128, HTB = HALF * BK * 2, STAGE_BYTES = 8 * HTB, NXCD = 8, WGM = 8;
__host__ __device__ __forceinline__ int lds_byte(int r, int c) { const int st = (r >> 4) * 2 + (c >> 5), rr = r & 15, cc = c & 31, ob = rr * 64 + cc * 2; return st * 1024 + (ob ^ (((ob >> 9) & 1) << 5)); }
__host__ __device__ __forceinline__ void stage_rc(int b, int& R, int& C) { const int st = b / 1024, sb = b % 1024, swz = sb ^ (((sb >> 9) & 1) << 5); R = (st >> 1) * 16 + swz / 64; C = (st & 1) * 32 + (swz % 64) / 2; }
__host__ __device__ __forceinline__ int perm32(int rho) { const int n = rho >> 4, i = rho & 15; return 8 * (i >> 2) + 4 * n + (i & 3); }

__host__ __device__ __forceinline__ size_t paired_off(int row, int k, int K) { return (size_t)(row >> 4) * 16 * K + (size_t)((row & 7) * (K >> 5) + (k >> 5)) * 64 + ((row >> 3) & 1) * 32 + (k & 31); }
struct Unit { int pm, pn; };
struct StaticOrder {
    int nM, nN, nwg, G, c, wgm, rev;
    __device__ __forceinline__ void init(int M_, int N_, int G_, int c_, int wgm_ = WGM, int rev_ = 0) { nM = M_ / BM; nN = N_ / BM; nwg = nM * nN; G = G_; c = c_; wgm = wgm_; rev = (rev_ && nwg % G_ == 0) ? 1 : 0; }
    __device__ __forceinline__ bool next(int i, Unit& u) const {
        if (i * G >= nwg) return false;
        const long L = (long)(rev ? nwg / G - 1 - i : i) * G + c; if (L >= nwg) return false;
        int wgid = (int)L; { const int q = nwg / NXCD, r = nwg % NXCD, xcd = wgid % NXCD, off = wgid / NXCD; wgid = (xcd < r ? xcd * (q + 1) : r * (q + 1) + (xcd - r) * q) + off; }
        const int nig = wgm * nN, gid = wgid / nig, fm = gid * wgm, gsz = (nM - fm) < wgm ? (nM - fm) : wgm;
        u.pm = fm + ((wgid % nig) % gsz); u.pn = (wgid % nig) / gsz; return true;
    }
};
struct DescPlain { const bf16_t* A; const bf16_t* Bt; int K, lda, ldb;
    __device__ __forceinline__ unsigned voffa(int R, int C) const { return (unsigned)paired_off(R, C, lda) * 2u; }
    __device__ __forceinline__ unsigned voffb(int Rb, int C) const { return (unsigned)paired_off(Rb, C, ldb) * 2u; }
    __device__ __forceinline__ size_t kstepa() const { return 4 * BK; }
    __device__ __forceinline__ size_t hstepa() const { return (size_t)HALF * lda * 2; }
    __device__ __forceinline__ size_t kstepb() const { return 4 * BK; }
    __device__ __forceinline__ const char* abase(const Unit& u) const { return (const char*)A + (size_t)u.pm * BM * lda * 2; }
    __device__ __forceinline__ const char* bbase(const Unit& u) const { return (const char*)Bt + (size_t)u.pn * BM * ldb * 2; } };
struct DescSplit { const bf16_t* A; const bf16_t* Ahi; int msplit; const bf16_t* Bt; int K, lda, ldb, ap;
    __device__ __forceinline__ unsigned voffa(int R, int C) const { return ap ? (unsigned)(((R >> 4) * 2 + (C >> 5)) * 1024 + (R & 7) * 128 + ((R >> 3) & 1) * 64 + (C & 31) * 2) : (unsigned)(R * lda + C) * 2u; }
    __device__ __forceinline__ size_t hstepa() const { return ap ? (size_t)16384 : (size_t)HALF * lda * 2; }
    __device__ __forceinline__ unsigned voffb(int Rb, int C) const { return (unsigned)paired_off(Rb, C, ldb) * 2u; }
    __device__ __forceinline__ size_t kstepa() const { return ap ? 32768 : 2 * BK; }
    __device__ __forceinline__ size_t kstepb() const { return 4 * BK; }
    __device__ __forceinline__ const char* abase(const Unit& u) const { return u.pm < msplit ? (const char*)A + (size_t)u.pm * BM * lda * 2 : (const char*)Ahi + (size_t)(u.pm - msplit) * BM * lda * 2; }
    __device__ __forceinline__ const char* bbase(const Unit& u) const { return (const char*)Bt + (size_t)u.pn * BM * ldb * 2; } };
struct DescF0 { const bf16_t* A; const bf16_t* Bt; int K, lda, ldb, prompt;
    __device__ __forceinline__ const char* abase(const Unit& u) const { return (const char*)A + (size_t)u.pm * CG * CG * 2; }
    __device__ __forceinline__ const char* bbase(const Unit& u) const {
        const int row0 = prompt ? u.pn : (u.pn >> 3) * SS + (u.pn & 7);
        return (const char*)Bt + paired_off(row0, u.pm * CG, D) * 2; }
    __device__ __forceinline__ unsigned voffa(int R, int C) const { return (unsigned)(R * lda + C) * 2u; }
    __device__ __forceinline__ unsigned voffb(int Rb, int C) const {
        const unsigned rp = prompt ? (unsigned)Rb * 64u * D : (unsigned)(Rb >> 1) * 16u * D + (unsigned)(Rb & 1) * 32u;
        return (rp + (unsigned)((C >> 5) * 64 + (C & 31))) * 2u; }
    __device__ __forceinline__ size_t kstepa() const { return 2 * BK; }
    __device__ __forceinline__ size_t hstepa() const { return (size_t)HALF * lda * 2; }
    __device__ __forceinline__ size_t kstepb() const { return 4 * BK; } };
struct DescF2 { const bf16_t* A; const bf16_t* Bt; int K, lda, ldb, amask, ashift;
    __device__ __forceinline__ unsigned voffa(int R, int C) const { return (unsigned)(R * lda + C) * 2u; }
    __device__ __forceinline__ unsigned voffb(int Rb, int C) const { return (unsigned)(Rb * ldb + C) * 2u; }
    __device__ __forceinline__ size_t kstepa() const { return 2 * BK; }
    __device__ __forceinline__ size_t hstepa() const { return (size_t)HALF * lda * 2; }
    __device__ __forceinline__ size_t kstepb() const { return 2 * BK; }
    __device__ __forceinline__ const char* abase(const Unit& u) const { return (const char*)A + (size_t)(u.pm & amask) * BM * lda * 2; }
    __device__ __forceinline__ const char* bbase(const Unit& u) const { return (const char*)Bt + ((size_t)(u.pm >> ashift) * D + (size_t)u.pn * BM) * ldb * 2; } };

__device__ __forceinline__ float rstd_of(float ss) { return 1.0f / sqrtf(ss * (1.0f / D) + RMS_EPS); }
constexpr float RS_FIX = 1048576.0f;
__device__ __forceinline__ u64 rs_fix(float s) { return (u64)(s * RS_FIX); }
__device__ __forceinline__ float row_rstd(const u64* p) { return rstd_of((float)__hip_atomic_load((GAS u64*)p, __ATOMIC_RELAXED, __HIP_MEMORY_SCOPE_AGENT) * (1.0f / RS_FIX)); }
__device__ __forceinline__ unsigned dpp_ror8(unsigned old, unsigned src, int bank_mask) {
    return bank_mask == 0xC ? (unsigned)__builtin_amdgcn_update_dpp((int)old, (int)src, 0x128, 0xf, 0xC, false) : (unsigned)__builtin_amdgcn_update_dpp((int)old, (int)src, 0x128, 0xf, 0x3, false); }
__device__ __forceinline__ void widen(const u32x4& own0, const u32x4& own1, u32x4& r1, u32x4& r2) {
#pragma unroll
    for (int e = 0; e < 4; ++e) { r1[e] = dpp_ror8(own0[e], own1[e], 0xC); r2[e] = dpp_ror8(own1[e], own0[e], 0x3); }
}
template <bool SCALE> struct EpiRes {
    static constexpr bool PERM = true;
    bf16_t* XS; u64* RS; int row0; const u64* RSin;
    __device__ __forceinline__ void operator()(const f32x4 (&acc)[2][2][4][2], const Unit& u, int wr, int wc, int fr, int fq) const {
        const int rt = row0 + u.pm * BM;
        GAS char* ub = (GAS char*)XS + (size_t)rt * D * 2 + (size_t)(8 * u.pn + 2 * wc) * 128 + (size_t)wr * 64 * D * 2;
        const unsigned lp = (unsigned)((fr & 7) * (D >> 5) * 64 + (fr >> 3) * 32 + 8 * fq) * 2u;
        u32x4 xv[2][4][2];
#pragma unroll
        for (int ai = 0; ai < 2; ++ai)
#pragma unroll
            for (int m = 0; m < 4; ++m) { const GAS char* rb = ub + (size_t)(ai * HALF + m * 16) * D * 2;
#pragma unroll
                for (int h = 0; h < 2; ++h) xv[ai][m][h] = *(const GAS u32x4*)(rb + lp + h * 128); }
        float rsc[2][4];
#pragma unroll
        for (int ai = 0; ai < 2; ++ai)
#pragma unroll
            for (int m = 0; m < 4; ++m) { rsc[ai][m] = 1.f;
                if (SCALE) { const float r = row_rstd(RSin + (rt + ai * HALF + wr * 64 + m * 16 + fr)); rsc[ai][m] = r * r; } }
#pragma unroll
        for (int ai = 0; ai < 2; ++ai)
#pragma unroll
            for (int m = 0; m < 4; ++m) { GAS char* rb = ub + (size_t)(ai * HALF + m * 16) * D * 2;
                const float sc = rsc[ai][m];
                float s = 0.f, s1 = 0.f;
                u32x4 w[2];
                const f32x2 sc2 = (f32x2){sc, sc};
#pragma unroll
                for (int bj = 0; bj < 2; ++bj) {
#pragma unroll
                    for (int n = 0; n < 2; ++n) { const f32x4 a = acc[ai][bj][m][n]; const unsigned x0 = xv[ai][m][bj][2 * n], x1 = xv[ai][m][bj][2 * n + 1];
                        f32x2 p0 = (f32x2){bf_lo(x0), bf_hi(x0)}, p1 = (f32x2){bf_lo(x1), bf_hi(x1)};
                        const f32x2 a0 = (f32x2){a[0], a[1]}, a1 = (f32x2){a[2], a[3]};
                        if (SCALE) { p0 = __builtin_elementwise_fma(a0, sc2, p0); p1 = __builtin_elementwise_fma(a1, sc2, p1); } else { p0 += a0; p1 += a1; }
                        const unsigned w0 = cvt_pk_bf16(p0[0], p0[1]), w1 = cvt_pk_bf16(p1[0], p1[1]);
                        w[bj][2 * n] = w0; w[bj][2 * n + 1] = w1;
                        s = dot2_bf16(w0, w0, s); s1 = dot2_bf16(w1, w1, s1); } }
                s += s1;
                *(GAS u32x4*)(rb + lp) = w[0]; *(GAS u32x4*)(rb + lp + 128) = w[1];
                s += __shfl_xor(s, 16); s += __shfl_xor(s, 32);
                if (fq == 0) __hip_atomic_fetch_add((GAS u64*)RS + (rt + ai * HALF + wr * 64 + m * 16 + fr), rs_fix(s), __ATOMIC_RELAXED, __HIP_MEMORY_SCOPE_AGENT);
                __builtin_amdgcn_sched_barrier(0);
            }
    }
};
template <int MODE  > struct EpiBf16 {
    static constexpr bool PERM = true;
    bf16_t* O; int ldc; const u64* RS; int row0; bf16_t* Ohi; int msplit;
    __device__ __forceinline__ void operator()(const f32x4 (&acc)[2][2][4][2], const Unit& u, int wr, int wc, int fr, int fq) const {
        GAS char* ub;
        if (MODE == 2) ub = (GAS char*)O + ((size_t)u.pn * D + (size_t)u.pm * BM) * BM * 2;
        else if (MODE == 1 && u.pm >= msplit) ub = (GAS char*)Ohi + ((size_t)(u.pm - msplit) * BM * ldc + (size_t)u.pn * BM) * 2;
        else ub = (GAS char*)O + ((size_t)u.pm * BM * ldc + (size_t)u.pn * BM) * 2;
        const unsigned lo = (unsigned)((wr * 64 + (fr & 7)) * ldc + wc * 64) * 2u + (unsigned)(4 * (fr >> 3) + fq) * 16u;
        f32x4 cs[2][2];
        if (MODE == 2) {
            const int ln = fq * 16 + fr, tc = wc * 64 + ln;
            const u64* tp = RS + (row0 ? u.pn + 64 * tc : MP + (u.pn >> 3) * SS + (u.pn & 7) + 8 * tc);
            const float tr = row_rstd(tp);
#pragma unroll
            for (int bj = 0; bj < 2; ++bj)
#pragma unroll
                for (int n = 0; n < 2; ++n)
#pragma unroll
                    for (int j = 0; j < 4; ++j) cs[bj][n][j] = __shfl(tr, bj * 32 + 8 * fq + 4 * n + j);
        } else {
#pragma unroll
            for (int bj = 0; bj < 2; ++bj)
#pragma unroll
                for (int n = 0; n < 2; ++n)
#pragma unroll
                    for (int j = 0; j < 4; ++j) cs[bj][n][j] = 0.f;
        }
        float rsc[2][4];
#pragma unroll
        for (int ai = 0; ai < 2; ++ai)
#pragma unroll
            for (int m = 0; m < 4; ++m) { rsc[ai][m] = 1.f;
            }
#pragma unroll
        for (int ai = 0; ai < 2; ++ai)
#pragma unroll
            for (int m = 0; m < 4; ++m) { GAS char* rb = ub + (size_t)(ai * HALF + m * 16) * ldc * 2;
                const float sc = rsc[ai][m];
                u32x4 w[2];
#pragma unroll
                for (int bj = 0; bj < 2; ++bj) { f32x4 v0 = acc[ai][bj][m][0], v1 = acc[ai][bj][m][1];
                    if (MODE == 1) { const f32x4 a = (f32x4){relu1(v0[0]), relu1(v0[1]), relu1(v0[2]), relu1(v0[3])}, b = (f32x4){relu1(v1[0]), relu1(v1[1]), relu1(v1[2]), relu1(v1[3])}; v0 = a * a; v1 = b * b; }
                    if (MODE == 2) { v0 = v0 * cs[bj][0]; v1 = v1 * cs[bj][1]; }
                    w[bj].x = cvt_pk_bf16(v0[0], v0[1]); w[bj].y = cvt_pk_bf16(v0[2], v0[3]); w[bj].z = cvt_pk_bf16(v1[0], v1[1]); w[bj].w = cvt_pk_bf16(v1[2], v1[3]); }
                if (MODE == 1) {
                    GAS char* hb = u.pm >= msplit ? (GAS char*)Ohi + (size_t)(u.pm - msplit) * BM * ldc * 2 : (GAS char*)O + (size_t)u.pm * BM * ldc * 2;
                    GAS char* gb = hb + (size_t)(4 * u.pn + wc) * 32768 + (size_t)(ai * 8 + wr * 4 + m) * 2048;
                    const unsigned lp = (unsigned)((fr & 7) * 128 + (fr >> 3) * 64 + fq * 16);
                    __builtin_nontemporal_store(w[0], (GAS u32x4*)(gb + lp)); __builtin_nontemporal_store(w[1], (GAS u32x4*)(gb + lp + 1024));
                } else { u32x4 r1, r2; widen(w[0], w[1], r1, r2); *(GAS u32x4*)(rb + lo) = r1; *(GAS u32x4*)(rb + lo + 8 * ldc * 2) = r2; } }
    }
};
struct EpiGate {
    static constexpr bool PERM = true;
    bf16_t* Bo; bf16_t* Uo;
    __device__ __forceinline__ void operator()(const f32x4 (&acc)[2][2][4][2], const Unit& u, int wr, int wc, int fr, int fq) const {
        if (u.pn < 8) {
            GAS char* ub = (GAS char*)Bo + ((size_t)u.pm * BM * D + (size_t)u.pn * BM) * 2;
            const unsigned lo = (unsigned)((wr * 64 + (fr & 7)) * D + wc * 64) * 2u + (unsigned)(4 * (fr >> 3) + fq) * 16u;
#pragma unroll
            for (int ai = 0; ai < 2; ++ai)
#pragma unroll
                for (int m = 0; m < 4; ++m) { GAS char* rb = ub + (size_t)(ai * HALF + m * 16) * D * 2;
                    u32x4 w[2];
#pragma unroll
                    for (int bj = 0; bj < 2; ++bj) { const f32x4 v0 = acc[ai][bj][m][0], v1 = acc[ai][bj][m][1];
                        w[bj].x = cvt_pk_bf16(v0[0], v0[1]); w[bj].y = cvt_pk_bf16(v0[2], v0[3]); w[bj].z = cvt_pk_bf16(v1[0], v1[1]); w[bj].w = cvt_pk_bf16(v1[2], v1[3]); }
                    u32x4 r1, r2; widen(w[0], w[1], r1, r2);
                    *(GAS u32x4*)(rb + lo) = r1; *(GAS u32x4*)(rb + lo + 8 * D * 2) = r2; }
        } else {
            GAS char* ub = (GAS char*)Uo + ((size_t)u.pm * BM * D + (size_t)(u.pn - 8) * HALF) * 2;
            const unsigned lo = (unsigned)((wr * 64 + fr) * D + wc * 32 + 8 * fq) * 2u;
#pragma unroll
            for (int ai = 0; ai < 2; ++ai)
#pragma unroll
                for (int m = 0; m < 4; ++m) { GAS char* rb = ub + (size_t)(ai * HALF + m * 16) * D * 2;
                    const f32x4 v0 = acc[ai][0][m][0] * acc[ai][1][m][0], v1 = acc[ai][0][m][1] * acc[ai][1][m][1];
                    u32x4 w; w.x = cvt_pk_bf16(v0[0], v0[1]); w.y = cvt_pk_bf16(v0[2], v0[3]); w.z = cvt_pk_bf16(v1[0], v1[1]); w.w = cvt_pk_bf16(v1[2], v1[3]);
                    *(GAS u32x4*)(rb + lo) = w; }
        }
    }
};

template <class Desc, class Epi, bool ALIGN_EPI, bool SP2>
__device__ __forceinline__ void gemm_phase(LAS unsigned char* lds, const Desc g, const StaticOrder& S, const Epi& E, unsigned long long& pacc) {
    int tid_ = threadIdx.x; asm volatile("" : "+v"(tid_));
    const int tid = tid_, wid = __builtin_amdgcn_readfirstlane(tid >> 6), lane = tid & 63, wr = wid >> 2, wc = wid & 3, fr = lane & 15, fq = lane >> 4;
    const int K = g.K, nt = K / BK, lda = g.lda, ldb = g.ldb;
    unsigned voffA[2], voffB[2];
#pragma unroll
    for (int i = 0; i < 2; ++i) { int R, C; stage_rc(tid * 16 + i * 8192, R, C); const int Rb = 2 * (R & ~31) + perm32(R & 31);
        voffA[i] = g.voffa(R, C); voffB[i] = g.voffb(Rb, C); }
    const size_t kstep = g.kstepa(), kstepB = g.kstepb();
    const size_t hstepA = g.hstepa(), hstepB = (size_t)32 * ldb * 2;
    const unsigned ldsw = (unsigned)wid * 1024u;
    const int aoff = lds_byte(wr * 64 + fr, fq * 8), boff = lds_byte(wc * 32 + fr, fq * 8);
#define PG8_SA(b, h) (((b) * 2 + (h)) * HTB)
#define PG8_SB(b, h) ((4 + (b) * 2 + (h)) * HTB)
#define PG8_STAGE(bufoff, gbase, voff) do { _Pragma("unroll") for (int _i = 0; _i < 2; ++_i) { unsigned _vo = (voff)[_i]; asm("" : "+v"(_vo));     \
        __builtin_amdgcn_global_load_lds((const GAS unsigned*)((const GAS char*)(gbase) + _vo), (LAS unsigned*)(lds + (bufoff) + ldsw + _i * 8192), 16, 0, 0); } } while (0)
#define PG8_LDA(dst, b, h) do { _Pragma("unroll") for (int m = 0; m < 4; ++m) _Pragma("unroll") for (int k = 0; k < 2; ++k) dst[m][k] = *(const LAS bf16x8*)(lds + PG8_SA(b, h) + aoff + m * 2048 + k * 1024); } while (0)
#define PG8_LDB(dst, b, h) do { _Pragma("unroll") for (int n = 0; n < 2; ++n) _Pragma("unroll") for (int k = 0; k < 2; ++k) dst[n][k] = *(const LAS bf16x8*)(lds + PG8_SB(b, h) + boff + n * 2048 + k * 1024); } while (0)
#define PG8_MMA(ai, bj, At, Bt) do { __builtin_amdgcn_s_setprio(1); _Pragma("unroll") for (int p = 0; p < 8; ++p) _Pragma("unroll") for (int q = 0; q < 2; ++q) { const int n = p >> 2, m = (n ? 3 - (p & 3) : (p & 3)), k = (p ^ q) & 1; \
        asm volatile("v_mfma_f32_16x16x32_bf16 %0, %1, %2, %0" : "+v"(acc[ai][bj][m][n]) : "v"(Bt[n][k]), "v"(At[m][k])); }     __builtin_amdgcn_s_setprio(0); } while (0)
#define PG8_WAIT_V(n) asm volatile("s_waitcnt vmcnt(" #n ")" ::: "memory")
#define PG8_WAIT_L(n) asm volatile("s_waitcnt lgkmcnt(" #n ")" ::: "memory")
#define PG8_BAR __builtin_amdgcn_s_barrier()
#define PG8_SCHED __builtin_amdgcn_sched_barrier(0)
    Unit cur, nxt; int ui = 0;
    if (!S.next(0, cur)) return;
    f32x4 acc[2][2][4][2];
#pragma unroll
    for (int a = 0; a < 2; ++a)
#pragma unroll
        for (int b = 0; b < 2; ++b)
#pragma unroll
            for (int m = 0; m < 4; ++m)
#pragma unroll
                for (int n = 0; n < 2; ++n) acc[a][b][m][n] = (f32x4){0.f, 0.f, 0.f, 0.f};
    bf16x8 At[4][2], B0[2][2], B1[2][2];
    const char* cA = g.abase(cur); const char* cB = g.bbase(cur);
    if constexpr (SP2) {
        PG8_STAGE(PG8_SB(0, 0), cB, voffB); PG8_STAGE(PG8_SB(0, 1), cB + hstepB, voffB); PG8_STAGE(PG8_SA(0, 0), cA, voffA); PG8_STAGE(PG8_SA(0, 1), cA + hstepA, voffA);
        if (wr == 1) PG8_BAR;
        PG8_WAIT_V(2); PG8_BAR;
        PG8_STAGE(PG8_SB(1, 0), cB + kstepB, voffB); PG8_STAGE(PG8_SA(1, 0), cA + kstep, voffA); PG8_STAGE(PG8_SB(1, 1), cB + hstepB + kstepB, voffB);
        PG8_WAIT_V(6); PG8_BAR;
    } else {
        PG8_STAGE(PG8_SB(0, 0), cB, voffB); PG8_STAGE(PG8_SA(0, 0), cA, voffA); PG8_STAGE(PG8_SB(0, 1), cB + hstepB, voffB); PG8_STAGE(PG8_SA(0, 1), cA + hstepA, voffA);
        if (wr == 1) PG8_BAR;
        PG8_WAIT_V(4); PG8_BAR;
        PG8_STAGE(PG8_SB(1, 0), cB + kstepB, voffB); PG8_STAGE(PG8_SA(1, 0), cA + kstep, voffA); PG8_STAGE(PG8_SB(1, 1), cB + hstepB + kstepB, voffB);
        PG8_WAIT_V(6); PG8_BAR;
    }
    for (;;) {
        const bool has_next = S.next(ui + 1, nxt);
        const char* nA = has_next ? g.abase(nxt) : cA; const char* nB = has_next ? g.bbase(nxt) : cB;
#pragma unroll 1
        for (int t = 0; t < nt; t += 2) {
            const bool last = (t == nt - 2);
            unsigned long long pk0 = 0ull; if (PROBE_CAT == 4 || PROBE_CAT == 5) pk0 = __builtin_amdgcn_s_memrealtime();
            const char* a1 = cA + (size_t)(t + 1) * kstep;
            const char* a2 = last ? nA : cA + (size_t)(t + 2) * kstep; const char* b2 = last ? nB : cB + (size_t)(t + 2) * kstepB;
            const char* a3 = a2 + kstep; const char* b3 = b2 + kstepB;
            if constexpr (SP2) {
            PG8_LDB(B0, 0, 0); PG8_LDB(B1, 0, 1); PG8_SCHED; PG8_LDA(At, 0, 0); PG8_STAGE(PG8_SA(1, 1), a1 + hstepA, voffA);
            PG8_WAIT_V(8); PG8_WAIT_L(0); PG8_BAR; PG8_MMA(0, 0, At, B0); PG8_MMA(0, 1, At, B1); PG8_BAR; PG8_SCHED;
            PG8_LDA(At, 0, 1); PG8_STAGE(PG8_SB(0, 0), b2, voffB); PG8_STAGE(PG8_SB(0, 1), b2 + hstepB, voffB); PG8_STAGE(PG8_SA(0, 0), a2, voffA);
            PG8_WAIT_V(8); PG8_WAIT_L(0); PG8_BAR; PG8_MMA(1, 0, At, B0); PG8_MMA(1, 1, At, B1); PG8_BAR; PG8_SCHED;
            PG8_LDB(B0, 1, 0); PG8_LDB(B1, 1, 1); PG8_SCHED; PG8_LDA(At, 1, 0); PG8_STAGE(PG8_SA(0, 1), a2 + hstepA, voffA);
            PG8_WAIT_V(8); PG8_WAIT_L(0); PG8_BAR; PG8_MMA(0, 0, At, B0); PG8_MMA(0, 1, At, B1); PG8_BAR; PG8_SCHED;
            PG8_LDA(At, 1, 1); PG8_STAGE(PG8_SB(1, 0), b3, voffB); PG8_STAGE(PG8_SB(1, 1), b3 + hstepB, voffB); PG8_STAGE(PG8_SA(1, 0), a3, voffA);
            PG8_WAIT_V(8); PG8_WAIT_L(0); PG8_BAR; PG8_MMA(1, 0, At, B0); PG8_MMA(1, 1, At, B1); PG8_BAR; PG8_SCHED;
            } else {
            PG8_LDB(B0, 0, 0); PG8_SCHED; PG8_LDA(At, 0, 0); PG8_STAGE(PG8_SA(1, 1), a1 + hstepA, voffA);
            PG8_WAIT_L(8); PG8_BAR; PG8_WAIT_L(0); PG8_MMA(0, 0, At, B0); PG8_BAR; PG8_SCHED;
            PG8_LDB(B1, 0, 1); PG8_STAGE(PG8_SB(0, 0), b2, voffB);
            PG8_BAR; PG8_WAIT_L(0); PG8_MMA(0, 1, At, B1); PG8_BAR;
            PG8_LDA(At, 0, 1); PG8_STAGE(PG8_SA(0, 0), a2, voffA);
            PG8_BAR; PG8_WAIT_L(0); PG8_MMA(1, 0, At, B0); PG8_BAR; PG8_SCHED;
            PG8_STAGE(PG8_SB(0, 1), b2 + hstepB, voffB);
            PG8_WAIT_V(6); PG8_BAR; PG8_MMA(1, 1, At, B1); PG8_BAR;
            PG8_LDB(B0, 1, 0); PG8_SCHED; PG8_LDA(At, 1, 0); PG8_STAGE(PG8_SA(0, 1), a2 + hstepA, voffA);
            PG8_WAIT_L(8); PG8_BAR; PG8_WAIT_L(0); PG8_MMA(0, 0, At, B0); PG8_BAR; PG8_SCHED;
            PG8_LDB(B1, 1, 1); PG8_STAGE(PG8_SB(1, 0), b3, voffB);
            PG8_BAR; PG8_WAIT_L(0); PG8_MMA(0, 1, At, B1); PG8_BAR;
            PG8_LDA(At, 1, 1); PG8_STAGE(PG8_SA(1, 0), a3, voffA);
            PG8_BAR; PG8_WAIT_L(0); PG8_MMA(1, 0, At, B0); PG8_BAR; PG8_SCHED;
            PG8_STAGE(PG8_SB(1, 1), b3 + hstepB, voffB);
            PG8_WAIT_V(6); PG8_BAR; PG8_MMA(1, 1, At, B1); PG8_BAR;
            }
            if (PROBE_CAT == 4 && t == 0 && ui > 0) pacc += __builtin_amdgcn_s_memrealtime() - pk0;
            if (PROBE_CAT == 5 && t == 2) pacc += __builtin_amdgcn_s_memrealtime() - pk0;
        }
        if constexpr (ALIGN_EPI) { if (wr == 0) PG8_BAR; }
        asm volatile("s_nop 15\n\ts_nop 15" ::: "memory");
        E(acc, cur, wr, wc, fr, fq);
        if (!has_next) break;
#pragma unroll
        for (int a = 0; a < 2; ++a)
#pragma unroll
            for (int b = 0; b < 2; ++b)
#pragma unroll
                for (int m = 0; m < 4; ++m)
#pragma unroll
                    for (int n = 0; n < 2; ++n) acc[a][b][m][n] = (f32x4){0.f, 0.f, 0.f, 0.f};
        cur = nxt; cA = nA; cB = nB; ++ui;
        if constexpr (ALIGN_EPI) { if (wr == 1) PG8_BAR; }
    }
    PG8_WAIT_V(0);
    if constexpr (!ALIGN_EPI) { if (wr == 0) PG8_BAR; }
    PG8_BAR;
#undef PG8_SA
#undef PG8_SB
#undef PG8_STAGE
#undef PG8_LDA
#undef PG8_LDB
#undef PG8_MMA
#undef PG8_WAIT_V
#undef PG8_WAIT_L
#undef PG8_BAR
#undef PG8_SCHED
}
}

#define XB_TMO      128
#define XB_XCNT(j)  (256  + 64 * (j))
#define XB_XSUB(j)  (1280 + 64 * (j))
#define XB_XGEN(j)  (2304 + 64 * (j))
#define XB_TOP      3328
#define XB_TOPGEN   3392
#define XCD_BAR_WORDS 3456
#define XB_SPIN_CAP (1u << 18)
__device__ __forceinline__ unsigned xb_ld(unsigned* p)              { return __hip_atomic_load(p, __ATOMIC_RELAXED, __HIP_MEMORY_SCOPE_AGENT); }
__device__ __forceinline__ unsigned xb_add(unsigned* p, unsigned v) { return __hip_atomic_fetch_add(p, v, __ATOMIC_RELAXED, __HIP_MEMORY_SCOPE_AGENT); }
__device__ __forceinline__ unsigned xb_xcc_id() { return (unsigned)__builtin_amdgcn_s_getreg((3 << 11) | 20) & 0xFu; }
#define XB_SPIN(cond, bar) do { unsigned _sp = 0; while (cond) { __builtin_amdgcn_s_sleep(1); \
    if ((++_sp & 255u) == 0u) { if (xb_ld(&(bar)[XB_TMO])) break; if (_sp > XB_SPIN_CAP) { atomicAdd(&(bar)[XB_TMO], 1u); break; } } } } while (0)
struct XcdBarrier { unsigned* bar; unsigned x; volatile LAS unsigned* st; };
__device__ __forceinline__ XcdBarrier xcd_barrier_post(unsigned* bar, volatile LAS unsigned* st) {
    XcdBarrier b; b.bar = bar; b.x = (unsigned)__builtin_amdgcn_readfirstlane((int)xb_xcc_id()); b.st = st;
    if (threadIdx.x == 0) (void)xb_add(&bar[XB_XCNT(b.x)], 1u);
    return b;
}
__device__ __forceinline__ void xcd_barrier_complete(unsigned* bar, unsigned x, unsigned& nloc, unsigned& nx) {
    const unsigned G = gridDim.x * gridDim.y * gridDim.z;
    unsigned sum, cnt, mine, sp = 0u;
    for (;;) {
        sum = 0u; cnt = 0u; mine = 0u;
#pragma unroll
        for (unsigned j = 0; j < 16; ++j) { const unsigned c = xb_ld(&bar[XB_XCNT(j)]); sum += c; cnt += (c > 0u) ? 1u : 0u; mine = (j == x) ? c : mine; }
        if (sum == G) break;
        __builtin_amdgcn_s_sleep(1);
        if ((++sp & 255u) == 0u) { if (xb_ld(&bar[XB_TMO])) break; if (sp > XB_SPIN_CAP) { atomicAdd(&bar[XB_TMO], 1u); break; } }
    }
    nloc = mine > 0u ? mine : 1u; nx = cnt > 0u ? cnt : 1u;
}
__device__ __forceinline__ void xcd_barrier(const XcdBarrier& b) {
    asm volatile("s_waitcnt vmcnt(0)" ::: "memory");
    __syncthreads();
    if (threadIdx.x == 0) {
        unsigned* bar = b.bar; unsigned bx_ = b.x; asm volatile("" : "+s"(bx_));
        __builtin_amdgcn_s_waitcnt(0);
        unsigned nloc = b.st[0], nx = b.st[1];
        if (nloc == 0u) { xcd_barrier_complete(bar, bx_, nloc, nx); b.st[0] = nloc; b.st[1] = nx; }
        const unsigned old = xb_add(&bar[XB_XSUB(bx_)], 1u);
        const unsigned gen = old / nloc;
        if (old + 1u == (gen + 1u) * nloc) {
            __builtin_amdgcn_fence(__ATOMIC_RELEASE, "agent");
            asm volatile("s_waitcnt vmcnt(0)" ::: "memory");
            const unsigned og = xb_add(&bar[XB_TOP], 1u);
            const unsigned tg = og / nx;
            if (og + 1u == (tg + 1u) * nx) xb_add(&bar[XB_TOPGEN], 1u);
            else XB_SPIN(xb_ld(&bar[XB_TOPGEN]) == tg, bar);
            __builtin_amdgcn_fence(__ATOMIC_ACQUIRE, "agent");
            xb_add(&bar[XB_XGEN(bx_)], 1u);
            asm volatile("s_waitcnt vmcnt(0)" ::: "memory");
        } else {
            XB_SPIN(xb_ld(&bar[XB_XGEN(bx_)]) == gen, bar);
            __builtin_amdgcn_fence(__ATOMIC_ACQUIRE, "agent");
            asm volatile("s_waitcnt vmcnt(0)" ::: "memory");
        }
    }
    __syncthreads();
}

__device__ __forceinline__ float wave_sum(float v) {
#pragma unroll
    for (int o = 1; o < 64; o <<= 1) v += __shfl_xor(v, o);
    return v;
}
__device__ __forceinline__ void transpose_item(const float* W, int K, int N, bf16_t* WT, int k0, int n0, int drow0, const float* gain, LAS float* scr, int lane) {
    float tv[32];
#pragma unroll
    for (int i = 0; i < 32; ++i) tv[i] = ((const GAS float*)W)[(size_t)(k0 + 2 * i + (lane >> 5)) * N + n0 + (lane & 31)];
#pragma unroll
    for (int i = 0; i < 32; ++i) { const int kk = 2 * i + (lane >> 5); float v = tv[i]; if (gain) v *= ((const GAS float*)gain)[k0 + kk]; scr[kk * 33 + (lane & 31)] = v; }
    LDS_WAIT(); asm volatile("" ::: "memory");
    const int c = lane & 7;
#pragma unroll
    for (int j = 0; j < 4; ++j) { const int n = (lane >> 3) + 8 * j; const LAS float* s = scr + (8 * c) * 33 + n;
        u32x4 o; o.x = cvt_pk_bf16(s[0 * 33], s[1 * 33]); o.y = cvt_pk_bf16(s[2 * 33], s[3 * 33]); o.z = cvt_pk_bf16(s[4 * 33], s[5 * 33]); o.w = cvt_pk_bf16(s[6 * 33], s[7 * 33]);
        *(GAS u32x4*)(WT + pg8::paired_off(drow0 + n, k0 + 8 * c, K)) = o; }
    LDS_WAIT(); asm volatile("" ::: "memory");
}
__device__ __forceinline__ int win_row(int n) {
    if (n < D) return n;
    const int which = (n >= 2 * D) ? 1 : 0, cc = n - D - which * D;
    return D + (cc >> 5) * 64 + which * 32 + (cc & 31);
}
__device__ __forceinline__ float cas_pi(float t) { float s, c; sincospif(t, &s, &c); return c + s; }

__device__ __forceinline__ unsigned char* wsp(unsigned char* ws, size_t off) { asm volatile("" : "+s"(ws)); return ws + off; }

struct Ptrs {
    const float *x_prompt, *x_sample, *norm_mix, *a_w_in, *a_conv_w, *a_w_out, *f_w_out, *norm_ffn, *w_up, *w_down, *final_norm;
    float* out; unsigned char* ws;
};

__device__ __forceinline__ void prologue(const Ptrs& P, LAS unsigned char* lds, int gw, int NGW, int wave, int lane_) {
    int lane = lane_; asm volatile("" : "+v"(lane));
    LAS float* scr = (LAS float*)(lds + wave * 16384);
    bf16_t* WIN = (bf16_t*)(P.ws + WS_WIN); bf16_t* AWO = (bf16_t*)(P.ws + WS_AWO); bf16_t* FWO = (bf16_t*)(P.ws + WS_FWO);
    bf16_t* WUP = (bf16_t*)(P.ws + WS_WUP); bf16_t* WDN = (bf16_t*)(P.ws + WS_WDN);
    constexpr int I_IN = (D / 64) * (3 * D / 32), I_SQ = (D / 64) * (D / 32), I_UP = (D / 64) * (DFF / 32), I_DN = (DFF / 64) * (D / 32);
    constexpr int NITEMS = 2 * I_IN + 4 * I_SQ + 4 * I_UP + 4 * I_DN;
    for (int it = gw; it < NITEMS; it += NGW) {
        int r = it;
        if (r < 2 * I_IN) { const int j = r / I_IN; r -= j * I_IN; const int nblk = 3 * D / 32, kb = r / nblk, nb = r % nblk;
            transpose_item(P.a_w_in + (size_t)j * D * 3 * D, D, 3 * D, WIN + (size_t)j * 3 * D * D, 64 * kb, 32 * nb, win_row(32 * nb), P.norm_mix + (2 * j) * D, scr, lane); continue; }
        r -= 2 * I_IN;
        if (r < 2 * I_SQ) { const int j = r / I_SQ; r -= j * I_SQ; const int nblk = D / 32, kb = r / nblk, nb = r % nblk;
            transpose_item(P.a_w_out + (size_t)j * D * D, D, D, AWO + (size_t)j * D * D, 64 * kb, 32 * nb, 32 * nb, nullptr, scr, lane); continue; }
        r -= 2 * I_SQ;
        if (r < 2 * I_SQ) { const int j = r / I_SQ; r -= j * I_SQ; const int nblk = D / 32, kb = r / nblk, nb = r % nblk;
            transpose_item(P.f_w_out + (size_t)j * D * D, D, D, FWO + (size_t)j * D * D, 64 * kb, 32 * nb, 32 * nb, nullptr, scr, lane); continue; }
        r -= 2 * I_SQ;
        if (r < 4 * I_UP) { const int j = r / I_UP; r -= j * I_UP; const int nblk = DFF / 32, kb = r / nblk, nb = r % nblk;
            transpose_item(P.w_up + (size_t)j * D * DFF, D, DFF, WUP + (size_t)j * D * DFF, 64 * kb, 32 * nb, 32 * nb, P.norm_ffn + j * D, scr, lane); continue; }
        r -= 4 * I_UP;
        { const int j = r / I_DN; r -= j * I_DN; const int nblk = D / 32, kb = r / nblk, nb = r % nblk;
            transpose_item(P.w_down + (size_t)j * D * DFF, DFF, D, WDN + (size_t)j * D * DFF, 64 * kb, 32 * nb, 32 * nb, nullptr, scr, lane); }
    }
    const int gl = gw * 64 + lane, NGL = NGW * 64;
    for (int i = gl; i < 2 * NGRP * CG * CG / 8; i += NGL) { const int jl = i / (NGRP * CG * CG / 8), r = i % (NGRP * CG * CG / 8), g = r / (CG * CG / 8), q = r % (CG * CG / 8), c = q / (CG / 8), j0 = (q % (CG / 8)) * 8; float v[8];
        const GAS float* gn = (const GAS float*)P.norm_mix + (2 * jl + 1) * D + g * CG + j0;
#pragma unroll
        for (int e = 0; e < 8; ++e) v[e] = cas_pi(-(float)((c * (j0 + e)) & (CG - 1)) * (1.0f / 128.0f)) * gn[e];
        u32x4 o; o.x = cvt_pk_bf16(v[0], v[1]); o.y = cvt_pk_bf16(v[2], v[3]); o.z = cvt_pk_bf16(v[4], v[5]); o.w = cvt_pk_bf16(v[6], v[7]);
        *(GAS u32x4*)((bf16_t*)(P.ws + WS_PT) + (size_t)i * 8) = o; }
    for (int i = gl; i < SP * RAD; i += NGL) { const int k = i >> 3, s2 = i & 7; float s, c; sincospif((float)((k * s2) & (SP - 1)) * (1.0f / 8192.0f), &s, &c);
        ((GAS f32x2*)(P.ws + WS_TW))[i] = (f32x2){c, s}; }
    for (int i = gl; i < CG * CG / 8; i += NGL) { const int k = i / (CG / 8), s0 = (i % (CG / 8)) * 8; float v[8];
#pragma unroll
        for (int e = 0; e < 8; ++e) v[e] = cas_pi((float)((k * (s0 + e)) & (CG - 1)) * (1.0f / 128.0f));
        u32x4 o; o.x = cvt_pk_bf16(v[0], v[1]); o.y = cvt_pk_bf16(v[2], v[3]); o.z = cvt_pk_bf16(v[4], v[5]); o.w = cvt_pk_bf16(v[6], v[7]);
        *(GAS u32x4*)((bf16_t*)(P.ws + WS_H256) + (size_t)k * CG + s0) = o; }
    for (int i = gl; i < SS * RAD; i += NGL) { const int k = i >> 3, s2 = i & 7; float s, c; sincospif((float)((k * s2) & (SS - 1)) * (1.0f / 1024.0f), &s, &c);
        ((GAS f32x2*)(P.ws + WS_TW + 1 * MiB))[i] = (f32x2){c, s}; }
    for (int q = gw; q < M / 2; q += NGW) {
        const int m = (q >> 3) * 16 + (q & 7), hh = (lane >> 2) & 1, mr = m + 8 * hh;
        const GAS f32x4* xr = (const GAS f32x4*)(mr < MP ? P.x_prompt + (size_t)mr * D : P.x_sample + (size_t)(mr - MP) * D) + (lane >> 3) * 8 + (lane & 3) * 2;
        f32x4 v[8][2]; float s = 0.f;
#pragma unroll
        for (int j = 0; j < 8; ++j) { v[j][0] = xr[64 * j]; v[j][1] = xr[64 * j + 1]; }
        GAS u32x4* o16 = (GAS u32x4*)((bf16_t*)(P.ws + WS_B1) + pg8::paired_off(m, 0, D)) + lane;
#pragma unroll
        for (int j = 0; j < 8; ++j) { u32x4 w; w[0] = cvt_pk_bf16(v[j][0].x, v[j][0].y); w[1] = cvt_pk_bf16(v[j][0].z, v[j][0].w); w[2] = cvt_pk_bf16(v[j][1].x, v[j][1].y); w[3] = cvt_pk_bf16(v[j][1].z, v[j][1].w); o16[64 * j] = w;
#pragma unroll
            for (int e = 0; e < 4; ++e) { const float y0 = bf_lo(w[e]), y1 = bf_hi(w[e]); s += y0 * y0 + y1 * y1; } }
        s += __shfl_xor(s, 1); s += __shfl_xor(s, 2); s += __shfl_xor(s, 8); s += __shfl_xor(s, 16); s += __shfl_xor(s, 32);
        if ((lane & ~4) == 0) ((GAS u64*)(P.ws + WS_RS))[mr] = pg8::rs_fix(s);
    }
}

__device__ __forceinline__ void final_norm_phase(const bf16_t* xs, float* out, const u64* RS, const float* gain, int gw, int NGW, int lane_) {
    int lane = lane_; asm volatile("" : "+v"(lane));
    const int col4 = (lane >> 3) * 8 + (lane & 3) * 2, hh = (lane >> 2) & 1;
    f32x4 gv[8][2];
#pragma unroll
    for (int j = 0; j < 8; ++j) { gv[j][0] = ((const GAS f32x4*)gain)[col4 + 64 * j]; gv[j][1] = ((const GAS f32x4*)gain)[col4 + 64 * j + 1]; }
    for (int q = gw; q < M / 2; q += NGW) {
        const int m = (q >> 3) * 16 + (q & 7), mr = m + 8 * hh;
        const GAS u32x4* xr = (const GAS u32x4*)(xs + pg8::paired_off(m, 0, D)) + lane;
        GAS f32x4* orow = (GAS f32x4*)(out + (size_t)mr * D) + col4;
        const float rstd = pg8::row_rstd(RS + mr);
        u32x4 v[8];
#pragma unroll
        for (int j = 0; j < 8; ++j) v[j] = xr[64 * j];
#pragma unroll
        for (int j = 0; j < 8; ++j) { f32x4 y0, y1; y0.x = bf_lo(v[j][0]); y0.y = bf_hi(v[j][0]); y0.z = bf_lo(v[j][1]); y0.w = bf_hi(v[j][1]); y1.x = bf_lo(v[j][2]); y1.y = bf_hi(v[j][2]); y1.z = bf_lo(v[j][3]); y1.w = bf_hi(v[j][3]);
            orow[64 * j] = y0 * rstd * gv[j][0]; orow[64 * j + 1] = y1 * rstd * gv[j][1]; }
    }
}
__device__ __forceinline__ void conv_phase(const bf16_t* Bb, const bf16_t* Ub, const float* cw, const u64* RS, bf16_t* Gb, int gw, int NGW, int lane_) {
    int lane = lane_; asm volatile("" : "+v"(lane));
    for (int chunk = gw; chunk < M / 8; chunk += NGW) {
        const int m0 = chunk * 8;
        const bool first = (m0 == 0) || (m0 >= MP && ((m0 - MP) & (SS - 1)) == 0);
        const bool last = (m0 + 8 == MP) || (m0 >= MP && ((m0 + 8 - MP) & (SS - 1)) == 0);
        float rr[10];
#pragma unroll
        for (int q = 0; q < 10; ++q) { const bool ok = !((q == 0 && first) || (q == 9 && last)); rr[q] = ok ? pg8::row_rstd(RS + (m0 - 1 + q)) : 0.f; }
#pragma unroll 1
        for (int j = 0; j < 4; ++j) {
            const int ch0 = (lane + 64 * j) * 8;
            float w0[8], w1[8], w2[8];
#pragma unroll
            for (int h = 0; h < 2; ++h) { const f32x4 a = *(const GAS f32x4*)(cw + ch0 + 4 * h), b = *(const GAS f32x4*)(cw + D + ch0 + 4 * h), c = *(const GAS f32x4*)(cw + 2 * D + ch0 + 4 * h);
#pragma unroll
                for (int e = 0; e < 4; ++e) { w0[4 * h + e] = a[e]; w1[4 * h + e] = b[e]; w2[4 * h + e] = c[e]; } }
            const GAS u32x4* up = (const GAS u32x4*)(Ub + (size_t)m0 * D + ch0);
            const GAS u32x4* bp = (const GAS u32x4*)(Bb + (size_t)m0 * D + ch0);
            GAS u32x4* gp = (GAS u32x4*)(Gb + (size_t)m0 * D + ch0);
            u32x4 uu[10], bb[8];
#pragma unroll
            for (int q = 0; q < 10; ++q) { const bool ok = !((q == 0 && first) || (q == 9 && last)); uu[q] = (u32x4){0u, 0u, 0u, 0u}; if (ok) uu[q] = *(up + (ptrdiff_t)(q - 1) * (D / 8)); }
#pragma unroll
            for (int r = 0; r < 8; ++r) bb[r] = bp[(size_t)r * (D / 8)];
#pragma unroll
            for (int r = 0; r < 8; ++r) {
                const float rp = rr[r] * rr[r], rc = rr[r + 1] * rr[r + 1], rn = rr[r + 2] * rr[r + 2], rb = rr[r + 1];
                float o[8];
#pragma unroll
                for (int e = 0; e < 8; ++e) o[e] = rb * bf_at(bb[r], e) * (w0[e] * rp * bf_at(uu[r], e) + w1[e] * rc * bf_at(uu[r + 1], e) + w2[e] * rn * bf_at(uu[r + 2], e));
                u32x4 w; w.x = cvt_pk_bf16(o[0], o[1]); w.y = cvt_pk_bf16(o[2], o[3]); w.z = cvt_pk_bf16(o[4], o[5]); w.w = cvt_pk_bf16(o[6], o[7]);
                gp[(size_t)r * (D / 8)] = w;
            }
        }
    }
}
__device__ __forceinline__ void load_rev(const GAS bf16_t* rowp, int g0, int c0, float (&r)[8]) {
    const u32x4 A = *(const GAS u32x4*)(rowp + g0 + ((248 - c0) & 255)), Bv = *(const GAS u32x4*)(rowp + g0 + ((256 - c0) & 255));
    r[0] = bf_at(Bv, 0);
#pragma unroll
    for (int i = 1; i < 8; ++i) r[i] = bf_at(A, 8 - i);
}
__device__ __forceinline__ void post_phase(int mode, const bf16_t* UP, const bf16_t* US, const f32x2* TWP, const f32x2* TWS, bf16_t* MXP, bf16_t* MXS, const bf16_t* HP256, bf16_t* H2048, int gw, int NGW, int lane_) {
    int lane = lane_; asm volatile("" : "+v"(lane));
    const float SC_S = 0.5f / sqrtf((float)SS * (float)CG), SC_P = 0.5f / sqrtf((float)SP * (float)CG);
    for (int it = gw + (mode == 1 ? SS : 0); it < (mode == 1 ? SS + NB * CG : SS); it += NGW) {
        const bool pr = it < SS;
        const int L = pr ? SS : CG, b = pr ? 0 : (it - SS) >> 8, k1 = pr ? it : (it - SS) & (CG - 1), nk1 = (L - k1) & (L - 1);
        const GAS bf16_t* H = pr ? (const GAS bf16_t*)UP : (const GAS bf16_t*)US + (size_t)b * SS * D;
        GAS bf16_t* O = pr ? (GAS bf16_t*)MXP : (GAS bf16_t*)MXS + (size_t)(MP + b * SS) * D;
        const f32x2* TW = pr ? TWP : TWS; const float sc = pr ? SC_P : SC_S;
        f32x2 st[4];
#pragma unroll
        for (int k2 = 0; k2 < 4; ++k2) st[k2] = TW[(size_t)(k1 + L * k2) * RAD + 1];
#pragma unroll 1
        for (int j = 0; j < 4; ++j) { const int ch0 = (lane + 64 * j) * 8, g0 = ch0 & ~255, c0 = ch0 & 255;
            const int ra = g0 + ((248 - c0) & 255), rb = g0 + ((256 - c0) & 255);
            f32x2 acc[8][4], cw[4];
#pragma unroll
            for (int a = 0; a < 8; ++a) { if (a < 4) cw[a] = (f32x2){1.f, 0.f};
#pragma unroll
                for (int e = 0; e < 4; ++e) acc[a][e] = (f32x2){0.f, 0.f}; }
#pragma unroll 1
            for (int hf = 0; hf < 4; ++hf) {
                u32x4 va[2], vp[2], nA[2], nB[2], kA[2], kB[2];
#pragma unroll
                for (int q = 0; q < 2; ++q) { const int s2 = hf * 2 + q;
                    const GAS bf16_t* rowk = H + ((size_t)s2 * L + k1) * D;
                    const GAS bf16_t* rown = H + ((size_t)s2 * L + nk1) * D;
                    va[q] = *(const GAS u32x4*)(rowk + ch0); vp[q] = *(const GAS u32x4*)(rown + ch0);
                    nA[q] = *(const GAS u32x4*)(rown + ra); nB[q] = *(const GAS u32x4*)(rown + rb);
                    kA[q] = *(const GAS u32x4*)(rowk + ra); kB[q] = *(const GAS u32x4*)(rowk + rb); }
#pragma unroll
                for (int q = 0; q < 2; ++q) {
                    float Ev[8], Ov[8];
                    Ev[0] = bf_at(va[q], 0) + bf_at(nB[q], 0); Ov[0] = bf_at(vp[q], 0) - bf_at(kB[q], 0);
#pragma unroll
                    for (int e = 1; e < 8; ++e) { Ev[e] = bf_at(va[q], e) + bf_at(nA[q], 8 - e); Ov[e] = bf_at(vp[q], e) - bf_at(kA[q], 8 - e); }
#pragma unroll
                    for (int k2 = 0; k2 < 4; ++k2) { const f32x2 cc = (f32x2){cw[k2].x, cw[k2].x}, ss = (f32x2){cw[k2].y, cw[k2].y};
#pragma unroll
                        for (int e = 0; e < 4; ++e) { acc[4 * q + k2][e] = __builtin_elementwise_fma((f32x2){Ev[2 * e], Ev[2 * e + 1]}, cc, acc[4 * q + k2][e]);
                                                      acc[4 * q + k2][e] = __builtin_elementwise_fma((f32x2){Ov[2 * e], Ov[2 * e + 1]}, ss, acc[4 * q + k2][e]); }
                        const float nc = cw[k2].x * st[k2].x - cw[k2].y * st[k2].y, ns = cw[k2].y * st[k2].x + cw[k2].x * st[k2].y; cw[k2] = (f32x2){nc, ns}; }
                }
            }
#pragma unroll
            for (int k2 = 0; k2 < 8; ++k2) { u32x4 w; f32x2 o[4];
#pragma unroll
                for (int e = 0; e < 4; ++e) o[e] = (k2 < 4 ? acc[k2][e] + acc[4 + k2][e] : acc[k2 - 4][e] - acc[k2][e]) * sc;
                w.x = cvt_pk_bf16(o[0].x, o[0].y); w.y = cvt_pk_bf16(o[1].x, o[1].y);
                w.z = cvt_pk_bf16(o[2].x, o[2].y); w.w = cvt_pk_bf16(o[3].x, o[3].y);
                *(GAS u32x4*)(O + (size_t)(k1 + L * k2) * D + ch0) = w; }
        }
    }
    if (mode == 1) {
        for (int it = gw; it < RAD * CG; it += NGW) {
            const int t = it >> 8, k1 = it & (CG - 1), nk1 = (CG - k1) & (CG - 1);
            f32x2 st[4];
#pragma unroll
            for (int k2 = 0; k2 < 4; ++k2) st[k2] = TWS[(size_t)(k1 + CG * k2) * RAD + 1];
#pragma unroll 1
            for (int j = 0; j < 4; ++j) { const int ch0 = (lane + 64 * j) * 8;
                f32x2 acc[8][4], cw[4];
#pragma unroll
                for (int a = 0; a < 8; ++a) { if (a < 4) cw[a] = (f32x2){1.f, 0.f};
#pragma unroll
                    for (int e = 0; e < 4; ++e) acc[a][e] = (f32x2){0.f, 0.f}; }
#pragma unroll 1
                for (int hf = 0; hf < 2; ++hf) {
                    u32x4 va[4], vp[4];
#pragma unroll
                    for (int q = 0; q < 4; ++q) { const int s2 = t + 8 * (hf * 4 + q);
                        va[q] = *(const GAS u32x4*)((const GAS bf16_t*)HP256 + ((size_t)s2 * CG + k1) * D + ch0);
                        vp[q] = *(const GAS u32x4*)((const GAS bf16_t*)HP256 + ((size_t)s2 * CG + nk1) * D + ch0); }
#pragma unroll
                    for (int q = 0; q < 4; ++q) {
#pragma unroll
                        for (int k2 = 0; k2 < 4; ++k2) { const f32x2 cc = (f32x2){cw[k2].x, cw[k2].x}, ss = (f32x2){cw[k2].y, cw[k2].y};
#pragma unroll
                            for (int e = 0; e < 4; ++e) { acc[4 * (q & 1) + k2][e] = __builtin_elementwise_fma((f32x2){bf_at(va[q], 2 * e), bf_at(va[q], 2 * e + 1)}, cc, acc[4 * (q & 1) + k2][e]);
                                                          acc[4 * (q & 1) + k2][e] = __builtin_elementwise_fma((f32x2){bf_at(vp[q], 2 * e), bf_at(vp[q], 2 * e + 1)}, ss, acc[4 * (q & 1) + k2][e]); }
                            const float nc = cw[k2].x * st[k2].x - cw[k2].y * st[k2].y, ns = cw[k2].y * st[k2].x + cw[k2].x * st[k2].y; cw[k2] = (f32x2){nc, ns}; }
                    }
                }
#pragma unroll
                for (int k2 = 0; k2 < 8; ++k2) { u32x4 w; f32x2 o[4];
#pragma unroll
                    for (int e = 0; e < 4; ++e) o[e] = k2 < 4 ? acc[k2][e] + acc[4 + k2][e] : acc[k2 - 4][e] - acc[k2][e];
                    w.x = cvt_pk_bf16(o[0].x, o[0].y); w.y = cvt_pk_bf16(o[1].x, o[1].y);
                    w.z = cvt_pk_bf16(o[2].x, o[2].y); w.w = cvt_pk_bf16(o[3].x, o[3].y);
                    *(GAS u32x4*)((GAS bf16_t*)H2048 + ((size_t)t * SS + k1 + CG * k2) * D + ch0) = w; }
            }
        }
    }
}

#define TIC() do { if (PROBE_CAT) pt0 = __builtin_amdgcn_s_memrealtime(); } while (0)
#define TOC(cat) do { if (PROBE_CAT == (cat)) pacc += __builtin_amdgcn_s_memrealtime() - pt0; } while (0)
#define GRID_BAR() do { TIC(); xcd_barrier(bar); TOC(2); } while (0)
__global__ void __launch_bounds__(NWAVES * 64, 2) fwd_kernel(Ptrs P) {
    extern __shared__ __attribute__((aligned(16))) unsigned char lds_raw[];
    LAS unsigned char* lds = (LAS unsigned char*)lds_raw;
    const int tid = threadIdx.x, lane = tid & 63, wave = __builtin_amdgcn_readfirstlane(tid >> 6);
    const int G = gridDim.x, bx = blockIdx.x;
    const int vcu = (G % 8 == 0) ? (bx % 8) * (G / 8) + bx / 8 : bx;
    const int gw = vcu * NWAVES + wave, NGW = G * NWAVES;
    for (int u = tid; u < (LDS_BYTES - LDSCTL_OFF) / 4; u += NWAVES * 64) ((LAS unsigned*)(lds + LDSCTL_OFF))[u] = 0u;
    __syncthreads();
    volatile LAS unsigned* MISC = (volatile LAS unsigned*)(lds + MISC_OFF);
    XcdBarrier bar = xcd_barrier_post((unsigned*)(P.ws + WS_CTL) + CW_BAR, MISC + 8);

#define WIN ((bf16_t*)wsp(P.ws, WS_WIN))
#define AWO ((bf16_t*)wsp(P.ws, WS_AWO))
#define FWO ((bf16_t*)wsp(P.ws, WS_FWO))
#define WUP ((bf16_t*)wsp(P.ws, WS_WUP))
#define WDN ((bf16_t*)wsp(P.ws, WS_WDN))
#define HART ((bf16_t*)wsp(P.ws, WS_HART))
#define PT ((bf16_t*)wsp(P.ws, WS_PT))
#define TW ((const f32x2*)wsp(P.ws, WS_TW))
#define TWS ((const f32x2*)wsp(P.ws, WS_TW + 1 * MiB))
#define H256 ((bf16_t*)wsp(P.ws, WS_H256))
#define B1 ((bf16_t*)wsp(P.ws, WS_B1))
#define B2 ((bf16_t*)wsp(P.ws, WS_B2))
#define B3 ((bf16_t*)wsp(P.ws, WS_B3))

    unsigned long long pacc = 0ull, pt0 = 0ull;
    TIC(); prologue(P, lds, gw, NGW, wave, lane); TOC(1);
    GRID_BAR();

#define PTG PT
#define RSB ((u64*)wsp(P.ws, WS_RS))
#define XS B1
#pragma unroll 1
    for (int layer = 0; layer < 4; ++layer) {
        const int j = layer >> 1;
        u64* RS0 = RSB + (size_t)(2 * layer) * (RS_STRIDE / 8);
        u64* RS1 = RS0 + RS_STRIDE / 8;
        u64* RS2 = RS1 + RS_STRIDE / 8;
        if ((layer & 1) == 0) {
            {
                pg8::DescPlain g{XS, WIN + (size_t)j * 3 * D * D, D, D, D}; pg8::StaticOrder S; S.init(M, 3 * D, G, bx, 4, 1);
                pg8::EpiGate E{B2, B3};
                pg8::gemm_phase<pg8::DescPlain, pg8::EpiGate, true, true>(lds, g, S, E, pacc);
            }
            GRID_BAR();
            TIC(); conv_phase(B2, B3, P.a_conv_w + (size_t)j * 3 * D, RS0, B2, gw, NGW, lane); TOC(1);
            GRID_BAR();
        } else {
            bf16_t* VTS = B2 + (size_t)RAD * D * SS; bf16_t* USM = B3 + (size_t)RAD * SS * D;
#pragma unroll 1
            for (int pr = 1; pr >= 0; --pr) {
                pg8::DescF0 g{PTG + (size_t)j * NGRP * CG * CG, pr ? XS : XS + (size_t)MP * D, CG, CG, pr ? 64 * D : 8 * D, pr}; pg8::StaticOrder S; S.init(D, pr ? MP : MS, G, bx);
                pg8::EpiBf16<2> E{pr ? B2 : VTS, CG, RS0, pr, nullptr, 0};
                pg8::gemm_phase<pg8::DescF0, pg8::EpiBf16<2>, true, true>(lds, g, S, E, pacc);
            }
            GRID_BAR();
            {
                pg8::DescF2 g{H256, B2, CG, CG, CG, 0, 0}; pg8::StaticOrder S; S.init(M, D, G, bx);
                pg8::EpiBf16<0> E{B3, D, nullptr, 0, nullptr, 0};
                pg8::gemm_phase<pg8::DescF2, pg8::EpiBf16<0>, true, true>(lds, g, S, E, pacc);
            }
            GRID_BAR();
#pragma unroll 1
            for (int mode = 1; mode <= 2; ++mode) {
                TIC(); post_phase(mode, B2, USM, TW, TWS, B3, B2, B3, B2, gw, NGW, lane); TOC(1);
                GRID_BAR();
            }
        }
        {
            pg8::DescSplit g{(layer & 1) ? B3 : B2, B2 + (size_t)MP * D, MP / BMT, ((layer & 1) == 0 ? AWO : FWO) + (size_t)j * D * D, D, D, D, 0}; pg8::StaticOrder S; S.init(M, D, G, bx, 4);
            pg8::EpiRes<false> E{XS, RS1, 0, nullptr};
            pg8::gemm_phase<pg8::DescSplit, pg8::EpiRes<false>, true, true>(lds, g, S, E, pacc);
        }
        GRID_BAR();
        {
            pg8::DescPlain g{XS, WUP + (size_t)layer * D * DFF, D, D, D}; pg8::StaticOrder S; S.init(M, DFF, G, bx, 4, 1);
            pg8::EpiBf16<1> E{B2, DFF, nullptr, 0, (bf16_t*)P.out, MCH / BMT};
            pg8::gemm_phase<pg8::DescPlain, pg8::EpiBf16<1>, true, true>(lds, g, S, E, pacc);
        }
        GRID_BAR();
        {
            pg8::DescSplit g{B2, (const bf16_t*)P.out, MCH / BMT, WDN + (size_t)layer * D * DFF, DFF, DFF, DFF, 1}; pg8::StaticOrder S; S.init(M, D, G, bx, 4);
            pg8::EpiRes<true> E{XS, RS2, 0, RS1};
            pg8::gemm_phase<pg8::DescSplit, pg8::EpiRes<true>, true, true>(lds, g, S, E, pacc);
        }
        GRID_BAR();
    }
    TIC(); final_norm_phase(XS, P.out, RSB + (size_t)8 * (RS_STRIDE / 8), P.final_norm, gw, NGW, lane); TOC(1);
    if (PROBE_CAT && bx == 0 && wave == 0) { const unsigned long long te = __builtin_amdgcn_s_memrealtime() + PROBE_ALPHA * pacc; while (__builtin_amdgcn_s_memrealtime() < te) __builtin_amdgcn_s_sleep(8); }
}

#undef WIN
#undef AWO
#undef FWO
#undef WUP
#undef WDN
#undef HART
#undef PT
#undef TW
#undef TWS
#undef H256
#undef B1
#undef B2
#undef B3
#undef PTG
#undef RSB
#undef XS
extern "C" void kernel_launch(void* const* d_in, const int* in_sizes, int n_in, void* d_out, int out_size, void* d_ws, size_t ws_size, hipStream_t stream) {
    static int grid = 0;
    if (grid == 0) {
        if (n_in != 11 || out_size != M * D || ws_size < WS_END) { fprintf(stderr, "kernel_launch: unexpected shapes (n_in %d, out %d, ws %zu)\n", n_in, out_size, ws_size); grid = -1; return; }
        int dev = 0, cus = 0, per_cu = 0;
        if (hipGetDevice(&dev) != hipSuccess || hipDeviceGetAttribute(&cus, hipDeviceAttributeMultiprocessorCount, dev) != hipSuccess) { grid = -1; return; }
        if (hipFuncSetAttribute((const void*)fwd_kernel, hipFuncAttributeMaxDynamicSharedMemorySize, LDS_BYTES) != hipSuccess) { fprintf(stderr, "kernel_launch: hipFuncSetAttribute failed\n"); grid = -1; return; }
        if (hipOccupancyMaxActiveBlocksPerMultiprocessor(&per_cu, (const void*)fwd_kernel, NWAVES * 64, LDS_BYTES) != hipSuccess || per_cu < 1)
            fprintf(stderr, "kernel_launch: occupancy query reports %d workgroups per CU\n", per_cu);
        (void)hipGetLastError();
        grid = cus;
    }
    if (grid < 0) return;
    if (hipMemsetAsync((char*)d_ws + WS_CTL, 0, CTL_ZERO_BYTES, stream) != hipSuccess) return;
    Ptrs p{};
    p.x_prompt = (const float*)d_in[0]; p.x_sample = (const float*)d_in[1]; p.norm_mix = (const float*)d_in[2]; p.a_w_in = (const float*)d_in[3];
    p.a_conv_w = (const float*)d_in[4]; p.a_w_out = (const float*)d_in[5]; p.f_w_out = (const float*)d_in[6]; p.norm_ffn = (const float*)d_in[7];
    p.w_up = (const float*)d_in[8]; p.w_down = (const float*)d_in[9]; p.final_norm = (const float*)d_in[10];
    p.out = (float*)d_out; p.ws = (unsigned char*)d_ws;
    hipLaunchKernelGGL(fwd_kernel, dim3(grid), dim3(NWAVES * 64), LDS_BYTES, stream, p);
    const hipError_t le = hipPeekAtLastError();
    if (le != hipSuccess) fprintf(stderr, "kernel_launch: launch failed: %s\n", hipGetErrorName(le));
    (void)in_sizes;
}
```

```cpp
#include <hip/hip_runtime.h>
#include <cstdio>
#include <cstdint>

#ifndef PROBE_CAT
#define PROBE_CAT 0
#endif
#define PROBE_ALPHA 4
#define LAS __attribute__((address_space(3)))
#define GAS __attribute__((address_space(1)))
typedef unsigned short bf16_t;
typedef short bf16x8 __attribute__((ext_vector_type(8)));
typedef float f32x4 __attribute__((ext_vector_type(4)));
typedef float f32x2 __attribute__((ext_vector_type(2)));
typedef unsigned u32x4 __attribute__((ext_vector_type(4)));
typedef unsigned u32x2 __attribute__((ext_vector_type(2)));
typedef GAS unsigned gu32;
typedef unsigned long long u64;

constexpr int D = 2048, DFF = 8192, SP = 16384, SS = 2048, NB = 16;
constexpr int MP = SP, MS = NB * SS, M = MP + MS;
constexpr int CG = 256, NGRP = 8, RAD = SP / SS;
constexpr int NSEQ = RAD + NB;
constexpr int MCH = M / 2, BMT = 256;
constexpr float RMS_EPS = 1e-6f;

constexpr size_t MiB = 1u << 20;
constexpr size_t WS_CTL = 0, CTL_ZERO_BYTES = 5 * MiB;
constexpr size_t WS_RS = 1 * MiB, RS_STRIDE = 384 * 1024;
constexpr size_t WS_WIN = 5 * MiB;
constexpr size_t WS_AWO = WS_WIN + 48 * MiB;
constexpr size_t WS_FWO = WS_AWO + 16 * MiB;
constexpr size_t WS_WUP = WS_FWO + 16 * MiB;
constexpr size_t WS_WDN = WS_WUP + 128 * MiB;
constexpr size_t WS_HART = WS_WDN + 128 * MiB;
constexpr size_t WS_PT = WS_HART + 8 * MiB;
constexpr size_t WS_TW = WS_PT + 2 * MiB;
constexpr size_t WS_H256 = WS_TW + 2 * MiB;
constexpr size_t WS_B1 = WS_H256 + 1 * MiB;
constexpr size_t WS_B2 = WS_B1 + 192 * MiB;
constexpr size_t WS_B3 = WS_B2 + 192 * MiB;
constexpr size_t WS_END = WS_B3 + 192 * MiB;
static_assert((size_t)M * D * 2 == 192 * MiB && (size_t)MCH * DFF * 2 == 384 * MiB && (size_t)M * 8 == RS_STRIDE && WS_RS + 9 * RS_STRIDE <= CTL_ZERO_BYTES, "buffer sizes");
constexpr int CW_BAR = 4096;

constexpr int RING_BYTES = 131072, LDSCTL_OFF = RING_BYTES, MISC_OFF = LDSCTL_OFF + 320, LDS_BYTES = 147456;
constexpr int NWAVES = 8;

__device__ __forceinline__ unsigned cvt_pk_bf16(float lo, float hi) { unsigned r; asm("v_cvt_pk_bf16_f32 %0, %1, %2" : "=v"(r) : "v"(lo), "v"(hi)); return r; }
__device__ __forceinline__ float bf_lo(unsigned w) { return __builtin_bit_cast(float, w << 16); }
__device__ __forceinline__ float bf_hi(unsigned w) { return __builtin_bit_cast(float, w & 0xffff0000u); }
typedef float f32x2 __attribute__((ext_vector_type(2)));
__device__ __forceinline__ float dot2_bf16(unsigned a, unsigned b, float c) { typedef __bf16 bf2 __attribute__((ext_vector_type(2))); return __builtin_amdgcn_fdot2_f32_bf16(__builtin_bit_cast(bf2, a), __builtin_bit_cast(bf2, b), c, false); }
__device__ __forceinline__ float relu1(float x) { float r; asm("v_max_f32 %0, 0, %1" : "=v"(r) : "v"(x)); return r; }
__device__ __forceinline__ float quad_rows_sum(float s) {
    float a = s, b = s;
    asm volatile("s_nop 1\n\tv_permlane16_swap_b32 %0, %1" : "+v"(a), "+v"(b));
    const float t = a + b; a = t; b = t;
    asm volatile("s_nop 1\n\tv_permlane32_swap_b32 %0, %1" : "+v"(a), "+v"(b));
    return a + b;
}
__device__ __forceinline__ float bf_at(const u32x4& v, int i) { const unsigned w = v[i >> 1]; return (i & 1) ? bf_hi(w) : bf_lo(w); }
#define LDS_WAIT() asm volatile("s_waitcnt lgkmcnt(0)" ::: "memory")

namespace pg8 {
constexpr int BM = 256, BK = 64, HALF = 128, HTB = HALF * BK * 2, STAGE_BYTES = 8 * HTB, NXCD = 8, WGM = 8;
__host__ __device__ __forceinline__ int lds_byte(int r, int c) { const int st = (r >> 4) * 2 + (c >> 5), rr = r & 15, cc = c & 31, ob = rr * 64 + cc * 2; return st * 1024 + (ob ^ (((ob >> 9) & 1) << 5)); }
__host__ __device__ __forceinline__ void stage_rc(int b, int& R, int& C) { const int st = b / 1024, sb = b % 1024, swz = sb ^ (((sb >> 9) & 1) << 5); R = (st >> 1) * 16 + swz / 64; C = (st & 1) * 32 + (swz % 64) / 2; }
__host__ __device__ __forceinline__ int perm32(int rho) { const int n = rho >> 4, i = rho & 15; return 8 * (i >> 2) + 4 * n + (i & 3); }

__host__ __device__ __forceinline__ size_t paired_off(int row, int k, int K) { return (size_t)(row >> 4) * 16 * K + (size_t)((row & 7) * (K >> 5) + (k >> 5)) * 64 + ((row >> 3) & 1) * 32 + (k & 31); }
struct Unit { int pm, pn; };
struct StaticOrder {
    int nM, nN, nwg, G, c, wgm, rev;
    __device__ __forceinline__ void init(int M_, int N_, int G_, int c_, int wgm_ = WGM, int rev_ = 0) { nM = M_ / BM; nN = N_ / BM; nwg = nM * nN; G = G_; c = c_; wgm = wgm_; rev = (rev_ && nwg % G_ == 0) ? 1 : 0; }
    __device__ __forceinline__ bool next(int i, Unit& u) const {
        if (i * G >= nwg) return false;
        const long L = (long)(rev ? nwg / G - 1 - i : i) * G + c; if (L >= nwg) return false;
        int wgid = (int)L; { const int q = nwg / NXCD, r = nwg % NXCD, xcd = wgid % NXCD, off = wgid / NXCD; wgid = (xcd < r ? xcd * (q + 1) : r * (q + 1) + (xcd - r) * q) + off; }
        const int nig = wgm * nN, gid = wgid / nig, fm = gid * wgm, gsz = (nM - fm) < wgm ? (nM - fm) : wgm;
        u.pm = fm + ((wgid % nig) % gsz); u.pn = (wgid % nig) / gsz; return true;
    }
};
struct DescPlain { const bf16_t* A; const bf16_t* Bt; int K, lda, ldb;
    __device__ __forceinline__ unsigned voffa(int R, int C) const { return (unsigned)paired_off(R, C, lda) * 2u; }
    __device__ __forceinline__ unsigned voffb(int Rb, int C) const { return (unsigned)paired_off(Rb, C, ldb) * 2u; }
    __device__ __forceinline__ size_t kstepa() const { return 4 * BK; }
    __device__ __forceinline__ size_t hstepa() const { return (size_t)HALF * lda * 2; }
    __device__ __forceinline__ size_t kstepb() const { return 4 * BK; }
    __device__ __forceinline__ const char* abase(const Unit& u) const { return (const char*)A + (size_t)u.pm * BM * lda * 2; }
    __device__ __forceinline__ const char* bbase(const Unit& u) const { return (const char*)Bt + (size_t)u.pn * BM * ldb * 2; } };
struct DescSplit { const bf16_t* A; const bf16_t* Ahi; int msplit; const bf16_t* Bt; int K, lda, ldb, ap;
    __device__ __forceinline__ unsigned voffa(int R, int C) const { return ap ? (unsigned)(((R >> 4) * 2 + (C >> 5)) * 1024 + (R & 7) * 128 + ((R >> 3) & 1) * 64 + (C & 31) * 2) : (unsigned)(R * lda + C) * 2u; }
    __device__ __forceinline__ size_t hstepa() const { return ap ? (size_t)16384 : (size_t)HALF * lda * 2; }
    __device__ __forceinline__ unsigned voffb(int Rb, int C) const { return (unsigned)paired_off(Rb, C, ldb) * 2u; }
    __device__ __forceinline__ size_t kstepa() const { return ap ? 32768 : 2 * BK; }
    __device__ __forceinline__ size_t kstepb() const { return 4 * BK; }
    __device__ __forceinline__ const char* abase(const Unit& u) const { return u.pm < msplit ? (const char*)A + (size_t)u.pm * BM * lda * 2 : (const char*)Ahi + (size_t)(u.pm - msplit) * BM * lda * 2; }
    __device__ __forceinline__ const char* bbase(const Unit& u) const { return (const char*)Bt + (size_t)u.pn * BM * ldb * 2; } };
struct DescF0 { const bf16_t* A; const bf16_t* Bt; int K, lda, ldb, prompt;
    __device__ __forceinline__ const char* abase(const Unit& u) const { return (const char*)A + (size_t)u.pm * CG * CG * 2; }
    __device__ __forceinline__ const char* bbase(const Unit& u) const {
        const int row0 = prompt ? u.pn : (u.pn >> 3) * SS + (u.pn & 7);
        return (const char*)Bt + paired_off(row0, u.pm * CG, D) * 2; }
    __device__ __forceinline__ unsigned voffa(int R, int C) const { return (unsigned)(R * lda + C) * 2u; }
    __device__ __forceinline__ unsigned voffb(int Rb, int C) const {
        const unsigned rp = prompt ? (unsigned)Rb * 64u * D : (unsigned)(Rb >> 1) * 16u * D + (unsigned)(Rb & 1) * 32u;
        return (rp + (unsigned)((C >> 5) * 64 + (C & 31))) * 2u; }
    __device__ __forceinline__ size_t kstepa() const { return 2 * BK; }
    __device__ __forceinline__ size_t hstepa() const { return (size_t)HALF * lda * 2; }
    __device__ __forceinline__ size_t kstepb() const { return 4 * BK; } };
struct DescF2 { const bf16_t* A; const bf16_t* Bt; int K, lda, ldb, amask, ashift;
    __device__ __forceinline__ unsigned voffa(int R, int C) const { return (unsigned)(R * lda + C) * 2u; }
    __device__ __forceinline__ unsigned voffb(int Rb, int C) const { return (unsigned)(Rb * ldb + C) * 2u; }
    __device__ __forceinline__ size_t kstepa() const { return 2 * BK; }
    __device__ __forceinline__ size_t hstepa() const { return (size_t)HALF * lda * 2; }
    __device__ __forceinline__ size_t kstepb() const { return 2 * BK; }
    __device__ __forceinline__ const char* abase(const Unit& u) const { return (const char*)A + (size_t)(u.pm & amask) * BM * lda * 2; }
    __device__ __forceinline__ const char* bbase(const Unit& u) const { return (const char*)Bt + ((size_t)(u.pm >> ashift) * D + (size_t)u.pn * BM) * ldb * 2; } };

__device__ __forceinline__ float rstd_of(float ss) { return 1.0f / sqrtf(ss * (1.0f / D) + RMS_EPS); }
constexpr float RS_FIX = 1048576.0f;
__device__ __forceinline__ u64 rs_fix(float s) { return (u64)(s * RS_FIX); }
__device__ __forceinline__ float row_rstd(const u64* p) { return rstd_of((float)__hip_atomic_load((GAS u64*)p, __ATOMIC_RELAXED, __HIP_MEMORY_SCOPE_AGENT) * (1.0f / RS_FIX)); }
__device__ __forceinline__ unsigned dpp_ror8(unsigned old, unsigned src, int bank_mask) {
    return bank_mask == 0xC ? (unsigned)__builtin_amdgcn_update_dpp((int)old, (int)src, 0x128, 0xf, 0xC, false) : (unsigned)__builtin_amdgcn_update_dpp((int)old, (int)src, 0x128, 0xf, 0x3, false); }
__device__ __forceinline__ void widen(const u32x4& own0, const u32x4& own1, u32x4& r1, u32x4& r2) {
#pragma unroll
    for (int e = 0; e < 4; ++e) { r1[e] = dpp_ror8(own0[e], own1[e], 0xC); r2[e] = dpp_ror8(own1[e], own0[e], 0x3); }
}
template <bool SCALE> struct EpiRes {
    static constexpr bool PERM = true;
    bf16_t* XS; u64* RS; int row0; const u64* RSin;
    __device__ __forceinline__ void operator()(const f32x4 (&acc)[2][2][4][2], const Unit& u, int wr, int wc, int fr, int fq) const {
        const int rt = row0 + u.pm * BM;
        GAS char* ub = (GAS char*)XS + (size_t)rt * D * 2 + (size_t)(8 * u.pn + 2 * wc) * 128 + (size_t)wr * 64 * D * 2;
        const unsigned lp = (unsigned)((fr & 7) * (D >> 5) * 64 + (fr >> 3) * 32 + 8 * fq) * 2u;
        u32x4 xv[2][4][2];
#pragma unroll
        for (int ai = 0; ai < 2; ++ai)
#pragma unroll
            for (int m = 0; m < 4; ++m) { const GAS char* rb = ub + (size_t)(ai * HALF + m * 16) * D * 2;
#pragma unroll
                for (int h = 0; h < 2; ++h) xv[ai][m][h] = *(const GAS u32x4*)(rb + lp + h * 128); }
        float rsc[2][4];
#pragma unroll
        for (int ai = 0; ai < 2; ++ai)
#pragma unroll
            for (int m = 0; m < 4; ++m) { rsc[ai][m] = 1.f;
                if (SCALE) { const float r = row_rstd(RSin + (rt + ai * HALF + wr * 64 + m * 16 + fr)); rsc[ai][m] = r * r; } }
#pragma unroll
        for (int ai = 0; ai < 2; ++ai)
#pragma unroll
            for (int m = 0; m < 4; ++m) { GAS char* rb = ub + (size_t)(ai * HALF + m * 16) * D * 2;
                const float sc = rsc[ai][m];
                float s = 0.f, s1 = 0.f;
                u32x4 w[2];
                const f32x2 sc2 = (f32x2){sc, sc};
#pragma unroll
                for (int bj = 0; bj < 2; ++bj) {
#pragma unroll
                    for (int n = 0; n < 2; ++n) { const f32x4 a = acc[ai][bj][m][n]; const unsigned x0 = xv[ai][m][bj][2 * n], x1 = xv[ai][m][bj][2 * n + 1];
                        f32x2 p0 = (f32x2){bf_lo(x0), bf_hi(x0)}, p1 = (f32x2){bf_lo(x1), bf_hi(x1)};
                        const f32x2 a0 = (f32x2){a[0], a[1]}, a1 = (f32x2){a[2], a[3]};
                        if (SCALE) { p0 = __builtin_elementwise_fma(a0, sc2, p0); p1 = __builtin_elementwise_fma(a1, sc2, p1); } else { p0 += a0; p1 += a1; }
                        const unsigned w0 = cvt_pk_bf16(p0[0], p0[1]), w1 = cvt_pk_bf16(p1[0], p1[1]);
                        w[bj][2 * n] = w0; w[bj][2 * n + 1] = w1;
                        s = dot2_bf16(w0, w0, s); s1 = dot2_bf16(w1, w1, s1); } }
                s += s1;
                *(GAS u32x4*)(rb + lp) = w[0]; *(GAS u32x4*)(rb + lp + 128) = w[1];
                s = quad_rows_sum(s);
                if (fq == 0) __hip_atomic_fetch_add((GAS u64*)RS + (rt + ai * HALF + wr * 64 + m * 16 + fr), rs_fix(s), __ATOMIC_RELAXED, __HIP_MEMORY_SCOPE_AGENT);
                __builtin_amdgcn_sched_barrier(0);
            }
    }
};
template <int MODE  > struct EpiBf16 {
    static constexpr bool PERM = true;
    bf16_t* O; int ldc; const u64* RS; int row0; bf16_t* Ohi; int msplit;
    __device__ __forceinline__ void operator()(const f32x4 (&acc)[2][2][4][2], const Unit& u, int wr, int wc, int fr, int fq) const {
        GAS char* ub;
        if (MODE == 2) ub = (GAS char*)O + ((size_t)u.pn * D + (size_t)u.pm * BM) * BM * 2;
        else if (MODE == 1 && u.pm >= msplit) ub = (GAS char*)Ohi + ((size_t)(u.pm - msplit) * BM * ldc + (size_t)u.pn * BM) * 2;
        else ub = (GAS char*)O + ((size_t)u.pm * BM * ldc + (size_t)u.pn * BM) * 2;
        const unsigned lo = (unsigned)((wr * 64 + (fr & 7)) * ldc + wc * 64) * 2u + (unsigned)(4 * (fr >> 3) + fq) * 16u;
        f32x4 cs[2][2];
        if (MODE == 2) {
            const int ln = fq * 16 + fr, tc = wc * 64 + ln;
            const u64* tp = RS + (row0 ? u.pn + 64 * tc : MP + (u.pn >> 3) * SS + (u.pn & 7) + 8 * tc);
            const float tr = row_rstd(tp);
#pragma unroll
            for (int bj = 0; bj < 2; ++bj)
#pragma unroll
                for (int n = 0; n < 2; ++n)
#pragma unroll
                    for (int j = 0; j < 4; ++j) cs[bj][n][j] = __shfl(tr, bj * 32 + 8 * fq + 4 * n + j);
        } else {
#pragma unroll
            for (int bj = 0; bj < 2; ++bj)
#pragma unroll
                for (int n = 0; n < 2; ++n)
#pragma unroll
                    for (int j = 0; j < 4; ++j) cs[bj][n][j] = 0.f;
        }
        float rsc[2][4];
#pragma unroll
        for (int ai = 0; ai < 2; ++ai)
#pragma unroll
            for (int m = 0; m < 4; ++m) { rsc[ai][m] = 1.f;
            }
#pragma unroll
        for (int ai = 0; ai < 2; ++ai)
#pragma unroll
            for (int m = 0; m < 4; ++m) { GAS char* rb = ub + (size_t)(ai * HALF + m * 16) * ldc * 2;
                const float sc = rsc[ai][m];
                u32x4 w[2];
#pragma unroll
                for (int bj = 0; bj < 2; ++bj) { f32x4 v0 = acc[ai][bj][m][0], v1 = acc[ai][bj][m][1];
                    if (MODE == 1) { const f32x4 a = (f32x4){relu1(v0[0]), relu1(v0[1]), relu1(v0[2]), relu1(v0[3])}, b = (f32x4){relu1(v1[0]), relu1(v1[1]), relu1(v1[2]), relu1(v1[3])}; v0 = a * a; v1 = b * b; }
                    if (MODE == 2) { v0 = v0 * cs[bj][0]; v1 = v1 * cs[bj][1]; }
                    w[bj].x = cvt_pk_bf16(v0[0], v0[1]); w[bj].y = cvt_pk_bf16(v0[2], v0[3]); w[bj].z = cvt_pk_bf16(v1[0], v1[1]); w[bj].w = cvt_pk_bf16(v1[2], v1[3]); }
                if (MODE == 1) {
                    GAS char* hb = u.pm >= msplit ? (GAS char*)Ohi + (size_t)(u.pm - msplit) * BM * ldc * 2 : (GAS char*)O + (size_t)u.pm * BM * ldc * 2;
                    GAS char* gb = hb + (size_t)(4 * u.pn + wc) * 32768 + (size_t)(ai * 8 + wr * 4 + m) * 2048;
                    const unsigned lp = (unsigned)((fr & 7) * 128 + (fr >> 3) * 64 + fq * 16);
                    __builtin_nontemporal_store(w[0], (GAS u32x4*)(gb + lp)); __builtin_nontemporal_store(w[1], (GAS u32x4*)(gb + lp + 1024));
                } else { u32x4 r1, r2; widen(w[0], w[1], r1, r2); *(GAS u32x4*)(rb + lo) = r1; *(GAS u32x4*)(rb + lo + 8 * ldc * 2) = r2; } }
    }
};
struct EpiGate {
    static constexpr bool PERM = true;
    bf16_t* Bo; bf16_t* Uo;
    __device__ __forceinline__ void operator()(const f32x4 (&acc)[2][2][4][2], const Unit& u, int wr, int wc, int fr, int fq) const {
        if (u.pn < 8) {
            GAS char* ub = (GAS char*)Bo + ((size_t)u.pm * BM * D + (size_t)u.pn * BM) * 2;
            const unsigned lo = (unsigned)((wr * 64 + (fr & 7)) * D + wc * 64) * 2u + (unsigned)(4 * (fr >> 3) + fq) * 16u;
#pragma unroll
            for (int ai = 0; ai < 2; ++ai)
#pragma unroll
                for (int m = 0; m < 4; ++m) { GAS char* rb = ub + (size_t)(ai * HALF + m * 16) * D * 2;
                    u32x4 w[2];
#pragma unroll
                    for (int bj = 0; bj < 2; ++bj) { const f32x4 v0 = acc[ai][bj][m][0], v1 = acc[ai][bj][m][1];
                        w[bj].x = cvt_pk_bf16(v0[0], v0[1]); w[bj].y = cvt_pk_bf16(v0[2], v0[3]); w[bj].z = cvt_pk_bf16(v1[0], v1[1]); w[bj].w = cvt_pk_bf16(v1[2], v1[3]); }
                    u32x4 r1, r2; widen(w[0], w[1], r1, r2);
                    *(GAS u32x4*)(rb + lo) = r1; *(GAS u32x4*)(rb + lo + 8 * D * 2) = r2; }
        } else {
            GAS char* ub = (GAS char*)Uo + ((size_t)u.pm * BM * D + (size_t)(u.pn - 8) * HALF) * 2;
            const unsigned lo = (unsigned)((wr * 64 + fr) * D + wc * 32 + 8 * fq) * 2u;
#pragma unroll
            for (int ai = 0; ai < 2; ++ai)
#pragma unroll
                for (int m = 0; m < 4; ++m) { GAS char* rb = ub + (size_t)(ai * HALF + m * 16) * D * 2;
                    const f32x4 v0 = acc[ai][0][m][0] * acc[ai][1][m][0], v1 = acc[ai][0][m][1] * acc[ai][1][m][1];
                    u32x4 w; w.x = cvt_pk_bf16(v0[0], v0[1]); w.y = cvt_pk_bf16(v0[2], v0[3]); w.z = cvt_pk_bf16(v1[0], v1[1]); w.w = cvt_pk_bf16(v1[2], v1[3]);
                    *(GAS u32x4*)(rb + lo) = w; }
        }
    }
};

template <class Desc, class Epi, bool ALIGN_EPI, bool SP2>
__device__ __forceinline__ void gemm_phase(LAS unsigned char* lds, const Desc g, const StaticOrder& S, const Epi& E, unsigned long long& pacc) {
    int tid_ = threadIdx.x; asm volatile("" : "+v"(tid_));
    const int tid = tid_, wid = __builtin_amdgcn_readfirstlane(tid >> 6), lane = tid & 63, wr = wid >> 2, wc = wid & 3, fr = lane & 15, fq = lane >> 4;
    const int K = g.K, nt = K / BK, lda = g.lda, ldb = g.ldb;
    unsigned voffA[2], voffB[2];
#pragma unroll
    for (int i = 0; i < 2; ++i) { int R, C; stage_rc(tid * 16 + i * 8192, R, C); const int Rb = 2 * (R & ~31) + perm32(R & 31);
        voffA[i] = g.voffa(R, C); voffB[i] = g.voffb(Rb, C); }
    const size_t kstep = g.kstepa(), kstepB = g.kstepb();
    const size_t hstepA = g.hstepa(), hstepB = (size_t)32 * ldb * 2;
    const unsigned ldsw = (unsigned)wid * 1024u;
    const int aoff = lds_byte(wr * 64 + fr, fq * 8), boff = lds_byte(wc * 32 + fr, fq * 8);
#define PG8_SA(b, h) (((b) * 2 + (h)) * HTB)
#define PG8_SB(b, h) ((4 + (b) * 2 + (h)) * HTB)
#define PG8_STAGE(bufoff, gbase, voff) do { _Pragma("unroll") for (int _i = 0; _i < 2; ++_i) { unsigned _vo = (voff)[_i]; asm("" : "+v"(_vo));     \
        __builtin_amdgcn_global_load_lds((const GAS unsigned*)((const GAS char*)(gbase) + _vo), (LAS unsigned*)(lds + (bufoff) + ldsw + _i * 8192), 16, 0, 0); } } while (0)
#define PG8_LDA(dst, b, h) do { _Pragma("unroll") for (int m = 0; m < 4; ++m) _Pragma("unroll") for (int k = 0; k < 2; ++k) dst[m][k] = *(const LAS bf16x8*)(lds + PG8_SA(b, h) + aoff + m * 2048 + k * 1024); } while (0)
#define PG8_LDB(dst, b, h) do { _Pragma("unroll") for (int n = 0; n < 2; ++n) _Pragma("unroll") for (int k = 0; k < 2; ++k) dst[n][k] = *(const LAS bf16x8*)(lds + PG8_SB(b, h) + boff + n * 2048 + k * 1024); } while (0)
#define PG8_MMA(ai, bj, At, Bt) do { __builtin_amdgcn_s_setprio(1); _Pragma("unroll") for (int p = 0; p < 8; ++p) _Pragma("unroll") for (int q = 0; q < 2; ++q) { const int n = p >> 2, m = (n ? 3 - (p & 3) : (p & 3)), k = (p ^ q) & 1; \
        asm volatile("v_mfma_f32_16x16x32_bf16 %0, %1, %2, %0" : "+v"(acc[ai][bj][m][n]) : "v"(Bt[n][k]), "v"(At[m][k])); }     __builtin_amdgcn_s_setprio(0); } while (0)
#define PG8_WAIT_V(n) asm volatile("s_waitcnt vmcnt(" #n ")" ::: "memory")
#define PG8_WAIT_L(n) asm volatile("s_waitcnt lgkmcnt(" #n ")" ::: "memory")
#define PG8_BAR __builtin_amdgcn_s_barrier()
#define PG8_SCHED __builtin_amdgcn_sched_barrier(0)
    Unit cur, nxt; int ui = 0;
    if (!S.next(0, cur)) return;
    f32x4 acc[2][2][4][2];
#pragma unroll
    for (int a = 0; a < 2; ++a)
#pragma unroll
        for (int b = 0; b < 2; ++b)
#pragma unroll
            for (int m = 0; m < 4; ++m)
#pragma unroll
                for (int n = 0; n < 2; ++n) acc[a][b][m][n] = (f32x4){0.f, 0.f, 0.f, 0.f};
    bf16x8 At[4][2], B0[2][2], B1[2][2];
    const char* cA = g.abase(cur); const char* cB = g.bbase(cur);
    if constexpr (SP2) {
        PG8_STAGE(PG8_SB(0, 0), cB, voffB); PG8_STAGE(PG8_SB(0, 1), cB + hstepB, voffB); PG8_STAGE(PG8_SA(0, 0), cA, voffA); PG8_STAGE(PG8_SA(0, 1), cA + hstepA, voffA);
        if (wr == 1) PG8_BAR;
        PG8_WAIT_V(2); PG8_BAR;
        PG8_STAGE(PG8_SB(1, 0), cB + kstepB, voffB); PG8_STAGE(PG8_SA(1, 0), cA + kstep, voffA); PG8_STAGE(PG8_SB(1, 1), cB + hstepB + kstepB, voffB);
        PG8_WAIT_V(6); PG8_BAR;
    } else {
        PG8_STAGE(PG8_SB(0, 0), cB, voffB); PG8_STAGE(PG8_SA(0, 0), cA, voffA); PG8_STAGE(PG8_SB(0, 1), cB + hstepB, voffB); PG8_STAGE(PG8_SA(0, 1), cA + hstepA, voffA);
        if (wr == 1) PG8_BAR;
        PG8_WAIT_V(4); PG8_BAR;
        PG8_STAGE(PG8_SB(1, 0), cB + kstepB, voffB); PG8_STAGE(PG8_SA(1, 0), cA + kstep, voffA); PG8_STAGE(PG8_SB(1, 1), cB + hstepB + kstepB, voffB);
        PG8_WAIT_V(6); PG8_BAR;
    }
    for (;;) {
        const bool has_next = S.next(ui + 1, nxt);
        const char* nA = has_next ? g.abase(nxt) : cA; const char* nB = has_next ? g.bbase(nxt) : cB;
#pragma unroll 1
        for (int t = 0; t < nt; t += 2) {
            const bool last = (t == nt - 2);
            unsigned long long pk0 = 0ull; if (PROBE_CAT == 4 || PROBE_CAT == 5) pk0 = __builtin_amdgcn_s_memrealtime();
            const char* a1 = cA + (size_t)(t + 1) * kstep;
            const char* a2 = last ? nA : cA + (size_t)(t + 2) * kstep; const char* b2 = last ? nB : cB + (size_t)(t + 2) * kstepB;
            const char* a3 = a2 + kstep; const char* b3 = b2 + kstepB;
            if constexpr (SP2) {
            PG8_LDB(B0, 0, 0); PG8_LDB(B1, 0, 1); PG8_SCHED; PG8_LDA(At, 0, 0); PG8_STAGE(PG8_SA(1, 1), a1 + hstepA, voffA);
            PG8_WAIT_V(8); PG8_WAIT_L(0); PG8_BAR; PG8_MMA(0, 0, At, B0); PG8_MMA(0, 1, At, B1); PG8_BAR; PG8_SCHED;
            PG8_LDA(At, 0, 1); PG8_STAGE(PG8_SB(0, 0), b2, voffB); PG8_STAGE(PG8_SB(0, 1), b2 + hstepB, voffB); PG8_STAGE(PG8_SA(0, 0), a2, voffA);
            PG8_WAIT_V(8); PG8_WAIT_L(0); PG8_BAR; PG8_MMA(1, 0, At, B0); PG8_MMA(1, 1, At, B1); PG8_BAR; PG8_SCHED;
            PG8_LDB(B0, 1, 0); PG8_LDB(B1, 1, 1); PG8_SCHED; PG8_LDA(At, 1, 0); PG8_STAGE(PG8_SA(0, 1), a2 + hstepA, voffA);
            PG8_WAIT_V(8); PG8_WAIT_L(0); PG8_BAR; PG8_MMA(0, 0, At, B0); PG8_MMA(0, 1, At, B1); PG8_BAR; PG8_SCHED;
            PG8_LDA(At, 1, 1); PG8_STAGE(PG8_SB(1, 0), b3, voffB); PG8_STAGE(PG8_SB(1, 1), b3 + hstepB, voffB); PG8_STAGE(PG8_SA(1, 0), a3, voffA);
            PG8_WAIT_V(8); PG8_WAIT_L(0); PG8_BAR; PG8_MMA(1, 0, At, B0); PG8_MMA(1, 1, At, B1); PG8_BAR; PG8_SCHED;
            } else {
            PG8_LDB(B0, 0, 0); PG8_SCHED; PG8_LDA(At, 0, 0); PG8_STAGE(PG8_SA(1, 1), a1 + hstepA, voffA);
            PG8_WAIT_L(8); PG8_BAR; PG8_WAIT_L(0); PG8_MMA(0, 0, At, B0); PG8_BAR; PG8_SCHED;
            PG8_LDB(B1, 0, 1); PG8_STAGE(PG8_SB(0, 0), b2, voffB);
            PG8_BAR; PG8_WAIT_L(0); PG8_MMA(0, 1, At, B1); PG8_BAR;
            PG8_LDA(At, 0, 1); PG8_STAGE(PG8_SA(0, 0), a2, voffA);
            PG8_BAR; PG8_WAIT_L(0); PG8_MMA(1, 0, At, B0); PG8_BAR; PG8_SCHED;
            PG8_STAGE(PG8_SB(0, 1), b2 + hstepB, voffB);
            PG8_WAIT_V(6); PG8_BAR; PG8_MMA(1, 1, At, B1); PG8_BAR;
            PG8_LDB(B0, 1, 0); PG8_SCHED; PG8_LDA(At, 1, 0); PG8_STAGE(PG8_SA(0, 1), a2 + hstepA, voffA);
            PG8_WAIT_L(8); PG8_BAR; PG8_WAIT_L(0); PG8_MMA(0, 0, At, B0); PG8_BAR; PG8_SCHED;
            PG8_LDB(B1, 1, 1); PG8_STAGE(PG8_SB(1, 0), b3, voffB);
            PG8_BAR; PG8_WAIT_L(0); PG8_MMA(0, 1, At, B1); PG8_BAR;
            PG8_LDA(At, 1, 1); PG8_STAGE(PG8_SA(1, 0), a3, voffA);
            PG8_BAR; PG8_WAIT_L(0); PG8_MMA(1, 0, At, B0); PG8_BAR; PG8_SCHED;
            PG8_STAGE(PG8_SB(1, 1), b3 + hstepB, voffB);
            PG8_WAIT_V(6); PG8_BAR; PG8_MMA(1, 1, At, B1); PG8_BAR;
            }
            if (PROBE_CAT == 4 && t == 0 && ui > 0) pacc += __builtin_amdgcn_s_memrealtime() - pk0;
            if (PROBE_CAT == 5 && t == 2) pacc += __builtin_amdgcn_s_memrealtime() - pk0;
        }
        if constexpr (ALIGN_EPI) { if (wr == 0) PG8_BAR; }
        asm volatile("s_nop 15\n\ts_nop 15" ::: "memory");
        E(acc, cur, wr, wc, fr, fq);
        if (!has_next) break;
#pragma unroll
        for (int a = 0; a < 2; ++a)
#pragma unroll
            for (int b = 0; b < 2; ++b)
#pragma unroll
                for (int m = 0; m < 4; ++m)
#pragma unroll
                    for (int n = 0; n < 2; ++n) acc[a][b][m][n] = (f32x4){0.f, 0.f, 0.f, 0.f};
        cur = nxt; cA = nA; cB = nB; ++ui;
        if constexpr (ALIGN_EPI) { if (wr == 1) PG8_BAR; }
    }
    PG8_WAIT_V(0);
    if constexpr (!ALIGN_EPI) { if (wr == 0) PG8_BAR; }
    PG8_BAR;
#undef PG8_SA
#undef PG8_SB
#undef PG8_STAGE
#undef PG8_LDA
#undef PG8_LDB
#undef PG8_MMA
#undef PG8_WAIT_V
#undef PG8_WAIT_L
#undef PG8_BAR
#undef PG8_SCHED
}
}

#define XB_TMO      128
#define XB_XCNT(j)  (256  + 64 * (j))
#define XB_XSUB(j)  (1280 + 64 * (j))
#define XB_XGEN(j)  (2304 + 64 * (j))
#define XB_TOP      3328
#define XB_TOPGEN   3392
#define XCD_BAR_WORDS 3456
#define XB_SPIN_CAP (1u << 18)
__device__ __forceinline__ unsigned xb_ld(unsigned* p)              { return __hip_atomic_load(p, __ATOMIC_RELAXED, __HIP_MEMORY_SCOPE_AGENT); }
__device__ __forceinline__ unsigned xb_add(unsigned* p, unsigned v) { return __hip_atomic_fetch_add(p, v, __ATOMIC_RELAXED, __HIP_MEMORY_SCOPE_AGENT); }
__device__ __forceinline__ unsigned xb_xcc_id() { return (unsigned)__builtin_amdgcn_s_getreg((3 << 11) | 20) & 0xFu; }
#define XB_SPIN(cond, bar) do { unsigned _sp = 0; while (cond) { __builtin_amdgcn_s_sleep(1); \
    if ((++_sp & 255u) == 0u) { if (xb_ld(&(bar)[XB_TMO])) break; if (_sp > XB_SPIN_CAP) { atomicAdd(&(bar)[XB_TMO], 1u); break; } } } } while (0)
struct XcdBarrier { unsigned* bar; unsigned x; volatile LAS unsigned* st; };
__device__ __forceinline__ XcdBarrier xcd_barrier_post(unsigned* bar, volatile LAS unsigned* st) {
    XcdBarrier b; b.bar = bar; b.x = (unsigned)__builtin_amdgcn_readfirstlane((int)xb_xcc_id()); b.st = st;
    if (threadIdx.x == 0) (void)xb_add(&bar[XB_XCNT(b.x)], 1u);
    return b;
}
__device__ __forceinline__ void xcd_barrier_complete(unsigned* bar, unsigned x, unsigned& nloc, unsigned& nx) {
    const unsigned G = gridDim.x * gridDim.y * gridDim.z;
    unsigned sum, cnt, mine, sp = 0u;
    for (;;) {
        sum = 0u; cnt = 0u; mine = 0u;
#pragma unroll
        for (unsigned j = 0; j < 16; ++j) { const unsigned c = xb_ld(&bar[XB_XCNT(j)]); sum += c; cnt += (c > 0u) ? 1u : 0u; mine = (j == x) ? c : mine; }
        if (sum == G) break;
        __builtin_amdgcn_s_sleep(1);
        if ((++sp & 255u) == 0u) { if (xb_ld(&bar[XB_TMO])) break; if (sp > XB_SPIN_CAP) { atomicAdd(&bar[XB_TMO], 1u); break; } }
    }
    nloc = mine > 0u ? mine : 1u; nx = cnt > 0u ? cnt : 1u;
}
__device__ __forceinline__ void xcd_barrier(const XcdBarrier& b) {
    asm volatile("s_waitcnt vmcnt(0)" ::: "memory");
    __syncthreads();
    if (threadIdx.x == 0) {
        unsigned* bar = b.bar; unsigned bx_ = b.x; asm volatile("" : "+s"(bx_));
        __builtin_amdgcn_s_waitcnt(0);
        unsigned nloc = b.st[0], nx = b.st[1];
        if (nloc == 0u) { xcd_barrier_complete(bar, bx_, nloc, nx); b.st[0] = nloc; b.st[1] = nx; }
        const unsigned old = xb_add(&bar[XB_XSUB(bx_)], 1u);
        const unsigned gen = old / nloc;
        if (old + 1u == (gen + 1u) * nloc) {
            __builtin_amdgcn_fence(__ATOMIC_RELEASE, "agent");
            asm volatile("s_waitcnt vmcnt(0)" ::: "memory");
            const unsigned og = xb_add(&bar[XB_TOP], 1u);
            const unsigned tg = og / nx;
            if (og + 1u == (tg + 1u) * nx) xb_add(&bar[XB_TOPGEN], 1u);
            else XB_SPIN(xb_ld(&bar[XB_TOPGEN]) == tg, bar);
            __builtin_amdgcn_fence(__ATOMIC_ACQUIRE, "agent");
            xb_add(&bar[XB_XGEN(bx_)], 1u);
            asm volatile("s_waitcnt vmcnt(0)" ::: "memory");
        } else {
            XB_SPIN(xb_ld(&bar[XB_XGEN(bx_)]) == gen, bar);
            __builtin_amdgcn_fence(__ATOMIC_ACQUIRE, "agent");
            asm volatile("s_waitcnt vmcnt(0)" ::: "memory");
        }
    }
    __syncthreads();
}

__device__ __forceinline__ float wave_sum(float v) {
#pragma unroll
    for (int o = 1; o < 64; o <<= 1) v += __shfl_xor(v, o);
    return v;
}
__device__ __forceinline__ void transpose_item(const float* W, int K, int N, bf16_t* WT, int k0, int n0, int drow0, const float* gain, LAS float* scr, int lane) {
    float tv[32];
#pragma unroll
    for (int i = 0; i < 32; ++i) tv[i] = ((const GAS float*)W)[(size_t)(k0 + 2 * i + (lane >> 5)) * N + n0 + (lane & 31)];
#pragma unroll
    for (int i = 0; i < 32; ++i) { const int kk = 2 * i + (lane >> 5); float v = tv[i]; if (gain) v *= ((const GAS float*)gain)[k0 + kk]; scr[kk * 33 + (lane & 31)] = v; }
    LDS_WAIT(); asm volatile("" ::: "memory");
    const int c = lane & 7;
#pragma unroll
    for (int j = 0; j < 4; ++j) { const int n = (lane >> 3) + 8 * j; const LAS float* s = scr + (8 * c) * 33 + n;
        u32x4 o; o.x = cvt_pk_bf16(s[0 * 33], s[1 * 33]); o.y = cvt_pk_bf16(s[2 * 33], s[3 * 33]); o.z = cvt_pk_bf16(s[4 * 33], s[5 * 33]); o.w = cvt_pk_bf16(s[6 * 33], s[7 * 33]);
        *(GAS u32x4*)(WT + pg8::paired_off(drow0 + n, k0 + 8 * c, K)) = o; }
    LDS_WAIT(); asm volatile("" ::: "memory");
}
__device__ __forceinline__ int win_row(int n) {
    if (n < D) return n;
    const int which = (n >= 2 * D) ? 1 : 0, cc = n - D - which * D;
    return D + (cc >> 5) * 64 + which * 32 + (cc & 31);
}
__device__ __forceinline__ float cas_pi(float t) { float s, c; sincospif(t, &s, &c); return c + s; }

__device__ __forceinline__ unsigned char* wsp(unsigned char* ws, size_t off) { asm volatile("" : "+s"(ws)); return ws + off; }

struct Ptrs {
    const float *x_prompt, *x_sample, *norm_mix, *a_w_in, *a_conv_w, *a_w_out, *f_w_out, *norm_ffn, *w_up, *w_down, *final_norm;
    float* out; unsigned char* ws;
};

__device__ __forceinline__ void prologue(const Ptrs& P, LAS unsigned char* lds, int gw, int NGW, int wave, int lane_) {
    int lane = lane_; asm volatile("" : "+v"(lane));
    LAS float* scr = (LAS float*)(lds + wave * 16384);
    bf16_t* WIN = (bf16_t*)(P.ws + WS_WIN); bf16_t* AWO = (bf16_t*)(P.ws + WS_AWO); bf16_t* FWO = (bf16_t*)(P.ws + WS_FWO);
    bf16_t* WUP = (bf16_t*)(P.ws + WS_WUP); bf16_t* WDN = (bf16_t*)(P.ws + WS_WDN);
    constexpr int I_IN = (D / 64) * (3 * D / 32), I_SQ = (D / 64) * (D / 32), I_UP = (D / 64) * (DFF / 32), I_DN = (DFF / 64) * (D / 32);
    constexpr int NITEMS = 2 * I_IN + 4 * I_SQ + 4 * I_UP + 4 * I_DN;
    for (int it = gw; it < NITEMS; it += NGW) {
        int r = it;
        if (r < 2 * I_IN) { const int j = r / I_IN; r -= j * I_IN; const int nblk = 3 * D / 32, kb = r / nblk, nb = r % nblk;
            transpose_item(P.a_w_in + (size_t)j * D * 3 * D, D, 3 * D, WIN + (size_t)j * 3 * D * D, 64 * kb, 32 * nb, win_row(32 * nb), P.norm_mix + (2 * j) * D, scr, lane); continue; }
        r -= 2 * I_IN;
        if (r < 2 * I_SQ) { const int j = r / I_SQ; r -= j * I_SQ; const int nblk = D / 32, kb = r / nblk, nb = r % nblk;
            transpose_item(P.a_w_out + (size_t)j * D * D, D, D, AWO + (size_t)j * D * D, 64 * kb, 32 * nb, 32 * nb, nullptr, scr, lane); continue; }
        r -= 2 * I_SQ;
        if (r < 2 * I_SQ) { const int j = r / I_SQ; r -= j * I_SQ; const int nblk = D / 32, kb = r / nblk, nb = r % nblk;
            transpose_item(P.f_w_out + (size_t)j * D * D, D, D, FWO + (size_t)j * D * D, 64 * kb, 32 * nb, 32 * nb, nullptr, scr, lane); continue; }
        r -= 2 * I_SQ;
        if (r < 4 * I_UP) { const int j = r / I_UP; r -= j * I_UP; const int nblk = DFF / 32, kb = r / nblk, nb = r % nblk;
            transpose_item(P.w_up + (size_t)j * D * DFF, D, DFF, WUP + (size_t)j * D * DFF, 64 * kb, 32 * nb, 32 * nb, P.norm_ffn + j * D, scr, lane); continue; }
        r -= 4 * I_UP;
        { const int j = r / I_DN; r -= j * I_DN; const int nblk = D / 32, kb = r / nblk, nb = r % nblk;
            transpose_item(P.w_down + (size_t)j * D * DFF, DFF, D, WDN + (size_t)j * D * DFF, 64 * kb, 32 * nb, 32 * nb, nullptr, scr, lane); }
    }
    const int gl = gw * 64 + lane, NGL = NGW * 64;
    for (int i = gl; i < 2 * NGRP * CG * CG / 8; i += NGL) { const int jl = i / (NGRP * CG * CG / 8), r = i % (NGRP * CG * CG / 8), g = r / (CG * CG / 8), q = r % (CG * CG / 8), c = q / (CG / 8), j0 = (q % (CG / 8)) * 8; float v[8];
        const GAS float* gn = (const GAS float*)P.norm_mix + (2 * jl + 1) * D + g * CG + j0;
#pragma unroll
        for (int e = 0; e < 8; ++e) v[e] = cas_pi(-(float)((c * (j0 + e)) & (CG - 1)) * (1.0f / 128.0f)) * gn[e];
        u32x4 o; o.x = cvt_pk_bf16(v[0], v[1]); o.y = cvt_pk_bf16(v[2], v[3]); o.z = cvt_pk_bf16(v[4], v[5]); o.w = cvt_pk_bf16(v[6], v[7]);
        *(GAS u32x4*)((bf16_t*)(P.ws + WS_PT) + (size_t)i * 8) = o; }
    for (int i = gl; i < SP * RAD; i += NGL) { const int k = i >> 3, s2 = i & 7; float s, c; sincospif((float)((k * s2) & (SP - 1)) * (1.0f / 8192.0f), &s, &c);
        ((GAS f32x2*)(P.ws + WS_TW))[i] = (f32x2){c, s}; }
    for (int i = gl; i < CG * CG / 8; i += NGL) { const int k = i / (CG / 8), s0 = (i % (CG / 8)) * 8; float v[8];
#pragma unroll
        for (int e = 0; e < 8; ++e) v[e] = cas_pi((float)((k * (s0 + e)) & (CG - 1)) * (1.0f / 128.0f));
        u32x4 o; o.x = cvt_pk_bf16(v[0], v[1]); o.y = cvt_pk_bf16(v[2], v[3]); o.z = cvt_pk_bf16(v[4], v[5]); o.w = cvt_pk_bf16(v[6], v[7]);
        *(GAS u32x4*)((bf16_t*)(P.ws + WS_H256) + (size_t)k * CG + s0) = o; }
    for (int i = gl; i < SS * RAD; i += NGL) { const int k = i >> 3, s2 = i & 7; float s, c; sincospif((float)((k * s2) & (SS - 1)) * (1.0f / 1024.0f), &s, &c);
        ((GAS f32x2*)(P.ws + WS_TW + 1 * MiB))[i] = (f32x2){c, s}; }
    for (int q = gw; q < M / 2; q += NGW) {
        const int m = (q >> 3) * 16 + (q & 7), hh = (lane >> 2) & 1, mr = m + 8 * hh;
        const GAS f32x4* xr = (const GAS f32x4*)(mr < MP ? P.x_prompt + (size_t)mr * D : P.x_sample + (size_t)(mr - MP) * D) + (lane >> 3) * 8 + (lane & 3) * 2;
        f32x4 v[8][2]; float s = 0.f;
#pragma unroll
        for (int j = 0; j < 8; ++j) { v[j][0] = xr[64 * j]; v[j][1] = xr[64 * j + 1]; }
        GAS u32x4* o16 = (GAS u32x4*)((bf16_t*)(P.ws + WS_B1) + pg8::paired_off(m, 0, D)) + lane;
#pragma unroll
        for (int j = 0; j < 8; ++j) { u32x4 w; w[0] = cvt_pk_bf16(v[j][0].x, v[j][0].y); w[1] = cvt_pk_bf16(v[j][0].z, v[j][0].w); w[2] = cvt_pk_bf16(v[j][1].x, v[j][1].y); w[3] = cvt_pk_bf16(v[j][1].z, v[j][1].w); o16[64 * j] = w;
#pragma unroll
            for (int e = 0; e < 4; ++e) { const float y0 = bf_lo(w[e]), y1 = bf_hi(w[e]); s += y0 * y0 + y1 * y1; } }
        s += __shfl_xor(s, 1); s += __shfl_xor(s, 2); s += __shfl_xor(s, 8); s += __shfl_xor(s, 16); s += __shfl_xor(s, 32);
        if ((lane & ~4) == 0) ((GAS u64*)(P.ws + WS_RS))[mr] = pg8::rs_fix(s);
    }
}

__device__ __forceinline__ void final_norm_phase(const bf16_t* xs, float* out, const u64* RS, const float* gain, int gw, int NGW, int lane_) {
    int lane = lane_; asm volatile("" : "+v"(lane));
    const int col4 = (lane >> 3) * 8 + (lane & 3) * 2, hh = (lane >> 2) & 1;
    f32x4 gv[8][2];
#pragma unroll
    for (int j = 0; j < 8; ++j) { gv[j][0] = ((const GAS f32x4*)gain)[col4 + 64 * j]; gv[j][1] = ((const GAS f32x4*)gain)[col4 + 64 * j + 1]; }
    for (int q = gw; q < M / 2; q += NGW) {
        const int m = (q >> 3) * 16 + (q & 7), mr = m + 8 * hh;
        const GAS u32x4* xr = (const GAS u32x4*)(xs + pg8::paired_off(m, 0, D)) + lane;
        GAS f32x4* orow = (GAS f32x4*)(out + (size_t)mr * D) + col4;
        const float rstd = pg8::row_rstd(RS + mr);
        u32x4 v[8];
#pragma unroll
        for (int j = 0; j < 8; ++j) v[j] = xr[64 * j];
#pragma unroll
        for (int j = 0; j < 8; ++j) { f32x4 y0, y1; y0.x = bf_lo(v[j][0]); y0.y = bf_hi(v[j][0]); y0.z = bf_lo(v[j][1]); y0.w = bf_hi(v[j][1]); y1.x = bf_lo(v[j][2]); y1.y = bf_hi(v[j][2]); y1.z = bf_lo(v[j][3]); y1.w = bf_hi(v[j][3]);
            orow[64 * j] = y0 * rstd * gv[j][0]; orow[64 * j + 1] = y1 * rstd * gv[j][1]; }
    }
}
__device__ __forceinline__ void conv_phase(const bf16_t* Bb, const bf16_t* Ub, const float* cw, const u64* RS, bf16_t* Gb, int gw, int NGW, int lane_) {
    int lane = lane_; asm volatile("" : "+v"(lane));
    for (int chunk = gw; chunk < M / 8; chunk += NGW) {
        const int m0 = chunk * 8;
        const bool first = (m0 == 0) || (m0 >= MP && ((m0 - MP) & (SS - 1)) == 0);
        const bool last = (m0 + 8 == MP) || (m0 >= MP && ((m0 + 8 - MP) & (SS - 1)) == 0);
        float rr[10];
#pragma unroll
        for (int q = 0; q < 10; ++q) { const bool ok = !((q == 0 && first) || (q == 9 && last)); rr[q] = ok ? pg8::row_rstd(RS + (m0 - 1 + q)) : 0.f; }
#pragma unroll 1
        for (int j = 0; j < 4; ++j) {
            const int ch0 = (lane + 64 * j) * 8;
            float w0[8], w1[8], w2[8];
#pragma unroll
            for (int h = 0; h < 2; ++h) { const f32x4 a = *(const GAS f32x4*)(cw + ch0 + 4 * h), b = *(const GAS f32x4*)(cw + D + ch0 + 4 * h), c = *(const GAS f32x4*)(cw + 2 * D + ch0 + 4 * h);
#pragma unroll
                for (int e = 0; e < 4; ++e) { w0[4 * h + e] = a[e]; w1[4 * h + e] = b[e]; w2[4 * h + e] = c[e]; } }
            const GAS u32x4* up = (const GAS u32x4*)(Ub + (size_t)m0 * D + ch0);
            const GAS u32x4* bp = (const GAS u32x4*)(Bb + (size_t)m0 * D + ch0);
            GAS u32x4* gp = (GAS u32x4*)(Gb + (size_t)m0 * D + ch0);
            u32x4 uu[10], bb[8];
#pragma unroll
            for (int q = 0; q < 10; ++q) { const bool ok = !((q == 0 && first) || (q == 9 && last)); uu[q] = (u32x4){0u, 0u, 0u, 0u}; if (ok) uu[q] = *(up + (ptrdiff_t)(q - 1) * (D / 8)); }
#pragma unroll
            for (int r = 0; r < 8; ++r) bb[r] = bp[(size_t)r * (D / 8)];
#pragma unroll
            for (int r = 0; r < 8; ++r) {
                const float rp = rr[r] * rr[r], rc = rr[r + 1] * rr[r + 1], rn = rr[r + 2] * rr[r + 2], rb = rr[r + 1];
                float o[8];
#pragma unroll
                for (int e = 0; e < 8; ++e) o[e] = rb * bf_at(bb[r], e) * (w0[e] * rp * bf_at(uu[r], e) + w1[e] * rc * bf_at(uu[r + 1], e) + w2[e] * rn * bf_at(uu[r + 2], e));
                u32x4 w; w.x = cvt_pk_bf16(o[0], o[1]); w.y = cvt_pk_bf16(o[2], o[3]); w.z = cvt_pk_bf16(o[4], o[5]); w.w = cvt_pk_bf16(o[6], o[7]);
                gp[(size_t)r * (D / 8)] = w;
            }
        }
    }
}
__device__ __forceinline__ void load_rev(const GAS bf16_t* rowp, int g0, int c0, float (&r)[8]) {
    const u32x4 A = *(const GAS u32x4*)(rowp + g0 + ((248 - c0) & 255)), Bv = *(const GAS u32x4*)(rowp + g0 + ((256 - c0) & 255));
    r[0] = bf_at(Bv, 0);
#pragma unroll
    for (int i = 1; i < 8; ++i) r[i] = bf_at(A, 8 - i);
}
__device__ __forceinline__ void post_phase(int mode, const bf16_t* UP, const bf16_t* US, const f32x2* TWP, const f32x2* TWS, bf16_t* MXP, bf16_t* MXS, const bf16_t* HP256, bf16_t* H2048, int gw, int NGW, int lane_) {
    int lane = lane_; asm volatile("" : "+v"(lane));
    const float SC_S = 0.5f / sqrtf((float)SS * (float)CG), SC_P = 0.5f / sqrtf((float)SP * (float)CG);
    for (int it = gw + (mode == 1 ? SS : 0); it < (mode == 1 ? SS + NB * CG : SS); it += NGW) {
        const bool pr = it < SS;
        const int L = pr ? SS : CG, b = pr ? 0 : (it - SS) >> 8, k1 = pr ? it : (it - SS) & (CG - 1), nk1 = (L - k1) & (L - 1);
        const GAS bf16_t* H = pr ? (const GAS bf16_t*)UP : (const GAS bf16_t*)US + (size_t)b * SS * D;
        GAS bf16_t* O = pr ? (GAS bf16_t*)MXP : (GAS bf16_t*)MXS + (size_t)(MP + b * SS) * D;
        const f32x2* TW = pr ? TWP : TWS; const float sc = pr ? SC_P : SC_S;
        f32x2 st[4];
#pragma unroll
        for (int k2 = 0; k2 < 4; ++k2) st[k2] = TW[(size_t)(k1 + L * k2) * RAD + 1];
#pragma unroll 1
        for (int j = 0; j < 4; ++j) { const int ch0 = (lane + 64 * j) * 8, g0 = ch0 & ~255, c0 = ch0 & 255;
            const int ra = g0 + ((248 - c0) & 255), rb = g0 + ((256 - c0) & 255);
            f32x2 acc[8][4], cw[4];
#pragma unroll
            for (int a = 0; a < 8; ++a) { if (a < 4) cw[a] = (f32x2){1.f, 0.f};
#pragma unroll
                for (int e = 0; e < 4; ++e) acc[a][e] = (f32x2){0.f, 0.f}; }
            const int lsa = ((lane & 32) + (31 - (lane & 31))) * 4, lsb = ((lane & 32) + ((32 - (lane & 31)) & 31)) * 4;
#pragma unroll 1
            for (int hf = 0; hf < 2; ++hf) {
            u32x4 va[4], vp[4];
#pragma unroll
            for (int s2 = 0; s2 < 4; ++s2) {
                va[s2] = *(const GAS u32x4*)(H + ((size_t)(hf * 4 + s2) * L + k1) * D + ch0); vp[s2] = *(const GAS u32x4*)(H + ((size_t)(hf * 4 + s2) * L + nk1) * D + ch0); }
#pragma unroll
            for (int s2 = 0; s2 < 4; ++s2) {
                u32x4 nA, kA; unsigned nB0, kB0;
#pragma unroll
                for (int d = 0; d < 4; ++d) { nA[d] = (unsigned)__builtin_amdgcn_ds_bpermute(lsa, (int)vp[s2][d]); kA[d] = (unsigned)__builtin_amdgcn_ds_bpermute(lsa, (int)va[s2][d]); }
                nB0 = (unsigned)__builtin_amdgcn_ds_bpermute(lsb, (int)vp[s2][0]); kB0 = (unsigned)__builtin_amdgcn_ds_bpermute(lsb, (int)va[s2][0]);
                float Ev[8], Ov[8];
                Ev[0] = bf_at(va[s2], 0) + bf_lo(nB0); Ov[0] = bf_at(vp[s2], 0) - bf_lo(kB0);
#pragma unroll
                for (int e = 1; e < 8; ++e) { Ev[e] = bf_at(va[s2], e) + bf_at(nA, 8 - e); Ov[e] = bf_at(vp[s2], e) - bf_at(kA, 8 - e); }
#pragma unroll
                for (int k2 = 0; k2 < 4; ++k2) { const f32x2 cc = (f32x2){cw[k2].x, cw[k2].x}, ss = (f32x2){cw[k2].y, cw[k2].y};
#pragma unroll
                    for (int e = 0; e < 4; ++e) { acc[4 * (s2 & 1) + k2][e] = __builtin_elementwise_fma((f32x2){Ev[2 * e], Ev[2 * e + 1]}, cc, acc[4 * (s2 & 1) + k2][e]);
                                                  acc[4 * (s2 & 1) + k2][e] = __builtin_elementwise_fma((f32x2){Ov[2 * e], Ov[2 * e + 1]}, ss, acc[4 * (s2 & 1) + k2][e]); }
                    const float nc = cw[k2].x * st[k2].x - cw[k2].y * st[k2].y, ns = cw[k2].y * st[k2].x + cw[k2].x * st[k2].y; cw[k2] = (f32x2){nc, ns}; }
            }
            }
#pragma unroll
            for (int k2 = 0; k2 < 8; ++k2) { u32x4 w; f32x2 o[4];
#pragma unroll
                for (int e = 0; e < 4; ++e) o[e] = (k2 < 4 ? acc[k2][e] + acc[4 + k2][e] : acc[k2 - 4][e] - acc[k2][e]) * sc;
                w.x = cvt_pk_bf16(o[0].x, o[0].y); w.y = cvt_pk_bf16(o[1].x, o[1].y);
                w.z = cvt_pk_bf16(o[2].x, o[2].y); w.w = cvt_pk_bf16(o[3].x, o[3].y);
                *(GAS u32x4*)(O + (size_t)(k1 + L * k2) * D + ch0) = w; }
        }
    }
    if (mode == 1) {
        for (int it = gw; it < RAD * CG; it += NGW) {
            const int t = it >> 8, k1 = it & (CG - 1), nk1 = (CG - k1) & (CG - 1);
            f32x2 st[4];
#pragma unroll
            for (int k2 = 0; k2 < 4; ++k2) st[k2] = TWS[(size_t)(k1 + CG * k2) * RAD + 1];
#pragma unroll 1
            for (int j = 0; j < 4; ++j) { const int ch0 = (lane + 64 * j) * 8;
                f32x2 acc[8][4], cw[4];
#pragma unroll
                for (int a = 0; a < 8; ++a) { if (a < 4) cw[a] = (f32x2){1.f, 0.f};
#pragma unroll
                    for (int e = 0; e < 4; ++e) acc[a][e] = (f32x2){0.f, 0.f}; }
#pragma unroll 1
                for (int hf = 0; hf < 2; ++hf) {
                    u32x4 va[4], vp[4];
#pragma unroll
                    for (int q = 0; q < 4; ++q) { const int s2 = t + 8 * (hf * 4 + q);
                        va[q] = *(const GAS u32x4*)((const GAS bf16_t*)HP256 + ((size_t)s2 * CG + k1) * D + ch0);
                        vp[q] = *(const GAS u32x4*)((const GAS bf16_t*)HP256 + ((size_t)s2 * CG + nk1) * D + ch0); }
#pragma unroll
                    for (int q = 0; q < 4; ++q) {
#pragma unroll
                        for (int k2 = 0; k2 < 4; ++k2) { const f32x2 cc = (f32x2){cw[k2].x, cw[k2].x}, ss = (f32x2){cw[k2].y, cw[k2].y};
#pragma unroll
                            for (int e = 0; e < 4; ++e) { acc[4 * (q & 1) + k2][e] = __builtin_elementwise_fma((f32x2){bf_at(va[q], 2 * e), bf_at(va[q], 2 * e + 1)}, cc, acc[4 * (q & 1) + k2][e]);
                                                          acc[4 * (q & 1) + k2][e] = __builtin_elementwise_fma((f32x2){bf_at(vp[q], 2 * e), bf_at(vp[q], 2 * e + 1)}, ss, acc[4 * (q & 1) + k2][e]); }
                            const float nc = cw[k2].x * st[k2].x - cw[k2].y * st[k2].y, ns = cw[k2].y * st[k2].x + cw[k2].x * st[k2].y; cw[k2] = (f32x2){nc, ns}; }
                    }
                }
#pragma unroll
                for (int k2 = 0; k2 < 8; ++k2) { u32x4 w; f32x2 o[4];
#pragma unroll
                    for (int e = 0; e < 4; ++e) o[e] = k2 < 4 ? acc[k2][e] + acc[4 + k2][e] : acc[k2 - 4][e] - acc[k2][e];
                    w.x = cvt_pk_bf16(o[0].x, o[0].y); w.y = cvt_pk_bf16(o[1].x, o[1].y);
                    w.z = cvt_pk_bf16(o[2].x, o[2].y); w.w = cvt_pk_bf16(o[3].x, o[3].y);
                    *(GAS u32x4*)((GAS bf16_t*)H2048 + ((size_t)t * SS + k1 + CG * k2) * D + ch0) = w; }
            }
        }
    }
}

#define TIC() do { if (PROBE_CAT) pt0 = __builtin_amdgcn_s_memrealtime(); } while (0)
#define TOC(cat) do { if (PROBE_CAT == (cat)) pacc += __builtin_amdgcn_s_memrealtime() - pt0; } while (0)
#define GRID_BAR() do { TIC(); xcd_barrier(bar); TOC(2); } while (0)
__global__ void __launch_bounds__(NWAVES * 64, 2) fwd_kernel(Ptrs P) {
    extern __shared__ __attribute__((aligned(16))) unsigned char lds_raw[];
    LAS unsigned char* lds = (LAS unsigned char*)lds_raw;
    const int tid = threadIdx.x, lane = tid & 63, wave = __builtin_amdgcn_readfirstlane(tid >> 6);
    const int G = gridDim.x, bx = blockIdx.x;
    const int vcu = (G % 8 == 0) ? (bx % 8) * (G / 8) + bx / 8 : bx;
    const int gw = vcu * NWAVES + wave, NGW = G * NWAVES;
    for (int u = tid; u < (LDS_BYTES - LDSCTL_OFF) / 4; u += NWAVES * 64) ((LAS unsigned*)(lds + LDSCTL_OFF))[u] = 0u;
    __syncthreads();
    volatile LAS unsigned* MISC = (volatile LAS unsigned*)(lds + MISC_OFF);
    XcdBarrier bar = xcd_barrier_post((unsigned*)(P.ws + WS_CTL) + CW_BAR, MISC + 8);

#define WIN ((bf16_t*)wsp(P.ws, WS_WIN))
#define AWO ((bf16_t*)wsp(P.ws, WS_AWO))
#define FWO ((bf16_t*)wsp(P.ws, WS_FWO))
#define WUP ((bf16_t*)wsp(P.ws, WS_WUP))
#define WDN ((bf16_t*)wsp(P.ws, WS_WDN))
#define HART ((bf16_t*)wsp(P.ws, WS_HART))
#define PT ((bf16_t*)wsp(P.ws, WS_PT))
#define TW ((const f32x2*)wsp(P.ws, WS_TW))
#define TWS ((const f32x2*)wsp(P.ws, WS_TW + 1 * MiB))
#define H256 ((bf16_t*)wsp(P.ws, WS_H256))
#define B1 ((bf16_t*)wsp(P.ws, WS_B1))
#define B2 ((bf16_t*)wsp(P.ws, WS_B2))
#define B3 ((bf16_t*)wsp(P.ws, WS_B3))

    unsigned long long pacc = 0ull, pt0 = 0ull;
    TIC(); prologue(P, lds, gw, NGW, wave, lane); TOC(1);
    GRID_BAR();

#define PTG PT
#define RSB ((u64*)wsp(P.ws, WS_RS))
#define XS B1
#pragma unroll 1
    for (int layer = 0; layer < 4; ++layer) {
        const int j = layer >> 1;
        u64* RS0 = RSB + (size_t)(2 * layer) * (RS_STRIDE / 8);
        u64* RS1 = RS0 + RS_STRIDE / 8;
        u64* RS2 = RS1 + RS_STRIDE / 8;
        if ((layer & 1) == 0) {
            {
                pg8::DescPlain g{XS, WIN + (size_t)j * 3 * D * D, D, D, D}; pg8::StaticOrder S; S.init(M, 3 * D, G, bx, 4, 1);
                pg8::EpiGate E{B2, B3};
                pg8::gemm_phase<pg8::DescPlain, pg8::EpiGate, true, true>(lds, g, S, E, pacc);
            }
            GRID_BAR();
            TIC(); conv_phase(B2, B3, P.a_conv_w + (size_t)j * 3 * D, RS0, B2, gw, NGW, lane); TOC(1);
            GRID_BAR();
        } else {
            bf16_t* VTS = B2 + (size_t)RAD * D * SS; bf16_t* USM = B3 + (size_t)RAD * SS * D;
#pragma unroll 1
            for (int pr = 1; pr >= 0; --pr) {
                pg8::DescF0 g{PTG + (size_t)j * NGRP * CG * CG, pr ? XS : XS + (size_t)MP * D, CG, CG, pr ? 64 * D : 8 * D, pr}; pg8::StaticOrder S; S.init(D, pr ? MP : MS, G, bx);
                pg8::EpiBf16<2> E{pr ? B2 : VTS, CG, RS0, pr, nullptr, 0};
                pg8::gemm_phase<pg8::DescF0, pg8::EpiBf16<2>, true, true>(lds, g, S, E, pacc);
            }
            GRID_BAR();
            {
                pg8::DescF2 g{H256, B2, CG, CG, CG, 0, 0}; pg8::StaticOrder S; S.init(M, D, G, bx);
                pg8::EpiBf16<0> E{B3, D, nullptr, 0, nullptr, 0};
                pg8::gemm_phase<pg8::DescF2, pg8::EpiBf16<0>, true, true>(lds, g, S, E, pacc);
            }
            GRID_BAR();
#pragma unroll 1
            for (int mode = 1; mode <= 2; ++mode) {
                TIC(); post_phase(mode, B2, USM, TW, TWS, B3, B2, B3, B2, gw, NGW, lane); TOC(1);
                GRID_BAR();
            }
        }
        {
            pg8::DescSplit g{(layer & 1) ? B3 : B2, B2 + (size_t)MP * D, MP / BMT, ((layer & 1) == 0 ? AWO : FWO) + (size_t)j * D * D, D, D, D, 0}; pg8::StaticOrder S; S.init(M, D, G, bx, 4);
            pg8::EpiRes<false> E{XS, RS1, 0, nullptr};
            pg8::gemm_phase<pg8::DescSplit, pg8::EpiRes<false>, true, true>(lds, g, S, E, pacc);
        }
        GRID_BAR();
        {
            pg8::DescPlain g{XS, WUP + (size_t)layer * D * DFF, D, D, D}; pg8::StaticOrder S; S.init(M, DFF, G, bx, 4, 1);
            pg8::EpiBf16<1> E{B2, DFF, nullptr, 0, (bf16_t*)P.out, MCH / BMT};
            pg8::gemm_phase<pg8::DescPlain, pg8::EpiBf16<1>, true, true>(lds, g, S, E, pacc);
        }
        GRID_BAR();
        {
            pg8::DescSplit g{B2, (const bf16_t*)P.out, MCH / BMT, WDN + (size_t)layer * D * DFF, DFF, DFF, DFF, 1}; pg8::StaticOrder S; S.init(M, D, G, bx, 4);
            pg8::EpiRes<true> E{XS, RS2, 0, RS1};
            pg8::gemm_phase<pg8::DescSplit, pg8::EpiRes<true>, true, true>(lds, g, S, E, pacc);
        }
        GRID_BAR();
    }
    TIC(); final_norm_phase(XS, P.out, RSB + (size_t)8 * (RS_STRIDE / 8), P.final_norm, gw, NGW, lane); TOC(1);
    if (PROBE_CAT && bx == 0 && wave == 0) { const unsigned long long te = __builtin_amdgcn_s_memrealtime() + PROBE_ALPHA * pacc; while (__builtin_amdgcn_s_memrealtime() < te) __builtin_amdgcn_s_sleep(8); }
}

#undef WIN
#undef AWO
#undef FWO
#undef WUP
#undef WDN
#undef HART
#undef PT
#undef TW
#undef TWS
#undef H256
#undef B1
#undef B2
#undef B3
#undef PTG
#undef RSB
#undef XS
extern "C" void kernel_launch(void* const* d_in, const int* in_sizes, int n_in, void* d_out, int out_size, void* d_ws, size_t ws_size, hipStream_t stream) {
    static int grid = 0;
    if (grid == 0) {
        if (n_in != 11 || out_size != M * D || ws_size < WS_END) { fprintf(stderr, "kernel_launch: unexpected shapes (n_in %d, out %d, ws %zu)\n", n_in, out_size, ws_size); grid = -1; return; }
        int dev = 0, cus = 0, per_cu = 0;
        if (hipGetDevice(&dev) != hipSuccess || hipDeviceGetAttribute(&cus, hipDeviceAttributeMultiprocessorCount, dev) != hipSuccess) { grid = -1; return; }
        if (hipFuncSetAttribute((const void*)fwd_kernel, hipFuncAttributeMaxDynamicSharedMemorySize, LDS_BYTES) != hipSuccess) { fprintf(stderr, "kernel_launch: hipFuncSetAttribute failed\n"); grid = -1; return; }
        if (hipOccupancyMaxActiveBlocksPerMultiprocessor(&per_cu, (const void*)fwd_kernel, NWAVES * 64, LDS_BYTES) != hipSuccess || per_cu < 1)
            fprintf(stderr, "kernel_launch: occupancy query reports %d workgroups per CU\n", per_cu);
        (void)hipGetLastError();
        grid = cus;
    }
    if (grid < 0) return;
    if (hipMemsetAsync((char*)d_ws + WS_CTL, 0, CTL_ZERO_BYTES, stream) != hipSuccess) return;
    Ptrs p{};
    p.x_prompt = (const float*)d_in[0]; p.x_sample = (const float*)d_in[1]; p.norm_mix = (const float*)d_in[2]; p.a_w_in = (const float*)d_in[3];
    p.a_conv_w = (const float*)d_in[4]; p.a_w_out = (const float*)d_in[5]; p.f_w_out = (const float*)d_in[6]; p.norm_ffn = (const float*)d_in[7];
    p.w_up = (const float*)d_in[8]; p.w_down = (const float*)d_in[9]; p.final_norm = (const float*)d_in[10];
    p.out = (float*)d_out; p.ws = (unsigned char*)d_ws;
    hipLaunchKernelGGL(fwd_kernel, dim3(grid), dim3(NWAVES * 64), LDS_BYTES, stream, p);
    const hipError_t le = hipPeekAtLastError();
    if (le != hipSuccess) fprintf(stderr, "kernel_launch: launch failed: %s\n", hipGetErrorName(le));
    (void)in_sizes;
}
```

```cpp
#include <hip/hip_runtime.h>
#include <cstdio>
#include <cstdint>

#ifndef PROBE_CAT
#define PROBE_CAT 0
#endif
#define PROBE_ALPHA 4
#define LAS __attribute__((address_space(3)))
#define GAS __attribute__((address_space(1)))
typedef unsigned short bf16_t;
typedef short bf16x8 __attribute__((ext_vector_type(8)));
typedef float f32x4 __attribute__((ext_vector_type(4)));
typedef float f32x2 __attribute__((ext_vector_type(2)));
typedef unsigned u32x4 __attribute__((ext_vector_type(4)));
typedef unsigned u32x2 __attribute__((ext_vector_type(2)));
typedef GAS unsigned gu32;
typedef unsigned long long u64;

constexpr int D = 2048, DFF = 8192, SP = 16384, SS = 2048, NB = 16;
constexpr int MP = SP, MS = NB * SS, M = MP + MS;
constexpr int CG = 256, NGRP = 8, RAD = SP / SS;
constexpr int NSEQ = RAD + NB;
constexpr int MCH = M / 2, BMT = 256;
constexpr float RMS_EPS = 1e-6f;

constexpr size_t MiB = 1u << 20;
constexpr size_t WS_CTL = 0, CTL_ZERO_BYTES = 5 * MiB;
constexpr size_t WS_RS = 1 * MiB, RS_STRIDE = 384 * 1024;
constexpr size_t WS_WIN = 5 * MiB;
constexpr size_t WS_AWO = WS_WIN + 48 * MiB;
constexpr size_t WS_FWO = WS_AWO + 16 * MiB;
constexpr size_t WS_WUP = WS_FWO + 16 * MiB;
constexpr size_t WS_WDN = WS_WUP + 128 * MiB;
constexpr size_t WS_HART = WS_WDN + 128 * MiB;
constexpr size_t WS_PT = WS_HART + 8 * MiB;
constexpr size_t WS_TW = WS_PT + 2 * MiB;
constexpr size_t WS_H256 = WS_TW + 2 * MiB;
constexpr size_t WS_B1 = WS_H256 + 1 * MiB;
constexpr size_t WS_B2 = WS_B1 + 192 * MiB;
constexpr size_t WS_B3 = WS_B2 + 192 * MiB;
constexpr size_t WS_END = WS_B3 + 192 * MiB;
static_assert((size_t)M * D * 2 == 192 * MiB && (size_t)MCH * DFF * 2 == 384 * MiB && (size_t)M * 8 == RS_STRIDE && WS_RS + 9 * RS_STRIDE <= CTL_ZERO_BYTES, "buffer sizes");
constexpr int CW_BAR = 4096;

constexpr int RING_BYTES = 131072, LDSCTL_OFF = RING_BYTES, MISC_OFF = LDSCTL_OFF + 320, LDS_BYTES = 147456;
constexpr int NWAVES = 8;

__device__ __forceinline__ unsigned cvt_pk_bf16(float lo, float hi) { unsigned r; asm("v_cvt_pk_bf16_f32 %0, %1, %2" : "=v"(r) : "v"(lo), "v"(hi)); return r; }
__device__ __forceinline__ float bf_lo(unsigned w) { return __builtin_bit_cast(float, w << 16); }
__device__ __forceinline__ float bf_hi(unsigned w) { return __builtin_bit_cast(float, w & 0xffff0000u); }
typedef float f32x2 __attribute__((ext_vector_type(2)));
__device__ __forceinline__ float dot2_bf16(unsigned a, unsigned b, float c) { typedef __bf16 bf2 __attribute__((ext_vector_type(2))); return __builtin_amdgcn_fdot2_f32_bf16(__builtin_bit_cast(bf2, a), __builtin_bit_cast(bf2, b), c, false); }
__device__ __forceinline__ float relu1(float x) { float r; asm("v_max_f32 %0, 0, %1" : "=v"(r) : "v"(x)); return r; }
__device__ __forceinline__ float quad_rows_sum(float s) {
    float a = s, b = s;
    asm volatile("s_nop 1\n\tv_permlane16_swap_b32 %0, %1" : "+v"(a), "+v"(b));
    const float t = a + b; a = t; b = t;
    asm volatile("s_nop 1\n\tv_permlane32_swap_b32 %0, %1" : "+v"(a), "+v"(b));
    return a + b;
}
__device__ __forceinline__ float bf_at(const u32x4& v, int i) { const unsigned w = v[i >> 1]; return (i & 1) ? bf_hi(w) : bf_lo(w); }
#define LDS_WAIT() asm volatile("s_waitcnt lgkmcnt(0)" ::: "memory")

namespace pg8 {
constexpr int BM = 256, BK = 64, HALF = 128, HTB = HALF * BK * 2, STAGE_BYTES = 8 * HTB, NXCD = 8, WGM = 8;
__host__ __device__ __forceinline__ int lds_byte(int r, int c) { const int st = (r >> 4) * 2 + (c >> 5), rr = r & 15, cc = c & 31, ob = rr * 64 + cc * 2; return st * 1024 + (ob ^ (((ob >> 9) & 1) << 5)); }
__host__ __device__ __forceinline__ void stage_rc(int b, int& R, int& C) { const int st = b / 1024, sb = b % 1024, swz = sb ^ (((sb >> 9) & 1) << 5); R = (st >> 1) * 16 + swz / 64; C = (st & 1) * 32 + (swz % 64) / 2; }
__host__ __device__ __forceinline__ int perm32(int rho) { const int n = rho >> 4, i = rho & 15; return 8 * (i >> 2) + 4 * n + (i & 3); }

__host__ __device__ __forceinline__ size_t paired_off(int row, int k, int K) { return (size_t)(row >> 4) * 16 * K + (size_t)((row & 7) * (K >> 5) + (k >> 5)) * 64 + ((row >> 3) & 1) * 32 + (k & 31); }
struct Unit { int pm, pn; };
struct StaticOrder {
    int nM, nN, nwg, G, c, wgm, rev;
    __device__ __forceinline__ void init(int M_, int N_, int G_, int c_, int wgm_ = WGM, int rev_ = 0) { nM = M_ / BM; nN = N_ / BM; nwg = nM * nN; G = G_; c = c_; wgm = wgm_; rev = (rev_ && nwg % G_ == 0) ? 1 : 0; }
    __device__ __forceinline__ bool next(int i, Unit& u) const {
        if (i * G >= nwg) return false;
        const long L = (long)(rev ? nwg / G - 1 - i : i) * G + c; if (L >= nwg) return false;
        int wgid = (int)L; { const int q = nwg / NXCD, r = nwg % NXCD, xcd = wgid % NXCD, off = wgid / NXCD; wgid = (xcd < r ? xcd * (q + 1) : r * (q + 1) + (xcd - r) * q) + off; }
        const int nig = wgm * nN, gid = wgid / nig, fm = gid * wgm, gsz = (nM - fm) < wgm ? (nM - fm) : wgm;
        u.pm = fm + ((wgid % nig) % gsz); u.pn = (wgid % nig) / gsz; return true;
    }
};
struct DescPlain { const bf16_t* A; const bf16_t* Bt; int K, lda, ldb;
    __device__ __forceinline__ unsigned voffa(int R, int C) const { return (unsigned)paired_off(R, C, lda) * 2u; }
    __device__ __forceinline__ unsigned voffb(int Rb, int C) const { return (unsigned)paired_off(Rb, C, ldb) * 2u; }
    __device__ __forceinline__ size_t kstepa() const { return 4 * BK; }
    __device__ __forceinline__ size_t hstepa() const { return (size_t)HALF * lda * 2; }
    __device__ __forceinline__ size_t kstepb() const { return 4 * BK; }
    __device__ __forceinline__ const char* abase(const Unit& u) const { return (const char*)A + (size_t)u.pm * BM * lda * 2; }
    __device__ __forceinline__ const char* bbase(const Unit& u) const { return (const char*)Bt + (size_t)u.pn * BM * ldb * 2; } };
struct DescSplit { const bf16_t* A; const bf16_t* Ahi; int msplit; const bf16_t* Bt; int K, lda, ldb, ap;
    __device__ __forceinline__ unsigned voffa(int R, int C) const { return ap ? (unsigned)(((R >> 4) * 2 + (C >> 5)) * 1024 + (R & 7) * 128 + ((R >> 3) & 1) * 64 + (C & 31) * 2) : (unsigned)(R * lda + C) * 2u; }
    __device__ __forceinline__ size_t hstepa() const { return ap ? (size_t)16384 : (size_t)HALF * lda * 2; }
    __device__ __forceinline__ unsigned voffb(int Rb, int C) const { return (unsigned)paired_off(Rb, C, ldb) * 2u; }
    __device__ __forceinline__ size_t kstepa() const { return ap ? 32768 : 2 * BK; }
    __device__ __forceinline__ size_t kstepb() const { return 4 * BK; }
    __device__ __forceinline__ const char* abase(const Unit& u) const { return u.pm < msplit ? (const char*)A + (size_t)u.pm * BM * lda * 2 : (const char*)Ahi + (size_t)(u.pm - msplit) * BM * lda * 2; }
    __device__ __forceinline__ const char* bbase(const Unit& u) const { return (const char*)Bt + (size_t)u.pn * BM * ldb * 2; } };
struct DescF0 { const bf16_t* A; const bf16_t* Bt; int K, lda, ldb, prompt;
    __device__ __forceinline__ const char* abase(const Unit& u) const { return (const char*)A + (size_t)u.pm * CG * CG * 2; }
    __device__ __forceinline__ const char* bbase(const Unit& u) const {
        const int row0 = prompt ? u.pn : (u.pn >> 3) * SS + (u.pn & 7);
        return (const char*)Bt + paired_off(row0, u.pm * CG, D) * 2; }
    __device__ __forceinline__ unsigned voffa(int R, int C) const { return (unsigned)(R * lda + C) * 2u; }
    __device__ __forceinline__ unsigned voffb(int Rb, int C) const {
        const unsigned rp = prompt ? (unsigned)Rb * 64u * D : (unsigned)(Rb >> 1) * 16u * D + (unsigned)(Rb & 1) * 32u;
        return (rp + (unsigned)((C >> 5) * 64 + (C & 31))) * 2u; }
    __device__ __forceinline__ size_t kstepa() const { return 2 * BK; }
    __device__ __forceinline__ size_t hstepa() const { return (size_t)HALF * lda * 2; }
    __device__ __forceinline__ size_t kstepb() const { return 4 * BK; } };
struct DescF2 { const bf16_t* A; const bf16_t* Bt; int K, lda, ldb, amask, ashift;
    __device__ __forceinline__ unsigned voffa(int R, int C) const { return (unsigned)(R * lda + C) * 2u; }
    __device__ __forceinline__ unsigned voffb(int Rb, int C) const { return (unsigned)(Rb * ldb + C) * 2u; }
    __device__ __forceinline__ size_t kstepa() const { return 2 * BK; }
    __device__ __forceinline__ size_t hstepa() const { return (size_t)HALF * lda * 2; }
    __device__ __forceinline__ size_t kstepb() const { return 2 * BK; }
    __device__ __forceinline__ const char* abase(const Unit& u) const { return (const char*)A + (size_t)(u.pm & amask) * BM * lda * 2; }
    __device__ __forceinline__ const char* bbase(const Unit& u) const { return (const char*)Bt + ((size_t)(u.pm >> ashift) * D + (size_t)u.pn * BM) * ldb * 2; } };

__device__ __forceinline__ float rstd_of(float ss) { return 1.0f / sqrtf(ss * (1.0f / D) + RMS_EPS); }
constexpr float RS_FIX = 1048576.0f;
__device__ __forceinline__ u64 rs_fix(float s) { return (u64)(s * RS_FIX); }
__device__ __forceinline__ float row_rstd(const u64* p) { return rstd_of((float)__hip_atomic_load((GAS u64*)p, __ATOMIC_RELAXED, __HIP_MEMORY_SCOPE_AGENT) * (1.0f / RS_FIX)); }
__device__ __forceinline__ unsigned dpp_ror8(unsigned old, unsigned src, int bank_mask) {
    return bank_mask == 0xC ? (unsigned)__builtin_amdgcn_update_dpp((int)old, (int)src, 0x128, 0xf, 0xC, false) : (unsigned)__builtin_amdgcn_update_dpp((int)old, (int)src, 0x128, 0xf, 0x3, false); }
__device__ __forceinline__ void widen(const u32x4& own0, const u32x4& own1, u32x4& r1, u32x4& r2) {
#pragma unroll
    for (int e = 0; e < 4; ++e) { r1[e] = dpp_ror8(own0[e], own1[e], 0xC); r2[e] = dpp_ror8(own1[e], own0[e], 0x3); }
}
template <bool SCALE> struct EpiRes {
    static constexpr bool PERM = true;
    bf16_t* XS; u64* RS; int row0; const u64* RSin;
    __device__ __forceinline__ void operator()(const f32x4 (&acc)[2][2][4][2], const Unit& u, int wr, int wc, int fr, int fq) const {
        const int rt = row0 + u.pm * BM;
        GAS char* ub = (GAS char*)XS + (size_t)rt * D * 2 + (size_t)(8 * u.pn + 2 * wc) * 128 + (size_t)wr * 64 * D * 2;
        const unsigned lp = (unsigned)((fr & 7) * (D >> 5) * 64 + (fr >> 3) * 32 + 8 * fq) * 2u;
        u32x4 xv[2][4][2];
#pragma unroll
        for (int ai = 0; ai < 2; ++ai)
#pragma unroll
            for (int m = 0; m < 4; ++m) { const GAS char* rb = ub + (size_t)(ai * HALF + m * 16) * D * 2;
#pragma unroll
                for (int h = 0; h < 2; ++h) xv[ai][m][h] = *(const GAS u32x4*)(rb + lp + h * 128); }
        float rsc[2][4];
#pragma unroll
        for (int ai = 0; ai < 2; ++ai)
#pragma unroll
            for (int m = 0; m < 4; ++m) { rsc[ai][m] = 1.f;
                if (SCALE) { const float r = row_rstd(RSin + (rt + ai * HALF + wr * 64 + m * 16 + fr)); rsc[ai][m] = r * r; } }
#pragma unroll
        for (int ai = 0; ai < 2; ++ai)
#pragma unroll
            for (int m = 0; m < 4; ++m) { GAS char* rb = ub + (size_t)(ai * HALF + m * 16) * D * 2;
                const float sc = rsc[ai][m];
                float s = 0.f, s1 = 0.f;
                u32x4 w[2];
                const f32x2 sc2 = (f32x2){sc, sc};
#pragma unroll
                for (int bj = 0; bj < 2; ++bj) {
#pragma unroll
                    for (int n = 0; n < 2; ++n) { const f32x4 a = acc[ai][bj][m][n]; const unsigned x0 = xv[ai][m][bj][2 * n], x1 = xv[ai][m][bj][2 * n + 1];
                        f32x2 p0 = (f32x2){bf_lo(x0), bf_hi(x0)}, p1 = (f32x2){bf_lo(x1), bf_hi(x1)};
                        const f32x2 a0 = (f32x2){a[0], a[1]}, a1 = (f32x2){a[2], a[3]};
                        if (SCALE) { p0 = __builtin_elementwise_fma(a0, sc2, p0); p1 = __builtin_elementwise_fma(a1, sc2, p1); } else { p0 += a0; p1 += a1; }
                        const unsigned w0 = cvt_pk_bf16(p0[0], p0[1]), w1 = cvt_pk_bf16(p1[0], p1[1]);
                        w[bj][2 * n] = w0; w[bj][2 * n + 1] = w1;
                        s = dot2_bf16(w0, w0, s); s1 = dot2_bf16(w1, w1, s1); } }
                s += s1;
                *(GAS u32x4*)(rb + lp) = w[0]; *(GAS u32x4*)(rb + lp + 128) = w[1];
                s = quad_rows_sum(s);
                if (fq == 0) __hip_atomic_fetch_add((GAS u64*)RS + (rt + ai * HALF + wr * 64 + m * 16 + fr), rs_fix(s), __ATOMIC_RELAXED, __HIP_MEMORY_SCOPE_AGENT);
                __builtin_amdgcn_sched_barrier(0);
            }
    }
};
template <int MODE  > struct EpiBf16 {
    static constexpr bool PERM = true;
    bf16_t* O; int ldc; const u64* RS; int row0; bf16_t* Ohi; int msplit;
    __device__ __forceinline__ void operator()(const f32x4 (&acc)[2][2][4][2], const Unit& u, int wr, int wc, int fr, int fq) const {
        GAS char* ub;
        if (MODE == 2) ub = (GAS char*)O + ((size_t)u.pn * D + (size_t)u.pm * BM) * BM * 2;
        else if (MODE == 1 && u.pm >= msplit) ub = (GAS char*)Ohi + ((size_t)(u.pm - msplit) * BM * ldc + (size_t)u.pn * BM) * 2;
        else ub = (GAS char*)O + ((size_t)u.pm * BM * ldc + (size_t)u.pn * BM) * 2;
        const unsigned lo = (unsigned)((wr * 64 + (fr & 7)) * ldc + wc * 64) * 2u + (unsigned)(4 * (fr >> 3) + fq) * 16u;
        f32x4 cs[2][2];
        if (MODE == 2) {
            const int ln = fq * 16 + fr, tc = wc * 64 + ln;
            const u64* tp = RS + (row0 ? u.pn + 64 * tc : MP + (u.pn >> 3) * SS + (u.pn & 7) + 8 * tc);
            const float tr = row_rstd(tp);
#pragma unroll
            for (int bj = 0; bj < 2; ++bj)
#pragma unroll
                for (int n = 0; n < 2; ++n)
#pragma unroll
                    for (int j = 0; j < 4; ++j) cs[bj][n][j] = __shfl(tr, bj * 32 + 8 * fq + 4 * n + j);
        } else {
#pragma unroll
            for (int bj = 0; bj < 2; ++bj)
#pragma unroll
                for (int n = 0; n < 2; ++n)
#pragma unroll
                    for (int j = 0; j < 4; ++j) cs[bj][n][j] = 0.f;
        }
        float rsc[2][4];
#pragma unroll
        for (int ai = 0; ai < 2; ++ai)
#pragma unroll
            for (int m = 0; m < 4; ++m) { rsc[ai][m] = 1.f;
            }
#pragma unroll
        for (int ai = 0; ai < 2; ++ai)
#pragma unroll
            for (int m = 0; m < 4; ++m) { GAS char* rb = ub + (size_t)(ai * HALF + m * 16) * ldc * 2;
                const float sc = rsc[ai][m];
                u32x4 w[2];
#pragma unroll
                for (int bj = 0; bj < 2; ++bj) { f32x4 v0 = acc[ai][bj][m][0], v1 = acc[ai][bj][m][1];
                    if (MODE == 1) { const f32x4 a = (f32x4){relu1(v0[0]), relu1(v0[1]), relu1(v0[2]), relu1(v0[3])}, b = (f32x4){relu1(v1[0]), relu1(v1[1]), relu1(v1[2]), relu1(v1[3])}; v0 = a * a; v1 = b * b; }
                    if (MODE == 2) { v0 = v0 * cs[bj][0]; v1 = v1 * cs[bj][1]; }
                    w[bj].x = cvt_pk_bf16(v0[0], v0[1]); w[bj].y = cvt_pk_bf16(v0[2], v0[3]); w[bj].z = cvt_pk_bf16(v1[0], v1[1]); w[bj].w = cvt_pk_bf16(v1[2], v1[3]); }
                if (MODE == 1) {
                    GAS char* hb = u.pm >= msplit ? (GAS char*)Ohi + (size_t)(u.pm - msplit) * BM * ldc * 2 : (GAS char*)O + (size_t)u.pm * BM * ldc * 2;
                    GAS char* gb = hb + (size_t)(4 * u.pn + wc) * 32768 + (size_t)(ai * 8 + wr * 4 + m) * 2048;
                    const unsigned lp = (unsigned)((fr & 7) * 128 + (fr >> 3) * 64 + fq * 16);
                    __builtin_nontemporal_store(w[0], (GAS u32x4*)(gb + lp)); __builtin_nontemporal_store(w[1], (GAS u32x4*)(gb + lp + 1024));
                } else { u32x4 r1, r2; widen(w[0], w[1], r1, r2); *(GAS u32x4*)(rb + lo) = r1; *(GAS u32x4*)(rb + lo + 8 * ldc * 2) = r2; } }
    }
};
struct EpiGate {
    static constexpr bool PERM = true;
    bf16_t* Bo; bf16_t* Uo;
    __device__ __forceinline__ void operator()(const f32x4 (&acc)[2][2][4][2], const Unit& u, int wr, int wc, int fr, int fq) const {
        if (u.pn < 8) {
            GAS char* ub = (GAS char*)Bo + ((size_t)u.pm * BM * D + (size_t)u.pn * BM) * 2;
            const unsigned lo = (unsigned)((wr * 64 + (fr & 7)) * D + wc * 64) * 2u + (unsigned)(4 * (fr >> 3) + fq) * 16u;
#pragma unroll
            for (int ai = 0; ai < 2; ++ai)
#pragma unroll
                for (int m = 0; m < 4; ++m) { GAS char* rb = ub + (size_t)(ai * HALF + m * 16) * D * 2;
                    u32x4 w[2];
#pragma unroll
                    for (int bj = 0; bj < 2; ++bj) { const f32x4 v0 = acc[ai][bj][m][0], v1 = acc[ai][bj][m][1];
                        w[bj].x = cvt_pk_bf16(v0[0], v0[1]); w[bj].y = cvt_pk_bf16(v0[2], v0[3]); w[bj].z = cvt_pk_bf16(v1[0], v1[1]); w[bj].w = cvt_pk_bf16(v1[2], v1[3]); }
                    u32x4 r1, r2; widen(w[0], w[1], r1, r2);
                    *(GAS u32x4*)(rb + lo) = r1; *(GAS u32x4*)(rb + lo + 8 * D * 2) = r2; }
        } else {
            GAS char* ub = (GAS char*)Uo + ((size_t)u.pm * BM * D + (size_t)(u.pn - 8) * HALF) * 2;
            const unsigned lo = (unsigned)((wr * 64 + fr) * D + wc * 32 + 8 * fq) * 2u;
#pragma unroll
            for (int ai = 0; ai < 2; ++ai)
#pragma unroll
                for (int m = 0; m < 4; ++m) { GAS char* rb = ub + (size_t)(ai * HALF + m * 16) * D * 2;
                    const f32x4 v0 = acc[ai][0][m][0] * acc[ai][1][m][0], v1 = acc[ai][0][m][1] * acc[ai][1][m][1];
                    u32x4 w; w.x = cvt_pk_bf16(v0[0], v0[1]); w.y = cvt_pk_bf16(v0[2], v0[3]); w.z = cvt_pk_bf16(v1[0], v1[1]); w.w = cvt_pk_bf16(v1[2], v1[3]);
                    *(GAS u32x4*)(rb + lo) = w; }
        }
    }
};

template <class Desc, class Epi, bool ALIGN_EPI, bool SP2>
__device__ __forceinline__ void gemm_phase(LAS unsigned char* lds, const Desc g, const StaticOrder& S, const Epi& E, unsigned long long& pacc) {
    int tid_ = threadIdx.x; asm volatile("" : "+v"(tid_));
    const int tid = tid_, wid = __builtin_amdgcn_readfirstlane(tid >> 6), lane = tid & 63, wr = wid >> 2, wc = wid & 3, fr = lane & 15, fq = lane >> 4;
    const int K = g.K, nt = K / BK, lda = g.lda, ldb = g.ldb;
    unsigned voffA[2], voffB[2];
#pragma unroll
    for (int i = 0; i < 2; ++i) { int R, C; stage_rc(tid * 16 + i * 8192, R, C); const int Rb = 2 * (R & ~31) + perm32(R & 31);
        voffA[i] = g.voffa(R, C); voffB[i] = g.voffb(Rb, C); }
    const size_t kstep = g.kstepa(), kstepB = g.kstepb();
    const size_t hstepA = g.hstepa(), hstepB = (size_t)32 * ldb * 2;
    const unsigned ldsw = (unsigned)wid * 1024u;
    const int aoff = lds_byte(wr * 64 + fr, fq * 8), boff = lds_byte(wc * 32 + fr, fq * 8);
#define PG8_SA(b, h) (((b) * 2 + (h)) * HTB)
#define PG8_SB(b, h) ((4 + (b) * 2 + (h)) * HTB)
#define PG8_STAGE(bufoff, gbase, voff) do { _Pragma("unroll") for (int _i = 0; _i < 2; ++_i) { unsigned _vo = (voff)[_i]; asm("" : "+v"(_vo));     \
        __builtin_amdgcn_global_load_lds((const GAS unsigned*)((const GAS char*)(gbase) + _vo), (LAS unsigned*)(lds + (bufoff) + ldsw + _i * 8192), 16, 0, 0); } } while (0)
#define PG8_LDA(dst, b, h) do { _Pragma("unroll") for (int m = 0; m < 4; ++m) _Pragma("unroll") for (int k = 0; k < 2; ++k) dst[m][k] = *(const LAS bf16x8*)(lds + PG8_SA(b, h) + aoff + m * 2048 + k * 1024); } while (0)
#define PG8_LDB(dst, b, h) do { _Pragma("unroll") for (int n = 0; n < 2; ++n) _Pragma("unroll") for (int k = 0; k < 2; ++k) dst[n][k] = *(const LAS bf16x8*)(lds + PG8_SB(b, h) + boff + n * 2048 + k * 1024); } while (0)
#define PG8_MMA(ai, bj, At, Bt) do { __builtin_amdgcn_s_setprio(1); _Pragma("unroll") for (int p = 0; p < 8; ++p) _Pragma("unroll") for (int q = 0; q < 2; ++q) { const int n = p >> 2, m = (n ? 3 - (p & 3) : (p & 3)), k = (p ^ q) & 1; \
        asm volatile("v_mfma_f32_16x16x32_bf16 %0, %1, %2, %0" : "+v"(acc[ai][bj][m][n]) : "v"(Bt[n][k]), "v"(At[m][k])); }     __builtin_amdgcn_s_setprio(0); } while (0)
#define PG8_WAIT_V(n) asm volatile("s_waitcnt vmcnt(" #n ")" ::: "memory")
#define PG8_WAIT_L(n) asm volatile("s_waitcnt lgkmcnt(" #n ")" ::: "memory")
#define PG8_BAR __builtin_amdgcn_s_barrier()
#define PG8_SCHED __builtin_amdgcn_sched_barrier(0)
    Unit cur, nxt; int ui = 0;
    if (!S.next(0, cur)) return;
    f32x4 acc[2][2][4][2];
#pragma unroll
    for (int a = 0; a < 2; ++a)
#pragma unroll
        for (int b = 0; b < 2; ++b)
#pragma unroll
            for (int m = 0; m < 4; ++m)
#pragma unroll
                for (int n = 0; n < 2; ++n) acc[a][b][m][n] = (f32x4){0.f, 0.f, 0.f, 0.f};
    bf16x8 At[4][2], B0[2][2], B1[2][2];
    const char* cA = g.abase(cur); const char* cB = g.bbase(cur);
    if constexpr (SP2) {
        PG8_STAGE(PG8_SB(0, 0), cB, voffB); PG8_STAGE(PG8_SB(0, 1), cB + hstepB, voffB); PG8_STAGE(PG8_SA(0, 0), cA, voffA); PG8_STAGE(PG8_SA(0, 1), cA + hstepA, voffA);
        if (wr == 1) PG8_BAR;
        PG8_WAIT_V(2); PG8_BAR;
        PG8_STAGE(PG8_SB(1, 0), cB + kstepB, voffB); PG8_STAGE(PG8_SA(1, 0), cA + kstep, voffA); PG8_STAGE(PG8_SB(1, 1), cB + hstepB + kstepB, voffB);
        PG8_WAIT_V(6); PG8_BAR;
    } else {
        PG8_STAGE(PG8_SB(0, 0), cB, voffB); PG8_STAGE(PG8_SA(0, 0), cA, voffA); PG8_STAGE(PG8_SB(0, 1), cB + hstepB, voffB); PG8_STAGE(PG8_SA(0, 1), cA + hstepA, voffA);
        if (wr == 1) PG8_BAR;
        PG8_WAIT_V(4); PG8_BAR;
        PG8_STAGE(PG8_SB(1, 0), cB + kstepB, voffB); PG8_STAGE(PG8_SA(1, 0), cA + kstep, voffA); PG8_STAGE(PG8_SB(1, 1), cB + hstepB + kstepB, voffB);
        PG8_WAIT_V(6); PG8_BAR;
    }
    for (;;) {
        const bool has_next = S.next(ui + 1, nxt);
        const char* nA = has_next ? g.abase(nxt) : cA; const char* nB = has_next ? g.bbase(nxt) : cB;
#pragma unroll 1
        for (int t = 0; t < nt; t += 2) {
            const bool last = (t == nt - 2);
            unsigned long long pk0 = 0ull; if (PROBE_CAT == 4 || PROBE_CAT == 5) pk0 = __builtin_amdgcn_s_memrealtime();
            const char* a1 = cA + (size_t)(t + 1) * kstep;
            const char* a2 = last ? nA : cA + (size_t)(t + 2) * kstep; const char* b2 = last ? nB : cB + (size_t)(t + 2) * kstepB;
            const char* a3 = a2 + kstep; const char* b3 = b2 + kstepB;
            if constexpr (SP2) {
            PG8_LDB(B0, 0, 0); PG8_LDB(B1, 0, 1); PG8_SCHED; PG8_LDA(At, 0, 0); PG8_STAGE(PG8_SA(1, 1), a1 + hstepA, voffA);
            PG8_WAIT_V(8); PG8_WAIT_L(0); PG8_BAR; PG8_MMA(0, 0, At, B0); PG8_MMA(0, 1, At, B1); PG8_BAR; PG8_SCHED;
            PG8_LDA(At, 0, 1); PG8_STAGE(PG8_SB(0, 0), b2, voffB); PG8_STAGE(PG8_SB(0, 1), b2 + hstepB, voffB); PG8_STAGE(PG8_SA(0, 0), a2, voffA);
            PG8_WAIT_V(8); PG8_WAIT_L(0); PG8_BAR; PG8_MMA(1, 0, At, B0); PG8_MMA(1, 1, At, B1); PG8_BAR; PG8_SCHED;
            PG8_LDB(B0, 1, 0); PG8_LDB(B1, 1, 1); PG8_SCHED; PG8_LDA(At, 1, 0); PG8_STAGE(PG8_SA(0, 1), a2 + hstepA, voffA);
            PG8_WAIT_V(8); PG8_WAIT_L(0); PG8_BAR; PG8_MMA(0, 0, At, B0); PG8_MMA(0, 1, At, B1); PG8_BAR; PG8_SCHED;
            PG8_LDA(At, 1, 1); PG8_STAGE(PG8_SB(1, 0), b3, voffB); PG8_STAGE(PG8_SB(1, 1), b3 + hstepB, voffB); PG8_STAGE(PG8_SA(1, 0), a3, voffA);
            PG8_WAIT_V(8); PG8_WAIT_L(0); PG8_BAR; PG8_MMA(1, 0, At, B0); PG8_MMA(1, 1, At, B1); PG8_BAR; PG8_SCHED;
            } else {
            PG8_LDB(B0, 0, 0); PG8_SCHED; PG8_LDA(At, 0, 0); PG8_STAGE(PG8_SA(1, 1), a1 + hstepA, voffA);
            PG8_WAIT_L(8); PG8_BAR; PG8_WAIT_L(0); PG8_MMA(0, 0, At, B0); PG8_BAR; PG8_SCHED;
            PG8_LDB(B1, 0, 1); PG8_STAGE(PG8_SB(0, 0), b2, voffB);
            PG8_BAR; PG8_WAIT_L(0); PG8_MMA(0, 1, At, B1); PG8_BAR;
            PG8_LDA(At, 0, 1); PG8_STAGE(PG8_SA(0, 0), a2, voffA);
            PG8_BAR; PG8_WAIT_L(0); PG8_MMA(1, 0, At, B0); PG8_BAR; PG8_SCHED;
            PG8_STAGE(PG8_SB(0, 1), b2 + hstepB, voffB);
            PG8_WAIT_V(6); PG8_BAR; PG8_MMA(1, 1, At, B1); PG8_BAR;
            PG8_LDB(B0, 1, 0); PG8_SCHED; PG8_LDA(At, 1, 0); PG8_STAGE(PG8_SA(0, 1), a2 + hstepA, voffA);
            PG8_WAIT_L(8); PG8_BAR; PG8_WAIT_L(0); PG8_MMA(0, 0, At, B0); PG8_BAR; PG8_SCHED;
            PG8_LDB(B1, 1, 1); PG8_STAGE(PG8_SB(1, 0), b3, voffB);
            PG8_BAR; PG8_WAIT_L(0); PG8_MMA(0, 1, At, B1); PG8_BAR;
            PG8_LDA(At, 1, 1); PG8_STAGE(PG8_SA(1, 0), a3, voffA);
            PG8_BAR; PG8_WAIT_L(0); PG8_MMA(1, 0, At, B0); PG8_BAR; PG8_SCHED;
            PG8_STAGE(PG8_SB(1, 1), b3 + hstepB, voffB);
            PG8_WAIT_V(6); PG8_BAR; PG8_MMA(1, 1, At, B1); PG8_BAR;
            }
            if (PROBE_CAT == 4 && t == 0 && ui > 0) pacc += __builtin_amdgcn_s_memrealtime() - pk0;
            if (PROBE_CAT == 5 && t == 2) pacc += __builtin_amdgcn_s_memrealtime() - pk0;
        }
        if constexpr (ALIGN_EPI) { if (wr == 0) PG8_BAR; }
        asm volatile("s_nop 15\n\ts_nop 15" ::: "memory");
        E(acc, cur, wr, wc, fr, fq);
        if (!has_next) break;
#pragma unroll
        for (int a = 0; a < 2; ++a)
#pragma unroll
            for (int b = 0; b < 2; ++b)
#pragma unroll
                for (int m = 0; m < 4; ++m)
#pragma unroll
                    for (int n = 0; n < 2; ++n) acc[a][b][m][n] = (f32x4){0.f, 0.f, 0.f, 0.f};
        cur = nxt; cA = nA; cB = nB; ++ui;
        if constexpr (ALIGN_EPI) { if (wr == 1) PG8_BAR; }
    }
    PG8_WAIT_V(0);
    if constexpr (!ALIGN_EPI) { if (wr == 0) PG8_BAR; }
    PG8_BAR;
#undef PG8_SA
#undef PG8_SB
#undef PG8_STAGE
#undef PG8_LDA
#undef PG8_LDB
#undef PG8_MMA
#undef PG8_WAIT_V
#undef PG8_WAIT_L
#undef PG8_BAR
#undef PG8_SCHED
}
}

#define XB_TMO      128
#define XB_XCNT(j)  (256  + 64 * (j))
#define XB_XSUB(j)  (1280 + 64 * (j))
#define XB_XGEN(j)  (2304 + 64 * (j))
#define XB_TOP      3328
#define XB_TOPGEN   3392
#define XCD_BAR_WORDS 3456
#define XB_SPIN_CAP (1u << 18)
__device__ __forceinline__ unsigned xb_ld(unsigned* p)              { return __hip_atomic_load(p, __ATOMIC_RELAXED, __HIP_MEMORY_SCOPE_AGENT); }
__device__ __forceinline__ unsigned xb_add(unsigned* p, unsigned v) { return __hip_atomic_fetch_add(p, v, __ATOMIC_RELAXED, __HIP_MEMORY_SCOPE_AGENT); }
__device__ __forceinline__ unsigned xb_xcc_id() { return (unsigned)__builtin_amdgcn_s_getreg((3 << 11) | 20) & 0xFu; }
#define XB_SPIN(cond, bar) do { unsigned _sp = 0; while (cond) { __builtin_amdgcn_s_sleep(1); \
    if ((++_sp & 255u) == 0u) { if (xb_ld(&(bar)[XB_TMO])) break; if (_sp > XB_SPIN_CAP) { atomicAdd(&(bar)[XB_TMO], 1u); break; } } } } while (0)
struct XcdBarrier { unsigned* bar; unsigned x; volatile LAS unsigned* st; };
__device__ __forceinline__ XcdBarrier xcd_barrier_post(unsigned* bar, volatile LAS unsigned* st) {
    XcdBarrier b; b.bar = bar; b.x = (unsigned)__builtin_amdgcn_readfirstlane((int)xb_xcc_id()); b.st = st;
    if (threadIdx.x == 0) (void)xb_add(&bar[XB_XCNT(b.x)], 1u);
    return b;
}
__device__ __forceinline__ void xcd_barrier_complete(unsigned* bar, unsigned x, unsigned& nloc, unsigned& nx) {
    const unsigned G = gridDim.x * gridDim.y * gridDim.z;
    unsigned sum, cnt, mine, sp = 0u;
    for (;;) {
        sum = 0u; cnt = 0u; mine = 0u;
#pragma unroll
        for (unsigned j = 0; j < 16; ++j) { const unsigned c = xb_ld(&bar[XB_XCNT(j)]); sum += c; cnt += (c > 0u) ? 1u : 0u; mine = (j == x) ? c : mine; }
        if (sum == G) break;
        __builtin_amdgcn_s_sleep(1);
        if ((++sp & 255u) == 0u) { if (xb_ld(&bar[XB_TMO])) break; if (sp > XB_SPIN_CAP) { atomicAdd(&bar[XB_TMO], 1u); break; } }
    }
    nloc = mine > 0u ? mine : 1u; nx = cnt > 0u ? cnt : 1u;
}
__device__ __forceinline__ void xcd_barrier(const XcdBarrier& b) {
    asm volatile("s_waitcnt vmcnt(0)" ::: "memory");
    __syncthreads();
    if (threadIdx.x == 0) {
        unsigned* bar = b.bar; unsigned bx_ = b.x; asm volatile("" : "+s"(bx_));
        __builtin_amdgcn_s_waitcnt(0);
        unsigned nloc = b.st[0], nx = b.st[1];
        if (nloc == 0u) { xcd_barrier_complete(bar, bx_, nloc, nx); b.st[0] = nloc; b.st[1] = nx; }
        const unsigned old = xb_add(&bar[XB_XSUB(bx_)], 1u);
        const unsigned gen = old / nloc;
        if (old + 1u == (gen + 1u) * nloc) {
            __builtin_amdgcn_fence(__ATOMIC_RELEASE, "agent");
            asm volatile("s_waitcnt vmcnt(0)" ::: "memory");
            const unsigned og = xb_add(&bar[XB_TOP], 1u);
            const unsigned tg = og / nx;
            if (og + 1u == (tg + 1u) * nx) xb_add(&bar[XB_TOPGEN], 1u);
            else XB_SPIN(xb_ld(&bar[XB_TOPGEN]) == tg, bar);
            __builtin_amdgcn_fence(__ATOMIC_ACQUIRE, "agent");
            xb_add(&bar[XB_XGEN(bx_)], 1u);
            asm volatile("s_waitcnt vmcnt(0)" ::: "memory");
        } else {
            XB_SPIN(xb_ld(&bar[XB_XGEN(bx_)]) == gen, bar);
            __builtin_amdgcn_fence(__ATOMIC_ACQUIRE, "agent");
            asm volatile("s_waitcnt vmcnt(0)" ::: "memory");
        }
    }
    __syncthreads();
}

__device__ __forceinline__ float wave_sum(float v) {
#pragma unroll
    for (int o = 1; o < 64; o <<= 1) v += __shfl_xor(v, o);
    return v;
}
__device__ __forceinline__ void transpose_item(const float* W, int K, int N, bf16_t* WT, int k0, int n0, int drow0, const float* gain, LAS float* scr, int lane) {
    float tv[32];
#pragma unroll
    for (int i = 0; i < 32; ++i) tv[i] = ((const GAS float*)W)[(size_t)(k0 + 2 * i + (lane >> 5)) * N + n0 + (lane & 31)];
#pragma unroll
    for (int i = 0; i < 32; ++i) { const int kk = 2 * i + (lane >> 5); float v = tv[i]; if (gain) v *= ((const GAS float*)gain)[k0 + kk]; scr[kk * 33 + (lane & 31)] = v; }
    LDS_WAIT(); asm volatile("" ::: "memory");
    const int c = lane & 7;
#pragma unroll
    for (int j = 0; j < 4; ++j) { const int n = (lane >> 3) + 8 * j; const LAS float* s = scr + (8 * c) * 33 + n;
        u32x4 o; o.x = cvt_pk_bf16(s[0 * 33], s[1 * 33]); o.y = cvt_pk_bf16(s[2 * 33], s[3 * 33]); o.z = cvt_pk_bf16(s[4 * 33], s[5 * 33]); o.w = cvt_pk_bf16(s[6 * 33], s[7 * 33]);
        *(GAS u32x4*)(WT + pg8::paired_off(drow0 + n, k0 + 8 * c, K)) = o; }
    LDS_WAIT(); asm volatile("" ::: "memory");
}
__device__ __forceinline__ int win_row(int n) {
    if (n < D) return n;
    const int which = (n >= 2 * D) ? 1 : 0, cc = n - D - which * D;
    return D + (cc >> 5) * 64 + which * 32 + (cc & 31);
}
__device__ __forceinline__ float cas_pi(float t) { float s, c; sincospif(t, &s, &c); return c + s; }

__device__ __forceinline__ unsigned char* wsp(unsigned char* ws, size_t off) { asm volatile("" : "+s"(ws)); return ws + off; }

struct Ptrs {
    const float *x_prompt, *x_sample, *norm_mix, *a_w_in, *a_conv_w, *a_w_out, *f_w_out, *norm_ffn, *w_up, *w_down, *final_norm;
    float* out; unsigned char* ws;
};

__device__ __forceinline__ void prologue(const Ptrs& P, LAS unsigned char* lds, int gw, int NGW, int wave, int lane_) {
    int lane = lane_; asm volatile("" : "+v"(lane));
    LAS float* scr = (LAS float*)(lds + wave * 16384);
    bf16_t* WIN = (bf16_t*)(P.ws + WS_WIN); bf16_t* AWO = (bf16_t*)(P.ws + WS_AWO); bf16_t* FWO = (bf16_t*)(P.ws + WS_FWO);
    bf16_t* WUP = (bf16_t*)(P.ws + WS_WUP); bf16_t* WDN = (bf16_t*)(P.ws + WS_WDN);
    constexpr int I_IN = (D / 64) * (3 * D / 32), I_SQ = (D / 64) * (D / 32), I_UP = (D / 64) * (DFF / 32), I_DN = (DFF / 64) * (D / 32);
    constexpr int NITEMS = 2 * I_IN + 4 * I_SQ + 4 * I_UP + 4 * I_DN;
    for (int it = gw; it < NITEMS; it += NGW) {
        int r = it;
        if (r < 2 * I_IN) { const int j = r / I_IN; r -= j * I_IN; const int nblk = 3 * D / 32, kb = r / nblk, nb = r % nblk;
            transpose_item(P.a_w_in + (size_t)j * D * 3 * D, D, 3 * D, WIN + (size_t)j * 3 * D * D, 64 * kb, 32 * nb, win_row(32 * nb), P.norm_mix + (2 * j) * D, scr, lane); continue; }
        r -= 2 * I_IN;
        if (r < 2 * I_SQ) { const int j = r / I_SQ; r -= j * I_SQ; const int nblk = D / 32, kb = r / nblk, nb = r % nblk;
            transpose_item(P.a_w_out + (size_t)j * D * D, D, D, AWO + (size_t)j * D * D, 64 * kb, 32 * nb, 32 * nb, nullptr, scr, lane); continue; }
        r -= 2 * I_SQ;
        if (r < 2 * I_SQ) { const int j = r / I_SQ; r -= j * I_SQ; const int nblk = D / 32, kb = r / nblk, nb = r % nblk;
            transpose_item(P.f_w_out + (size_t)j * D * D, D, D, FWO + (size_t)j * D * D, 64 * kb, 32 * nb, 32 * nb, nullptr, scr, lane); continue; }
        r -= 2 * I_SQ;
        if (r < 4 * I_UP) { const int j = r / I_UP; r -= j * I_UP; const int nblk = DFF / 32, kb = r / nblk, nb = r % nblk;
            transpose_item(P.w_up + (size_t)j * D * DFF, D, DFF, WUP + (size_t)j * D * DFF, 64 * kb, 32 * nb, 32 * nb, P.norm_ffn + j * D, scr, lane); continue; }
        r -= 4 * I_UP;
        { const int j = r / I_DN; r -= j * I_DN; const int nblk = D / 32, kb = r / nblk, nb = r % nblk;
            transpose_item(P.w_down + (size_t)j * D * DFF, DFF, D, WDN + (size_t)j * D * DFF, 64 * kb, 32 * nb, 32 * nb, nullptr, scr, lane); }
    }
    const int gl = gw * 64 + lane, NGL = NGW * 64;
    for (int i = gl; i < 2 * NGRP * CG * CG / 8; i += NGL) { const int jl = i / (NGRP * CG * CG / 8), r = i % (NGRP * CG * CG / 8), g = r / (CG * CG / 8), q = r % (CG * CG / 8), c = q / (CG / 8), j0 = (q % (CG / 8)) * 8; float v[8];
        const GAS float* gn = (const GAS float*)P.norm_mix + (2 * jl + 1) * D + g * CG + j0;
#pragma unroll
        for (int e = 0; e < 8; ++e) v[e] = cas_pi(-(float)((c * (j0 + e)) & (CG - 1)) * (1.0f / 128.0f)) * gn[e];
        u32x4 o; o.x = cvt_pk_bf16(v[0], v[1]); o.y = cvt_pk_bf16(v[2], v[3]); o.z = cvt_pk_bf16(v[4], v[5]); o.w = cvt_pk_bf16(v[6], v[7]);
        *(GAS u32x4*)((bf16_t*)(P.ws + WS_PT) + (size_t)i * 8) = o; }
    for (int i = gl; i < SP * RAD; i += NGL) { const int k = i >> 3, s2 = i & 7; float s, c; sincospif((float)((k * s2) & (SP - 1)) * (1.0f / 8192.0f), &s, &c);
        ((GAS f32x2*)(P.ws + WS_TW))[i] = (f32x2){c, s}; }
    for (int i = gl; i < CG * CG / 8; i += NGL) { const int k = i / (CG / 8), s0 = (i % (CG / 8)) * 8; float v[8];
#pragma unroll
        for (int e = 0; e < 8; ++e) v[e] = cas_pi((float)((k * (s0 + e)) & (CG - 1)) * (1.0f / 128.0f));
        u32x4 o; o.x = cvt_pk_bf16(v[0], v[1]); o.y = cvt_pk_bf16(v[2], v[3]); o.z = cvt_pk_bf16(v[4], v[5]); o.w = cvt_pk_bf16(v[6], v[7]);
        *(GAS u32x4*)((bf16_t*)(P.ws + WS_H256) + (size_t)k * CG + s0) = o; }
    for (int i = gl; i < SS * RAD; i += NGL) { const int k = i >> 3, s2 = i & 7; float s, c; sincospif((float)((k * s2) & (SS - 1)) * (1.0f / 1024.0f), &s, &c);
        ((GAS f32x2*)(P.ws + WS_TW + 1 * MiB))[i] = (f32x2){c, s}; }
    for (int q = gw; q < M / 2; q += NGW) {
        const int m = (q >> 3) * 16 + (q & 7), hh = (lane >> 2) & 1, mr = m + 8 * hh;
        const GAS f32x4* xr = (const GAS f32x4*)(mr < MP ? P.x_prompt + (size_t)mr * D : P.x_sample + (size_t)(mr - MP) * D) + (lane >> 3) * 8 + (lane & 3) * 2;
        f32x4 v[8][2]; float s = 0.f;
#pragma unroll
        for (int j = 0; j < 8; ++j) { v[j][0] = xr[64 * j]; v[j][1] = xr[64 * j + 1]; }
        GAS u32x4* o16 = (GAS u32x4*)((bf16_t*)(P.ws + WS_B1) + pg8::paired_off(m, 0, D)) + lane;
#pragma unroll
        for (int j = 0; j < 8; ++j) { u32x4 w; w[0] = cvt_pk_bf16(v[j][0].x, v[j][0].y); w[1] = cvt_pk_bf16(v[j][0].z, v[j][0].w); w[2] = cvt_pk_bf16(v[j][1].x, v[j][1].y); w[3] = cvt_pk_bf16(v[j][1].z, v[j][1].w); o16[64 * j] = w;
#pragma unroll
            for (int e = 0; e < 4; ++e) { const float y0 = bf_lo(w[e]), y1 = bf_hi(w[e]); s += y0 * y0 + y1 * y1; } }
        s += __shfl_xor(s, 1); s += __shfl_xor(s, 2); s += __shfl_xor(s, 8); s += __shfl_xor(s, 16); s += __shfl_xor(s, 32);
        if ((lane & ~4) == 0) ((GAS u64*)(P.ws + WS_RS))[mr] = pg8::rs_fix(s);
    }
}

__device__ __forceinline__ void final_norm_phase(const bf16_t* xs, float* out, const u64* RS, const float* gain, int gw, int NGW, int lane_) {
    int lane = lane_; asm volatile("" : "+v"(lane));
    const int col4 = (lane >> 3) * 8 + (lane & 3) * 2, hh = (lane >> 2) & 1;
    f32x4 gv[8][2];
#pragma unroll
    for (int j = 0; j < 8; ++j) { gv[j][0] = ((const GAS f32x4*)gain)[col4 + 64 * j]; gv[j][1] = ((const GAS f32x4*)gain)[col4 + 64 * j + 1]; }
    for (int q = gw; q < M / 2; q += NGW) {
        const int m = (q >> 3) * 16 + (q & 7), mr = m + 8 * hh;
        const GAS u32x4* xr = (const GAS u32x4*)(xs + pg8::paired_off(m, 0, D)) + lane;
        GAS f32x4* orow = (GAS f32x4*)(out + (size_t)mr * D) + col4;
        const float rstd = pg8::row_rstd(RS + mr);
        u32x4 v[8];
#pragma unroll
        for (int j = 0; j < 8; ++j) v[j] = xr[64 * j];
#pragma unroll
        for (int j = 0; j < 8; ++j) { f32x4 y0, y1; y0.x = bf_lo(v[j][0]); y0.y = bf_hi(v[j][0]); y0.z = bf_lo(v[j][1]); y0.w = bf_hi(v[j][1]); y1.x = bf_lo(v[j][2]); y1.y = bf_hi(v[j][2]); y1.z = bf_lo(v[j][3]); y1.w = bf_hi(v[j][3]);
            orow[64 * j] = y0 * rstd * gv[j][0]; orow[64 * j + 1] = y1 * rstd * gv[j][1]; }
    }
}
__device__ __forceinline__ void conv_phase(const bf16_t* Bb, const bf16_t* Ub, const float* cw, const u64* RS, bf16_t* Gb, int gw, int NGW, int lane_) {
    int lane = lane_; asm volatile("" : "+v"(lane));
    for (int chunk = gw; chunk < M / 8; chunk += NGW) {
        const int m0 = chunk * 8;
        const bool first = (m0 == 0) || (m0 >= MP && ((m0 - MP) & (SS - 1)) == 0);
        const bool last = (m0 + 8 == MP) || (m0 >= MP && ((m0 + 8 - MP) & (SS - 1)) == 0);
        float rr[10];
#pragma unroll
        for (int q = 0; q < 10; ++q) { const bool ok = !((q == 0 && first) || (q == 9 && last)); rr[q] = ok ? pg8::row_rstd(RS + (m0 - 1 + q)) : 0.f; }
#pragma unroll 1
        for (int j = 0; j < 4; ++j) {
            const int ch0 = (lane + 64 * j) * 8;
            float w0[8], w1[8], w2[8];
#pragma unroll
            for (int h = 0; h < 2; ++h) { const f32x4 a = *(const GAS f32x4*)(cw + ch0 + 4 * h), b = *(const GAS f32x4*)(cw + D + ch0 + 4 * h), c = *(const GAS f32x4*)(cw + 2 * D + ch0 + 4 * h);
#pragma unroll
                for (int e = 0; e < 4; ++e) { w0[4 * h + e] = a[e]; w1[4 * h + e] = b[e]; w2[4 * h + e] = c[e]; } }
            const GAS u32x4* up = (const GAS u32x4*)(Ub + (size_t)m0 * D + ch0);
            const GAS u32x4* bp = (const GAS u32x4*)(Bb + (size_t)m0 * D + ch0);
            GAS u32x4* gp = (GAS u32x4*)(Gb + (size_t)m0 * D + ch0);
            u32x4 uu[10], bb[8];
#pragma unroll
            for (int q = 0; q < 10; ++q) { const bool ok = !((q == 0 && first) || (q == 9 && last)); uu[q] = (u32x4){0u, 0u, 0u, 0u}; if (ok) uu[q] = *(up + (ptrdiff_t)(q - 1) * (D / 8)); }
#pragma unroll
            for (int r = 0; r < 8; ++r) bb[r] = bp[(size_t)r * (D / 8)];
#pragma unroll
            for (int r = 0; r < 8; ++r) {
                const float rp = rr[r] * rr[r], rc = rr[r + 1] * rr[r + 1], rn = rr[r + 2] * rr[r + 2], rb = rr[r + 1];
                float o[8];
#pragma unroll
                for (int e = 0; e < 8; ++e) o[e] = rb * bf_at(bb[r], e) * (w0[e] * rp * bf_at(uu[r], e) + w1[e] * rc * bf_at(uu[r + 1], e) + w2[e] * rn * bf_at(uu[r + 2], e));
                u32x4 w; w.x = cvt_pk_bf16(o[0], o[1]); w.y = cvt_pk_bf16(o[2], o[3]); w.z = cvt_pk_bf16(o[4], o[5]); w.w = cvt_pk_bf16(o[6], o[7]);
                gp[(size_t)r * (D / 8)] = w;
            }
        }
    }
}
__device__ __forceinline__ void load_rev(const GAS bf16_t* rowp, int g0, int c0, float (&r)[8]) {
    const u32x4 A = *(const GAS u32x4*)(rowp + g0 + ((248 - c0) & 255)), Bv = *(const GAS u32x4*)(rowp + g0 + ((256 - c0) & 255));
    r[0] = bf_at(Bv, 0);
#pragma unroll
    for (int i = 1; i < 8; ++i) r[i] = bf_at(A, 8 - i);
}
__device__ __forceinline__ void post_phase(int mode, const bf16_t* UP, const bf16_t* US, const f32x2* TWP, const f32x2* TWS, bf16_t* MXP, bf16_t* MXS, const bf16_t* HP256, bf16_t* H2048, int gw, int NGW, int lane_) {
    int lane = lane_; asm volatile("" : "+v"(lane));
    const float SC_S = 0.5f / sqrtf((float)SS * (float)CG), SC_P = 0.5f / sqrtf((float)SP * (float)CG);
    for (int it = gw + (mode == 1 ? SS : 0); it < (mode == 1 ? SS + NB * CG : SS); it += NGW) {
        const bool pr = it < SS;
        const int L = pr ? SS : CG, b = pr ? 0 : (it - SS) >> 8, k1 = pr ? it : (it - SS) & (CG - 1), nk1 = (L - k1) & (L - 1);
        const GAS bf16_t* H = pr ? (const GAS bf16_t*)UP : (const GAS bf16_t*)US + (size_t)b * SS * D;
        GAS bf16_t* O = pr ? (GAS bf16_t*)MXP : (GAS bf16_t*)MXS + (size_t)(MP + b * SS) * D;
        const f32x2* TW = pr ? TWP : TWS; const float sc = pr ? SC_P : SC_S;
        f32x2 st[4];
#pragma unroll
        for (int k2 = 0; k2 < 4; ++k2) st[k2] = TW[(size_t)(k1 + L * k2) * RAD + 1];
#pragma unroll 1
        for (int j = 0; j < 4; ++j) { const int ch0 = (lane + 64 * j) * 8, g0 = ch0 & ~255, c0 = ch0 & 255;
            const int ra = g0 + ((248 - c0) & 255), rb = g0 + ((256 - c0) & 255);
            f32x2 acc[8][4], cw[4];
#pragma unroll
            for (int a = 0; a < 8; ++a) { if (a < 4) cw[a] = (f32x2){1.f, 0.f};
#pragma unroll
                for (int e = 0; e < 4; ++e) acc[a][e] = (f32x2){0.f, 0.f}; }
            const int lsa = ((lane & 32) + (31 - (lane & 31))) * 4, lsb = ((lane & 32) + ((32 - (lane & 31)) & 31)) * 4;
#pragma unroll 1
            for (int hf = 0; hf < 2; ++hf) {
            u32x4 va[4], vp[4];
#pragma unroll
            for (int s2 = 0; s2 < 4; ++s2) {
                va[s2] = *(const GAS u32x4*)(H + ((size_t)(hf * 4 + s2) * L + k1) * D + ch0); vp[s2] = *(const GAS u32x4*)(H + ((size_t)(hf * 4 + s2) * L + nk1) * D + ch0); }
#pragma unroll
            for (int s2 = 0; s2 < 4; ++s2) {
                u32x4 nA, kA; unsigned nB0, kB0;
#pragma unroll
                for (int d = 0; d < 4; ++d) { nA[d] = (unsigned)__builtin_amdgcn_ds_bpermute(lsa, (int)vp[s2][d]); kA[d] = (unsigned)__builtin_amdgcn_ds_bpermute(lsa, (int)va[s2][d]); }
                nB0 = (unsigned)__builtin_amdgcn_ds_bpermute(lsb, (int)vp[s2][0]); kB0 = (unsigned)__builtin_amdgcn_ds_bpermute(lsb, (int)va[s2][0]);
                float Ev[8], Ov[8];
                Ev[0] = bf_at(va[s2], 0) + bf_lo(nB0); Ov[0] = bf_at(vp[s2], 0) - bf_lo(kB0);
#pragma unroll
                for (int e = 1; e < 8; ++e) { Ev[e] = bf_at(va[s2], e) + bf_at(nA, 8 - e); Ov[e] = bf_at(vp[s2], e) - bf_at(kA, 8 - e); }
#pragma unroll
                for (int k2 = 0; k2 < 4; ++k2) { const f32x2 cc = (f32x2){cw[k2].x, cw[k2].x}, ss = (f32x2){cw[k2].y, cw[k2].y};
#pragma unroll
                    for (int e = 0; e < 4; ++e) { acc[4 * (s2 & 1) + k2][e] = __builtin_elementwise_fma((f32x2){Ev[2 * e], Ev[2 * e + 1]}, cc, acc[4 * (s2 & 1) + k2][e]);
                                                  acc[4 * (s2 & 1) + k2][e] = __builtin_elementwise_fma((f32x2){Ov[2 * e], Ov[2 * e + 1]}, ss, acc[4 * (s2 & 1) + k2][e]); }
                    const float nc = cw[k2].x * st[k2].x - cw[k2].y * st[k2].y, ns = cw[k2].y * st[k2].x + cw[k2].x * st[k2].y; cw[k2] = (f32x2){nc, ns}; }
            }
            }
#pragma unroll
            for (int k2 = 0; k2 < 8; ++k2) { u32x4 w; f32x2 o[4];
#pragma unroll
                for (int e = 0; e < 4; ++e) o[e] = (k2 < 4 ? acc[k2][e] + acc[4 + k2][e] : acc[k2 - 4][e] - acc[k2][e]) * sc;
                w.x = cvt_pk_bf16(o[0].x, o[0].y); w.y = cvt_pk_bf16(o[1].x, o[1].y);
                w.z = cvt_pk_bf16(o[2].x, o[2].y); w.w = cvt_pk_bf16(o[3].x, o[3].y);
                *(GAS u32x4*)(O + (size_t)(k1 + L * k2) * D + ch0) = w; }
        }
    }
    if (mode == 1) {
        for (int it = gw; it < RAD * CG; it += NGW) {
            const int t = it >> 8, k1 = it & (CG - 1), nk1 = (CG - k1) & (CG - 1);
            f32x2 st[4];
#pragma unroll
            for (int k2 = 0; k2 < 4; ++k2) st[k2] = TWS[(size_t)(k1 + CG * k2) * RAD + 1];
#pragma unroll 1
            for (int j = 0; j < 4; ++j) { const int ch0 = (lane + 64 * j) * 8;
                f32x2 acc[8][4], cw[4];
#pragma unroll
                for (int a = 0; a < 8; ++a) { if (a < 4) cw[a] = (f32x2){1.f, 0.f};
#pragma unroll
                    for (int e = 0; e < 4; ++e) acc[a][e] = (f32x2){0.f, 0.f}; }
                {
                    u32x4 va[8], vp[8];
#pragma unroll
                    for (int q = 0; q < 8; ++q) { const int s2 = t + 8 * q;
                        va[q] = *(const GAS u32x4*)((const GAS bf16_t*)HP256 + ((size_t)s2 * CG + k1) * D + ch0);
                        vp[q] = *(const GAS u32x4*)((const GAS bf16_t*)HP256 + ((size_t)s2 * CG + nk1) * D + ch0); }
#pragma unroll
                    for (int q = 0; q < 8; ++q) {
#pragma unroll
                        for (int k2 = 0; k2 < 4; ++k2) { const f32x2 cc = (f32x2){cw[k2].x, cw[k2].x}, ss = (f32x2){cw[k2].y, cw[k2].y};
#pragma unroll
                            for (int e = 0; e < 4; ++e) { acc[4 * (q & 1) + k2][e] = __builtin_elementwise_fma((f32x2){bf_at(va[q], 2 * e), bf_at(va[q], 2 * e + 1)}, cc, acc[4 * (q & 1) + k2][e]);
                                                          acc[4 * (q & 1) + k2][e] = __builtin_elementwise_fma((f32x2){bf_at(vp[q], 2 * e), bf_at(vp[q], 2 * e + 1)}, ss, acc[4 * (q & 1) + k2][e]); }
                            const float nc = cw[k2].x * st[k2].x - cw[k2].y * st[k2].y, ns = cw[k2].y * st[k2].x + cw[k2].x * st[k2].y; cw[k2] = (f32x2){nc, ns}; }
                    }
                }
#pragma unroll
                for (int k2 = 0; k2 < 8; ++k2) { u32x4 w; f32x2 o[4];
#pragma unroll
                    for (int e = 0; e < 4; ++e) o[e] = k2 < 4 ? acc[k2][e] + acc[4 + k2][e] : acc[k2 - 4][e] - acc[k2][e];
                    w.x = cvt_pk_bf16(o[0].x, o[0].y); w.y = cvt_pk_bf16(o[1].x, o[1].y);
                    w.z = cvt_pk_bf16(o[2].x, o[2].y); w.w = cvt_pk_bf16(o[3].x, o[3].y);
                    *(GAS u32x4*)((GAS bf16_t*)H2048 + ((size_t)t * SS + k1 + CG * k2) * D + ch0) = w; }
            }
        }
    }
}

#define TIC() do { if (PROBE_CAT) pt0 = __builtin_amdgcn_s_memrealtime(); } while (0)
#define TOC(cat) do { if (PROBE_CAT == (cat)) pacc += __builtin_amdgcn_s_memrealtime() - pt0; } while (0)
#define GRID_BAR() do { TIC(); xcd_barrier(bar); TOC(2); } while (0)
__global__ void __launch_bounds__(NWAVES * 64, 2) fwd_kernel(Ptrs P) {
    extern __shared__ __attribute__((aligned(16))) unsigned char lds_raw[];
    LAS unsigned char* lds = (LAS unsigned char*)lds_raw;
    const int tid = threadIdx.x, lane = tid & 63, wave = __builtin_amdgcn_readfirstlane(tid >> 6);
    const int G = gridDim.x, bx = blockIdx.x;
    const int vcu = (G % 8 == 0) ? (bx % 8) * (G / 8) + bx / 8 : bx;
    const int gw = vcu * NWAVES + wave, NGW = G * NWAVES;
    for (int u = tid; u < (LDS_BYTES - LDSCTL_OFF) / 4; u += NWAVES * 64) ((LAS unsigned*)(lds + LDSCTL_OFF))[u] = 0u;
    __syncthreads();
    volatile LAS unsigned* MISC = (volatile LAS unsigned*)(lds + MISC_OFF);
    XcdBarrier bar = xcd_barrier_post((unsigned*)(P.ws + WS_CTL) + CW_BAR, MISC + 8);

#define WIN ((bf16_t*)wsp(P.ws, WS_WIN))
#define AWO ((bf16_t*)wsp(P.ws, WS_AWO))
#define FWO ((bf16_t*)wsp(P.ws, WS_FWO))
#define WUP ((bf16_t*)wsp(P.ws, WS_WUP))
#define WDN ((bf16_t*)wsp(P.ws, WS_WDN))
#define HART ((bf16_t*)wsp(P.ws, WS_HART))
#define PT ((bf16_t*)wsp(P.ws, WS_PT))
#define TW ((const f32x2*)wsp(P.ws, WS_TW))
#define TWS ((const f32x2*)wsp(P.ws, WS_TW + 1 * MiB))
#define H256 ((bf16_t*)wsp(P.ws, WS_H256))
#define B1 ((bf16_t*)wsp(P.ws, WS_B1))
#define B2 ((bf16_t*)wsp(P.ws, WS_B2))
#define B3 ((bf16_t*)wsp(P.ws, WS_B3))

    unsigned long long pacc = 0ull, pt0 = 0ull;
    TIC(); prologue(P, lds, gw, NGW, wave, lane); TOC(1);
    GRID_BAR();

#define PTG PT
#define RSB ((u64*)wsp(P.ws, WS_RS))
#define XS B1
#pragma unroll 1
    for (int layer = 0; layer < 4; ++layer) {
        const int j = layer >> 1;
        u64* RS0 = RSB + (size_t)(2 * layer) * (RS_STRIDE / 8);
        u64* RS1 = RS0 + RS_STRIDE / 8;
        u64* RS2 = RS1 + RS_STRIDE / 8;
        if ((layer & 1) == 0) {
            {
                pg8::DescPlain g{XS, WIN + (size_t)j * 3 * D * D, D, D, D}; pg8::StaticOrder S; S.init(M, 3 * D, G, bx, 4, 1);
                pg8::EpiGate E{B2, B3};
                pg8::gemm_phase<pg8::DescPlain, pg8::EpiGate, true, true>(lds, g, S, E, pacc);
            }
            GRID_BAR();
            TIC(); conv_phase(B2, B3, P.a_conv_w + (size_t)j * 3 * D, RS0, B2, gw, NGW, lane); TOC(1);
            GRID_BAR();
        } else {
            bf16_t* VTS = B2 + (size_t)RAD * D * SS; bf16_t* USM = B3 + (size_t)RAD * SS * D;
#pragma unroll 1
            for (int pr = 1; pr >= 0; --pr) {
                pg8::DescF0 g{PTG + (size_t)j * NGRP * CG * CG, pr ? XS : XS + (size_t)MP * D, CG, CG, pr ? 64 * D : 8 * D, pr}; pg8::StaticOrder S; S.init(D, pr ? MP : MS, G, bx);
                pg8::EpiBf16<2> E{pr ? B2 : VTS, CG, RS0, pr, nullptr, 0};
                pg8::gemm_phase<pg8::DescF0, pg8::EpiBf16<2>, true, true>(lds, g, S, E, pacc);
            }
            GRID_BAR();
            {
                pg8::DescF2 g{H256, B2, CG, CG, CG, 0, 0}; pg8::StaticOrder S; S.init(M, D, G, bx);
                pg8::EpiBf16<0> E{B3, D, nullptr, 0, nullptr, 0};
                pg8::gemm_phase<pg8::DescF2, pg8::EpiBf16<0>, true, true>(lds, g, S, E, pacc);
            }
            GRID_BAR();
#pragma unroll 1
            for (int mode = 1; mode <= 2; ++mode) {
                TIC(); post_phase(mode, B2, USM, TW, TWS, B3, B2, B3, B2, gw, NGW, lane); TOC(1);
                GRID_BAR();
            }
        }
        {
            pg8::DescSplit g{(layer & 1) ? B3 : B2, B2 + (size_t)MP * D, MP / BMT, ((layer & 1) == 0 ? AWO : FWO) + (size_t)j * D * D, D, D, D, 0}; pg8::StaticOrder S; S.init(M, D, G, bx, 4);
            pg8::EpiRes<false> E{XS, RS1, 0, nullptr};
            pg8::gemm_phase<pg8::DescSplit, pg8::EpiRes<false>, true, true>(lds, g, S, E, pacc);
        }
        GRID_BAR();
        {
            pg8::DescPlain g{XS, WUP + (size_t)layer * D * DFF, D, D, D}; pg8::StaticOrder S; S.init(M, DFF, G, bx, 4, 1);
            pg8::EpiBf16<1> E{B2, DFF, nullptr, 0, (bf16_t*)P.out, MCH / BMT};
            pg8::gemm_phase<pg8::DescPlain, pg8::EpiBf16<1>, true, true>(lds, g, S, E, pacc);
        }
        GRID_BAR();
        {
            pg8::DescSplit g{B2, (const bf16_t*)P.out, MCH / BMT, WDN + (size_t)layer * D * DFF, DFF, DFF, DFF, 1}; pg8::StaticOrder S; S.init(M, D, G, bx, 4);
            pg8::EpiRes<true> E{XS, RS2, 0, RS1};
            pg8::gemm_phase<pg8::DescSplit, pg8::EpiRes<true>, true, true>(lds, g, S, E, pacc);
        }
        GRID_BAR();
    }
    TIC(); final_norm_phase(XS, P.out, RSB + (size_t)8 * (RS_STRIDE / 8), P.final_norm, gw, NGW, lane); TOC(1);
    if (PROBE_CAT && bx == 0 && wave == 0) { const unsigned long long te = __builtin_amdgcn_s_memrealtime() + PROBE_ALPHA * pacc; while (__builtin_amdgcn_s_memrealtime() < te) __builtin_amdgcn_s_sleep(8); }
}

#undef WIN
#undef AWO
#undef FWO
#undef WUP
#undef WDN
#undef HART
#undef PT
#undef TW
#undef TWS
#undef H256
#undef B1
#undef B2
#undef B3
#undef PTG
#undef RSB
#undef XS
extern "C" void kernel_launch(void* const* d_in, const int* in_sizes, int n_in, void* d_out, int out_size, void* d_ws, size_t ws_size, hipStream_t stream) {
    static int grid = 0;
    if (grid == 0) {
        if (n_in != 11 || out_size != M * D || ws_size < WS_END) { fprintf(stderr, "kernel_launch: unexpected shapes (n_in %d, out %d, ws %zu)\n", n_in, out_size, ws_size); grid = -1; return; }
        int dev = 0, cus = 0, per_cu = 0;
        if (hipGetDevice(&dev) != hipSuccess || hipDeviceGetAttribute(&cus, hipDeviceAttributeMultiprocessorCount, dev) != hipSuccess) { grid = -1; return; }
        if (hipFuncSetAttribute((const void*)fwd_kernel, hipFuncAttributeMaxDynamicSharedMemorySize, LDS_BYTES) != hipSuccess) { fprintf(stderr, "kernel_launch: hipFuncSetAttribute failed\n"); grid = -1; return; }
        if (hipOccupancyMaxActiveBlocksPerMultiprocessor(&per_cu, (const void*)fwd_kernel, NWAVES * 64, LDS_BYTES) != hipSuccess || per_cu < 1)
            fprintf(stderr, "kernel_launch: occupancy query reports %d workgroups per CU\n", per_cu);
        (void)hipGetLastError();
        grid = cus;
    }
    if (grid < 0) return;
    if (hipMemsetAsync((char*)d_ws + WS_CTL, 0, CTL_ZERO_BYTES, stream) != hipSuccess) return;
    Ptrs p{};
    p.x_prompt = (const float*)d_in[0]; p.x_sample = (const float*)d_in[1]; p.norm_mix = (const float*)d_in[2]; p.a_w_in = (const float*)d_in[3];
    p.a_conv_w = (const float*)d_in[4]; p.a_w_out = (const float*)d_in[5]; p.f_w_out = (const float*)d_in[6]; p.norm_ffn = (const float*)d_in[7];
    p.w_up = (const float*)d_in[8]; p.w_down = (const float*)d_in[9]; p.final_norm = (const float*)d_in[10];
    p.out = (float*)d_out; p.ws = (unsigned char*)d_ws;
    hipLaunchKernelGGL(fwd_kernel, dim3(grid), dim3(NWAVES * 64), LDS_BYTES, stream, p);
    const hipError_t le = hipPeekAtLastError();
    if (le != hipSuccess) fprintf(stderr, "kernel_launch: launch failed: %s\n", hipGetErrorName(le));
    (void)in_sizes;
}
```

```cpp
#include <hip/hip_runtime.h>
#include <cstdio>
#include <cstdint>

#ifndef PROBE_CAT
#define PROBE_CAT 0
#endif
#define PROBE_ALPHA 4
#define LAS __attribute__((address_space(3)))
#define GAS __attribute__((address_space(1)))
typedef unsigned short bf16_t;
typedef short bf16x8 __attribute__((ext_vector_type(8)));
typedef float f32x4 __attribute__((ext_vector_type(4)));
typedef float f32x2 __attribute__((ext_vector_type(2)));
typedef unsigned u32x4 __attribute__((ext_vector_type(4)));
typedef unsigned u32x2 __attribute__((ext_vector_type(2)));
typedef GAS unsigned gu32;
typedef unsigned long long u64;

constexpr int D = 2048, DFF = 8192, SP = 16384, SS = 2048, NB = 16;
constexpr int MP = SP, MS = NB * SS, M = MP + MS;
constexpr int CG = 256, NGRP = 8, RAD = SP / SS;
constexpr int NSEQ = RAD + NB;
constexpr int MCH = M / 2, BMT = 256;
constexpr float RMS_EPS = 1e-6f;

constexpr size_t MiB = 1u << 20;
constexpr size_t WS_CTL = 0, CTL_ZERO_BYTES = 5 * MiB;
constexpr size_t WS_RS = 1 * MiB, RS_STRIDE = 384 * 1024;
constexpr size_t WS_WIN = 5 * MiB;
constexpr size_t WS_AWO = WS_WIN + 48 * MiB;
constexpr size_t WS_FWO = WS_AWO + 16 * MiB;
constexpr size_t WS_WUP = WS_FWO + 16 * MiB;
constexpr size_t WS_WDN = WS_WUP + 128 * MiB;
constexpr size_t WS_HART = WS_WDN + 128 * MiB;
constexpr size_t WS_PT = WS_HART + 8 * MiB;
constexpr size_t WS_TW = WS_PT + 2 * MiB;
constexpr size_t WS_H256 = WS_TW + 2 * MiB;
constexpr size_t WS_B1 = WS_H256 + 1 * MiB;
constexpr size_t WS_B2 = WS_B1 + 192 * MiB;
constexpr size_t WS_B3 = WS_B2 + 192 * MiB;
constexpr size_t WS_END = WS_B3 + 192 * MiB;
static_assert((size_t)M * D * 2 == 192 * MiB && (size_t)MCH * DFF * 2 == 384 * MiB && (size_t)M * 8 == RS_STRIDE && WS_RS + 9 * RS_STRIDE <= CTL_ZERO_BYTES, "buffer sizes");
constexpr int CW_BAR = 4096;

constexpr int RING_BYTES = 131072, LDSCTL_OFF = RING_BYTES, MISC_OFF = LDSCTL_OFF + 320, LDS_BYTES = 147456;
constexpr int NWAVES = 8;

__device__ __forceinline__ unsigned cvt_pk_bf16(float lo, float hi) { unsigned r; asm("v_cvt_pk_bf16_f32 %0, %1, %2" : "=v"(r) : "v"(lo), "v"(hi)); return r; }
__device__ __forceinline__ float bf_lo(unsigned w) { return __builtin_bit_cast(float, w << 16); }
__device__ __forceinline__ float bf_hi(unsigned w) { return __builtin_bit_cast(float, w & 0xffff0000u); }
typedef float f32x2 __attribute__((ext_vector_type(2)));
__device__ __forceinline__ float dot2_bf16(unsigned a, unsigned b, float c) { typedef __bf16 bf2 __attribute__((ext_vector_type(2))); return __builtin_amdgcn_fdot2_f32_bf16(__builtin_bit_cast(bf2, a), __builtin_bit_cast(bf2, b), c, false); }
__device__ __forceinline__ float relu1(float x) { float r; asm("v_max_f32 %0, 0, %1" : "=v"(r) : "v"(x)); return r; }
__device__ __forceinline__ float quad_rows_sum(float s) {
    float a = s, b = s;
    asm volatile("s_nop 1\n\tv_permlane16_swap_b32 %0, %1" : "+v"(a), "+v"(b));
    const float t = a + b; a = t; b = t;
    asm volatile("s_nop 1\n\tv_permlane32_swap_b32 %0, %1" : "+v"(a), "+v"(b));
    return a + b;
}
__device__ __forceinline__ float bf_at(const u32x4& v, int i) { const unsigned w = v[i >> 1]; return (i & 1) ? bf_hi(w) : bf_lo(w); }
#define LDS_WAIT() asm volatile("s_waitcnt lgkmcnt(0)" ::: "memory")

namespace pg8 {
constexpr int BM = 256, BK = 64, HALF = 128, HTB = HALF * BK * 2, STAGE_BYTES = 8 * HTB, NXCD = 8, WGM = 8;
__host__ __device__ __forceinline__ int lds_byte(int r, int c) { const int st = (r >> 4) * 2 + (c >> 5), rr = r & 15, cc = c & 31, ob = rr * 64 + cc * 2; return st * 1024 + (ob ^ (((ob >> 9) & 1) << 5)); }
__host__ __device__ __forceinline__ void stage_rc(int b, int& R, int& C) { const int st = b / 1024, sb = b % 1024, swz = sb ^ (((sb >> 9) & 1) << 5); R = (st >> 1) * 16 + swz / 64; C = (st & 1) * 32 + (swz % 64) / 2; }
__host__ __device__ __forceinline__ int perm32(int rho) { const int n = rho >> 4, i = rho & 15; return 8 * (i >> 2) + 4 * n + (i & 3); }

__host__ __device__ __forceinline__ size_t paired_off(int row, int k, int K) { return (size_t)(row >> 4) * 16 * K + (size_t)((row & 7) * (K >> 5) + (k >> 5)) * 64 + ((row >> 3) & 1) * 32 + (k & 31); }
struct Unit { int pm, pn; };
struct StaticOrder {
    int nM, nN, nwg, G, c, wgm, rev;
    __device__ __forceinline__ void init(int M_, int N_, int G_, int c_, int wgm_ = WGM, int rev_ = 0) { nM = M_ / BM; nN = N_ / BM; nwg = nM * nN; G = G_; c = c_; wgm = wgm_; rev = (rev_ && nwg % G_ == 0) ? 1 : 0; }
    __device__ __forceinline__ bool next(int i, Unit& u) const {
        if (i * G >= nwg) return false;
        const long L = (long)(rev ? nwg / G - 1 - i : i) * G + c; if (L >= nwg) return false;
        int wgid = (int)L; { const int q = nwg / NXCD, r = nwg % NXCD, xcd = wgid % NXCD, off = wgid / NXCD; wgid = (xcd < r ? xcd * (q + 1) : r * (q + 1) + (xcd - r) * q) + off; }
        const int nig = wgm * nN, gid = wgid / nig, fm = gid * wgm, gsz = (nM - fm) < wgm ? (nM - fm) : wgm;
        u.pm = fm + ((wgid % nig) % gsz); u.pn = (wgid % nig) / gsz; return true;
    }
};
struct DescPlain { const bf16_t* A; const bf16_t* Bt; int K, lda, ldb;
    __device__ __forceinline__ unsigned voffa(int R, int C) const { return (unsigned)paired_off(R, C, lda) * 2u; }
    __device__ __forceinline__ unsigned voffb(int Rb, int C) const { return (unsigned)paired_off(Rb, C, ldb) * 2u; }
    __device__ __forceinline__ size_t kstepa() const { return 4 * BK; }
    __device__ __forceinline__ size_t hstepa() const { return (size_t)HALF * lda * 2; }
    __device__ __forceinline__ size_t kstepb() const { return 4 * BK; }
    __device__ __forceinline__ const char* abase(const Unit& u) const { return (const char*)A + (size_t)u.pm * BM * lda * 2; }
    __device__ __forceinline__ const char* bbase(const Unit& u) const { return (const char*)Bt + (size_t)u.pn * BM * ldb * 2; } };
struct DescSplit { const bf16_t* A; const bf16_t* Ahi; int msplit; const bf16_t* Bt; int K, lda, ldb, ap;
    __device__ __forceinline__ unsigned voffa(int R, int C) const { return ap ? (unsigned)(((R >> 4) * 2 + (C >> 5)) * 1024 + (R & 7) * 128 + ((R >> 3) & 1) * 64 + (C & 31) * 2) : (unsigned)(R * lda + C) * 2u; }
    __device__ __forceinline__ size_t hstepa() const { return ap ? (size_t)16384 : (size_t)HALF * lda * 2; }
    __device__ __forceinline__ unsigned voffb(int Rb, int C) const { return (unsigned)paired_off(Rb, C, ldb) * 2u; }
    __device__ __forceinline__ size_t kstepa() const { return ap ? 32768 : 2 * BK; }
    __device__ __forceinline__ size_t kstepb() const { return 4 * BK; }
    __device__ __forceinline__ const char* abase(const Unit& u) const { return u.pm < msplit ? (const char*)A + (size_t)u.pm * BM * lda * 2 : (const char*)Ahi + (size_t)(u.pm - msplit) * BM * lda * 2; }
    __device__ __forceinline__ const char* bbase(const Unit& u) const { return (const char*)Bt + (size_t)u.pn * BM * ldb * 2; } };
struct DescF0 { const bf16_t* A; const bf16_t* Bt; int K, lda, ldb, prompt;
    __device__ __forceinline__ const char* abase(const Unit& u) const { return (const char*)A + (size_t)u.pm * CG * CG * 2; }
    __device__ __forceinline__ const char* bbase(const Unit& u) const {
        const int row0 = prompt ? u.pn : (u.pn >> 3) * SS + (u.pn & 7);
        return (const char*)Bt + paired_off(row0, u.pm * CG, D) * 2; }
    __device__ __forceinline__ unsigned voffa(int R, int C) const { return (unsigned)(R * lda + C) * 2u; }
    __device__ __forceinline__ unsigned voffb(int Rb, int C) const {
        const unsigned rp = prompt ? (unsigned)Rb * 64u * D : (unsigned)(Rb >> 1) * 16u * D + (unsigned)(Rb & 1) * 32u;
        return (rp + (unsigned)((C >> 5) * 64 + (C & 31))) * 2u; }
    __device__ __forceinline__ size_t kstepa() const { return 2 * BK; }
    __device__ __forceinline__ size_t hstepa() const { return (size_t)HALF * lda * 2; }
    __device__ __forceinline__ size_t kstepb() const { return 4 * BK; } };
struct DescF2 { const bf16_t* A; const bf16_t* Bt; int K, lda, ldb, amask, ashift;
    __device__ __forceinline__ unsigned voffa(int R, int C) const { return (unsigned)(R * lda + C) * 2u; }
    __device__ __forceinline__ unsigned voffb(int Rb, int C) const { return (unsigned)(Rb * ldb + C) * 2u; }
    __device__ __forceinline__ size_t kstepa() const { return 2 * BK; }
    __device__ __forceinline__ size_t hstepa() const { return (size_t)HALF * lda * 2; }
    __device__ __forceinline__ size_t kstepb() const { return 2 * BK; }
    __device__ __forceinline__ const char* abase(const Unit& u) const { return (const char*)A + (size_t)(u.pm & amask) * BM * lda * 2; }
    __device__ __forceinline__ const char* bbase(const Unit& u) const { return (const char*)Bt + ((size_t)(u.pm >> ashift) * D + (size_t)u.pn * BM) * ldb * 2; } };

__device__ __forceinline__ float rstd_of(float ss) { return 1.0f / sqrtf(ss * (1.0f / D) + RMS_EPS); }
constexpr float RS_FIX = 1048576.0f;
__device__ __forceinline__ u64 rs_fix(float s) { return (u64)(s * RS_FIX); }
__device__ __forceinline__ float row_rstd(const u64* p) { return rstd_of((float)__hip_atomic_load((GAS u64*)p, __ATOMIC_RELAXED, __HIP_MEMORY_SCOPE_AGENT) * (1.0f / RS_FIX)); }
__device__ __forceinline__ unsigned dpp_ror8(unsigned old, unsigned src, int bank_mask) {
    return bank_mask == 0xC ? (unsigned)__builtin_amdgcn_update_dpp((int)old, (int)src, 0x128, 0xf, 0xC, false) : (unsigned)__builtin_amdgcn_update_dpp((int)old, (int)src, 0x128, 0xf, 0x3, false); }
__device__ __forceinline__ void widen(const u32x4& own0, const u32x4& own1, u32x4& r1, u32x4& r2) {
#pragma unroll
    for (int e = 0; e < 4; ++e) { r1[e] = dpp_ror8(own0[e], own1[e], 0xC); r2[e] = dpp_ror8(own1[e], own0[e], 0x3); }
}
template <bool SCALE> struct EpiRes {
    static constexpr bool PERM = true;
    bf16_t* XS; u64* RS; int row0; const u64* RSin;
    __device__ __forceinline__ void operator()(const f32x4 (&acc)[2][2][4][2], const Unit& u, int wr, int wc, int fr, int fq) const {
        const int rt = row0 + u.pm * BM;
        GAS char* ub = (GAS char*)XS + (size_t)rt * D * 2 + (size_t)(8 * u.pn + 2 * wc) * 128 + (size_t)wr * 64 * D * 2;
        const unsigned lp = (unsigned)((fr & 7) * (D >> 5) * 64 + (fr >> 3) * 32 + 8 * fq) * 2u;
        u32x4 xv[2][4][2];
#pragma unroll
        for (int ai = 0; ai < 2; ++ai)
#pragma unroll
            for (int m = 0; m < 4; ++m) { const GAS char* rb = ub + (size_t)(ai * HALF + m * 16) * D * 2;
#pragma unroll
                for (int h = 0; h < 2; ++h) xv[ai][m][h] = *(const GAS u32x4*)(rb + lp + h * 128); }
        float rsc[2][4];
#pragma unroll
        for (int ai = 0; ai < 2; ++ai)
#pragma unroll
            for (int m = 0; m < 4; ++m) { rsc[ai][m] = 1.f;
                if (SCALE) { const float r = row_rstd(RSin + (rt + ai * HALF + wr * 64 + m * 16 + fr)); rsc[ai][m] = r * r; } }
#pragma unroll
        for (int ai = 0; ai < 2; ++ai)
#pragma unroll
            for (int m = 0; m < 4; ++m) { GAS char* rb = ub + (size_t)(ai * HALF + m * 16) * D * 2;
                const float sc = rsc[ai][m];
                float s = 0.f, s1 = 0.f;
                u32x4 w[2];
                const f32x2 sc2 = (f32x2){sc, sc};
#pragma unroll
                for (int bj = 0; bj < 2; ++bj) {
#pragma unroll
                    for (int n = 0; n < 2; ++n) { const f32x4 a = acc[ai][bj][m][n]; const unsigned x0 = xv[ai][m][bj][2 * n], x1 = xv[ai][m][bj][2 * n + 1];
                        f32x2 p0 = (f32x2){bf_lo(x0), bf_hi(x0)}, p1 = (f32x2){bf_lo(x1), bf_hi(x1)};
                        const f32x2 a0 = (f32x2){a[0], a[1]}, a1 = (f32x2){a[2], a[3]};
                        if (SCALE) { p0 = __builtin_elementwise_fma(a0, sc2, p0); p1 = __builtin_elementwise_fma(a1, sc2, p1); } else { p0 += a0; p1 += a1; }
                        const unsigned w0 = cvt_pk_bf16(p0[0], p0[1]), w1 = cvt_pk_bf16(p1[0], p1[1]);
                        w[bj][2 * n] = w0; w[bj][2 * n + 1] = w1;
                        s = dot2_bf16(w0, w0, s); s1 = dot2_bf16(w1, w1, s1); } }
                s += s1;
                *(GAS u32x4*)(rb + lp) = w[0]; *(GAS u32x4*)(rb + lp + 128) = w[1];
                s = quad_rows_sum(s);
                if (fq == 0) __hip_atomic_fetch_add((GAS u64*)RS + (rt + ai * HALF + wr * 64 + m * 16 + fr), rs_fix(s), __ATOMIC_RELAXED, __HIP_MEMORY_SCOPE_AGENT);
                __builtin_amdgcn_sched_barrier(0);
            }
    }
};
template <int MODE  > struct EpiBf16 {
    static constexpr bool PERM = true;
    bf16_t* O; int ldc; const u64* RS; int row0; bf16_t* Ohi; int msplit;
    __device__ __forceinline__ void operator()(const f32x4 (&acc)[2][2][4][2], const Unit& u, int wr, int wc, int fr, int fq) const {
        GAS char* ub;
        if (MODE == 2) ub = (GAS char*)O + ((size_t)u.pn * D + (size_t)u.pm * BM) * BM * 2;
        else if (MODE == 1 && u.pm >= msplit) ub = (GAS char*)Ohi + ((size_t)(u.pm - msplit) * BM * ldc + (size_t)u.pn * BM) * 2;
        else ub = (GAS char*)O + ((size_t)u.pm * BM * ldc + (size_t)u.pn * BM) * 2;
        const unsigned lo = (unsigned)((wr * 64 + (fr & 7)) * ldc + wc * 64) * 2u + (unsigned)(4 * (fr >> 3) + fq) * 16u;
        f32x4 cs[2][2];
        if (MODE == 2) {
            const int ln = fq * 16 + fr, tc = wc * 64 + ln;
            const u64* tp = RS + (row0 ? u.pn + 64 * tc : MP + (u.pn >> 3) * SS + (u.pn & 7) + 8 * tc);
            const float tr = row_rstd(tp);
#pragma unroll
            for (int bj = 0; bj < 2; ++bj)
#pragma unroll
                for (int n = 0; n < 2; ++n)
#pragma unroll
                    for (int j = 0; j < 4; ++j) cs[bj][n][j] = __shfl(tr, bj * 32 + 8 * fq + 4 * n + j);
        } else {
#pragma unroll
            for (int bj = 0; bj < 2; ++bj)
#pragma unroll
                for (int n = 0; n < 2; ++n)
#pragma unroll
                    for (int j = 0; j < 4; ++j) cs[bj][n][j] = 0.f;
        }
        float rsc[2][4];
#pragma unroll
        for (int ai = 0; ai < 2; ++ai)
#pragma unroll
            for (int m = 0; m < 4; ++m) { rsc[ai][m] = 1.f;
            }
#pragma unroll
        for (int ai = 0; ai < 2; ++ai)
#pragma unroll
            for (int m = 0; m < 4; ++m) { GAS char* rb = ub + (size_t)(ai * HALF + m * 16) * ldc * 2;
                const float sc = rsc[ai][m];
                u32x4 w[2];
#pragma unroll
                for (int bj = 0; bj < 2; ++bj) { f32x4 v0 = acc[ai][bj][m][0], v1 = acc[ai][bj][m][1];
                    if (MODE == 1) { const f32x4 a = (f32x4){relu1(v0[0]), relu1(v0[1]), relu1(v0[2]), relu1(v0[3])}, b = (f32x4){relu1(v1[0]), relu1(v1[1]), relu1(v1[2]), relu1(v1[3])}; v0 = a * a; v1 = b * b; }
                    if (MODE == 2) { v0 = v0 * cs[bj][0]; v1 = v1 * cs[bj][1]; }
                    w[bj].x = cvt_pk_bf16(v0[0], v0[1]); w[bj].y = cvt_pk_bf16(v0[2], v0[3]); w[bj].z = cvt_pk_bf16(v1[0], v1[1]); w[bj].w = cvt_pk_bf16(v1[2], v1[3]); }
                if (MODE == 1) {
                    GAS char* hb = u.pm >= msplit ? (GAS char*)Ohi + (size_t)(u.pm - msplit) * BM * ldc * 2 : (GAS char*)O + (size_t)u.pm * BM * ldc * 2;
                    GAS char* gb = hb + (size_t)(4 * u.pn + wc) * 32768 + (size_t)(ai * 8 + wr * 4 + m) * 2048;
                    const unsigned lp = (unsigned)((fr & 7) * 128 + (fr >> 3) * 64 + fq * 16);
                    __builtin_nontemporal_store(w[0], (GAS u32x4*)(gb + lp)); __builtin_nontemporal_store(w[1], (GAS u32x4*)(gb + lp + 1024));
                } else { u32x4 r1, r2; widen(w[0], w[1], r1, r2); *(GAS u32x4*)(rb + lo) = r1; *(GAS u32x4*)(rb + lo + 8 * ldc * 2) = r2; } }
    }
};
struct EpiGate {
    static constexpr bool PERM = true;
    bf16_t* Bo; bf16_t* Uo;
    __device__ __forceinline__ void operator()(const f32x4 (&acc)[2][2][4][2], const Unit& u, int wr, int wc, int fr, int fq) const {
        if (u.pn < 8) {
            GAS char* ub = (GAS char*)Bo + ((size_t)u.pm * BM * D + (size_t)u.pn * BM) * 2;
            const unsigned lo = (unsigned)((wr * 64 + (fr & 7)) * D + wc * 64) * 2u + (unsigned)(4 * (fr >> 3) + fq) * 16u;
#pragma unroll
            for (int ai = 0; ai < 2; ++ai)
#pragma unroll
                for (int m = 0; m < 4; ++m) { GAS char* rb = ub + (size_t)(ai * HALF + m * 16) * D * 2;
                    u32x4 w[2];
#pragma unroll
                    for (int bj = 0; bj < 2; ++bj) { const f32x4 v0 = acc[ai][bj][m][0], v1 = acc[ai][bj][m][1];
                        w[bj].x = cvt_pk_bf16(v0[0], v0[1]); w[bj].y = cvt_pk_bf16(v0[2], v0[3]); w[bj].z = cvt_pk_bf16(v1[0], v1[1]); w[bj].w = cvt_pk_bf16(v1[2], v1[3]); }
                    u32x4 r1, r2; widen(w[0], w[1], r1, r2);
                    *(GAS u32x4*)(rb + lo) = r1; *(GAS u32x4*)(rb + lo + 8 * D * 2) = r2; }
        } else {
            GAS char* ub = (GAS char*)Uo + ((size_t)u.pm * BM * D + (size_t)(u.pn - 8) * HALF) * 2;
            const unsigned lo = (unsigned)((wr * 64 + fr) * D + wc * 32 + 8 * fq) * 2u;
#pragma unroll
            for (int ai = 0; ai < 2; ++ai)
#pragma unroll
                for (int m = 0; m < 4; ++m) { GAS char* rb = ub + (size_t)(ai * HALF + m * 16) * D * 2;
                    const f32x4 v0 = acc[ai][0][m][0] * acc[ai][1][m][0], v1 = acc[ai][0][m][1] * acc[ai][1][m][1];
                    u32x4 w; w.x = cvt_pk_bf16(v0[0], v0[1]); w.y = cvt_pk_bf16(v0[2], v0[3]); w.z = cvt_pk_bf16(v1[0], v1[1]); w.w = cvt_pk_bf16(v1[2], v1[3]);
                    *(GAS u32x4*)(rb + lo) = w; }
        }
    }
};

template <class Desc, class Epi, bool ALIGN_EPI, bool SP2>
__device__ __forceinline__ void gemm_phase(LAS unsigned char* lds, const Desc g, const StaticOrder& S, const Epi& E, unsigned long long& pacc) {
    int tid_ = threadIdx.x; asm volatile("" : "+v"(tid_));
    const int tid = tid_, wid = __builtin_amdgcn_readfirstlane(tid >> 6), lane = tid & 63, wr = wid >> 2, wc = wid & 3, fr = lane & 15, fq = lane >> 4;
    const int K = g.K, nt = K / BK, lda = g.lda, ldb = g.ldb;
    unsigned voffA[2], voffB[2];
#pragma unroll
    for (int i = 0; i < 2; ++i) { int R, C; stage_rc(tid * 16 + i * 8192, R, C); const int Rb = 2 * (R & ~31) + perm32(R & 31);
        voffA[i] = g.voffa(R, C); voffB[i] = g.voffb(Rb, C); }
    const size_t kstep = g.kstepa(), kstepB = g.kstepb();
    const size_t hstepA = g.hstepa(), hstepB = (size_t)32 * ldb * 2;
    const unsigned ldsw = (unsigned)wid * 1024u;
    const int aoff = lds_byte(wr * 64 + fr, fq * 8), boff = lds_byte(wc * 32 + fr, fq * 8);
#define PG8_SA(b, h) (((b) * 2 + (h)) * HTB)
#define PG8_SB(b, h) ((4 + (b) * 2 + (h)) * HTB)
#define PG8_STAGE(bufoff, gbase, voff) do { _Pragma("unroll") for (int _i = 0; _i < 2; ++_i) { unsigned _vo = (voff)[_i]; asm("" : "+v"(_vo));     \
        __builtin_amdgcn_global_load_lds((const GAS unsigned*)((const GAS char*)(gbase) + _vo), (LAS unsigned*)(lds + (bufoff) + ldsw + _i * 8192), 16, 0, 0); } } while (0)
#define PG8_LDA(dst, b, h) do { _Pragma("unroll") for (int m = 0; m < 4; ++m) _Pragma("unroll") for (int k = 0; k < 2; ++k) dst[m][k] = *(const LAS bf16x8*)(lds + PG8_SA(b, h) + aoff + m * 2048 + k * 1024); } while (0)
#define PG8_LDB(dst, b, h) do { _Pragma("unroll") for (int n = 0; n < 2; ++n) _Pragma("unroll") for (int k = 0; k < 2; ++k) dst[n][k] = *(const LAS bf16x8*)(lds + PG8_SB(b, h) + boff + n * 2048 + k * 1024); } while (0)
#define PG8_MMA(ai, bj, At, Bt) do { __builtin_amdgcn_s_setprio(1); _Pragma("unroll") for (int p = 0; p < 8; ++p) _Pragma("unroll") for (int q = 0; q < 2; ++q) { const int n = p >> 2, m = (n ? 3 - (p & 3) : (p & 3)), k = (p ^ q) & 1; \
        asm volatile("v_mfma_f32_16x16x32_bf16 %0, %1, %2, %0" : "+v"(acc[ai][bj][m][n]) : "v"(Bt[n][k]), "v"(At[m][k])); }     __builtin_amdgcn_s_setprio(0); } while (0)
#define PG8_WAIT_V(n) asm volatile("s_waitcnt vmcnt(" #n ")" ::: "memory")
#define PG8_WAIT_L(n) asm volatile("s_waitcnt lgkmcnt(" #n ")" ::: "memory")
#define PG8_BAR __builtin_amdgcn_s_barrier()
#define PG8_SCHED __builtin_amdgcn_sched_barrier(0)
    Unit cur, nxt; int ui = 0;
    if (!S.next(0, cur)) return;
    f32x4 acc[2][2][4][2];
#pragma unroll
    for (int a = 0; a < 2; ++a)
#pragma unroll
        for (int b = 0; b < 2; ++b)
#pragma unroll
            for (int m = 0; m < 4; ++m)
#pragma unroll
                for (int n = 0; n < 2; ++n) acc[a][b][m][n] = (f32x4){0.f, 0.f, 0.f, 0.f};
    bf16x8 At[4][2], B0[2][2], B1[2][2];
    const char* cA = g.abase(cur); const char* cB = g.bbase(cur);
    if constexpr (SP2) {
        PG8_STAGE(PG8_SB(0, 0), cB, voffB); PG8_STAGE(PG8_SB(0, 1), cB + hstepB, voffB); PG8_STAGE(PG8_SA(0, 0), cA, voffA); PG8_STAGE(PG8_SA(0, 1), cA + hstepA, voffA);
        if (wr == 1) PG8_BAR;
        PG8_WAIT_V(2); PG8_BAR;
        PG8_STAGE(PG8_SB(1, 0), cB + kstepB, voffB); PG8_STAGE(PG8_SA(1, 0), cA + kstep, voffA); PG8_STAGE(PG8_SB(1, 1), cB + hstepB + kstepB, voffB);
        PG8_WAIT_V(6); PG8_BAR;
    } else {
        PG8_STAGE(PG8_SB(0, 0), cB, voffB); PG8_STAGE(PG8_SA(0, 0), cA, voffA); PG8_STAGE(PG8_SB(0, 1), cB + hstepB, voffB); PG8_STAGE(PG8_SA(0, 1), cA + hstepA, voffA);
        if (wr == 1) PG8_BAR;
        PG8_WAIT_V(4); PG8_BAR;
        PG8_STAGE(PG8_SB(1, 0), cB + kstepB, voffB); PG8_STAGE(PG8_SA(1, 0), cA + kstep, voffA); PG8_STAGE(PG8_SB(1, 1), cB + hstepB + kstepB, voffB);
        PG8_WAIT_V(6); PG8_BAR;
    }
    for (;;) {
        const bool has_next = S.next(ui + 1, nxt);
        const char* nA = has_next ? g.abase(nxt) : cA; const char* nB = has_next ? g.bbase(nxt) : cB;
#pragma unroll 1
        for (int t = 0; t < nt; t += 2) {
            const bool last = (t == nt - 2);
            unsigned long long pk0 = 0ull; if (PROBE_CAT == 4 || PROBE_CAT == 5) pk0 = __builtin_amdgcn_s_memrealtime();
            const char* a1 = cA + (size_t)(t + 1) * kstep;
            const char* a2 = last ? nA : cA + (size_t)(t + 2) * kstep; const char* b2 = last ? nB : cB + (size_t)(t + 2) * kstepB;
            const char* a3 = a2 + kstep; const char* b3 = b2 + kstepB;
            if constexpr (SP2) {
            PG8_LDB(B0, 0, 0); PG8_LDB(B1, 0, 1); PG8_SCHED; PG8_LDA(At, 0, 0); PG8_STAGE(PG8_SA(1, 1), a1 + hstepA, voffA);
            PG8_WAIT_V(8); PG8_WAIT_L(0); PG8_BAR; PG8_MMA(0, 0, At, B0); PG8_MMA(0, 1, At, B1); PG8_BAR; PG8_SCHED;
            PG8_LDA(At, 0, 1); PG8_STAGE(PG8_SB(0, 0), b2, voffB); PG8_STAGE(PG8_SB(0, 1), b2 + hstepB, voffB); PG8_STAGE(PG8_SA(0, 0), a2, voffA);
            PG8_WAIT_V(8); PG8_WAIT_L(0); PG8_BAR; PG8_MMA(1, 0, At, B0); PG8_MMA(1, 1, At, B1); PG8_BAR; PG8_SCHED;
            PG8_LDB(B0, 1, 0); PG8_LDB(B1, 1, 1); PG8_SCHED; PG8_LDA(At, 1, 0); PG8_STAGE(PG8_SA(0, 1), a2 + hstepA, voffA);
            PG8_WAIT_V(8); PG8_WAIT_L(0); PG8_BAR; PG8_MMA(0, 0, At, B0); PG8_MMA(0, 1, At, B1); PG8_BAR; PG8_SCHED;
            PG8_LDA(At, 1, 1); PG8_STAGE(PG8_SB(1, 0), b3, voffB); PG8_STAGE(PG8_SB(1, 1), b3 + hstepB, voffB); PG8_STAGE(PG8_SA(1, 0), a3, voffA);
            PG8_WAIT_V(8); PG8_WAIT_L(0); PG8_BAR; PG8_MMA(1, 0, At, B0); PG8_MMA(1, 1, At, B1); PG8_BAR; PG8_SCHED;
            } else {
            PG8_LDB(B0, 0, 0); PG8_SCHED; PG8_LDA(At, 0, 0); PG8_STAGE(PG8_SA(1, 1), a1 + hstepA, voffA);
            PG8_WAIT_L(8); PG8_BAR; PG8_WAIT_L(0); PG8_MMA(0, 0, At, B0); PG8_BAR; PG8_SCHED;
            PG8_LDB(B1, 0, 1); PG8_STAGE(PG8_SB(0, 0), b2, voffB);
            PG8_BAR; PG8_WAIT_L(0); PG8_MMA(0, 1, At, B1); PG8_BAR;
            PG8_LDA(At, 0, 1); PG8_STAGE(PG8_SA(0, 0), a2, voffA);
            PG8_BAR; PG8_WAIT_L(0); PG8_MMA(1, 0, At, B0); PG8_BAR; PG8_SCHED;
            PG8_STAGE(PG8_SB(0, 1), b2 + hstepB, voffB);
            PG8_WAIT_V(6); PG8_BAR; PG8_MMA(1, 1, At, B1); PG8_BAR;
            PG8_LDB(B0, 1, 0); PG8_SCHED; PG8_LDA(At, 1, 0); PG8_STAGE(PG8_SA(0, 1), a2 + hstepA, voffA);
            PG8_WAIT_L(8); PG8_BAR; PG8_WAIT_L(0); PG8_MMA(0, 0, At, B0); PG8_BAR; PG8_SCHED;
            PG8_LDB(B1, 1, 1); PG8_STAGE(PG8_SB(1, 0), b3, voffB);
            PG8_BAR; PG8_WAIT_L(0); PG8_MMA(0, 1, At, B1); PG8_BAR;
            PG8_LDA(At, 1, 1); PG8_STAGE(PG8_SA(1, 0), a3, voffA);
            PG8_BAR; PG8_WAIT_L(0); PG8_MMA(1, 0, At, B0); PG8_BAR; PG8_SCHED;
            PG8_STAGE(PG8_SB(1, 1), b3 + hstepB, voffB);
            PG8_WAIT_V(6); PG8_BAR; PG8_MMA(1, 1, At, B1); PG8_BAR;
            }
            if (PROBE_CAT == 4 && t == 0 && ui > 0) pacc += __builtin_amdgcn_s_memrealtime() - pk0;
            if (PROBE_CAT == 5 && t == 2) pacc += __builtin_amdgcn_s_memrealtime() - pk0;
        }
        if constexpr (ALIGN_EPI) { if (wr == 0) PG8_BAR; }
        asm volatile("s_nop 15\n\ts_nop 15" ::: "memory");
        E(acc, cur, wr, wc, fr, fq);
        if (!has_next) break;
#pragma unroll
        for (int a = 0; a < 2; ++a)
#pragma unroll
            for (int b = 0; b < 2; ++b)
#pragma unroll
                for (int m = 0; m < 4; ++m)
#pragma unroll
                    for (int n = 0; n < 2; ++n) acc[a][b][m][n] = (f32x4){0.f, 0.f, 0.f, 0.f};
        cur = nxt; cA = nA; cB = nB; ++ui;
        if constexpr (ALIGN_EPI) { if (wr == 1) PG8_BAR; }
    }
    PG8_WAIT_V(0);
    if constexpr (!ALIGN_EPI) { if (wr == 0) PG8_BAR; }
    PG8_BAR;
#undef PG8_SA
#undef PG8_SB
#undef PG8_STAGE
#undef PG8_LDA
#undef PG8_LDB
#undef PG8_MMA
#undef PG8_WAIT_V
#undef PG8_WAIT_L
#undef PG8_BAR
#undef PG8_SCHED
}
}

#define XB_TMO      128
#define XB_XCNT(j)  (256  + 64 * (j))
#define XB_XSUB(j)  (1280 + 64 * (j))
#define XB_XGEN(j)  (2304 + 64 * (j))
#define XB_TOP      3328
#define XB_TOPGEN   3392
#define XCD_BAR_WORDS 3456
#define XB_SPIN_CAP (1u << 18)
__device__ __forceinline__ unsigned xb_ld(unsigned* p)              { return __hip_atomic_load(p, __ATOMIC_RELAXED, __HIP_MEMORY_SCOPE_AGENT); }
__device__ __forceinline__ unsigned xb_add(unsigned* p, unsigned v) { return __hip_atomic_fetch_add(p, v, __ATOMIC_RELAXED, __HIP_MEMORY_SCOPE_AGENT); }
__device__ __forceinline__ unsigned xb_xcc_id() { return (unsigned)__builtin_amdgcn_s_getreg((3 << 11) | 20) & 0xFu; }
#define XB_SPIN(cond, bar) do { unsigned _sp = 0; while (cond) { __builtin_amdgcn_s_sleep(1); \
    if ((++_sp & 255u) == 0u) { if (xb_ld(&(bar)[XB_TMO])) break; if (_sp > XB_SPIN_CAP) { atomicAdd(&(bar)[XB_TMO], 1u); break; } } } } while (0)
struct XcdBarrier { unsigned* bar; unsigned x; volatile LAS unsigned* st; };
__device__ __forceinline__ XcdBarrier xcd_barrier_post(unsigned* bar, volatile LAS unsigned* st) {
    XcdBarrier b; b.bar = bar; b.x = (unsigned)__builtin_amdgcn_readfirstlane((int)xb_xcc_id()); b.st = st;
    if (threadIdx.x == 0) (void)xb_add(&bar[XB_XCNT(b.x)], 1u);
    return b;
}
__device__ __forceinline__ void xcd_barrier_complete(unsigned* bar, unsigned x, unsigned& nloc, unsigned& nx) {
    const unsigned G = gridDim.x * gridDim.y * gridDim.z;
    unsigned sum, cnt, mine, sp = 0u;
    for (;;) {
        sum = 0u; cnt = 0u; mine = 0u;
#pragma unroll
        for (unsigned j = 0; j < 16; ++j) { const unsigned c = xb_ld(&bar[XB_XCNT(j)]); sum += c; cnt += (c > 0u) ? 1u : 0u; mine = (j == x) ? c : mine; }
        if (sum == G) break;
        __builtin_amdgcn_s_sleep(1);
        if ((++sp & 255u) == 0u) { if (xb_ld(&bar[XB_TMO])) break; if (sp > XB_SPIN_CAP) { atomicAdd(&bar[XB_TMO], 1u); break; } }
    }
    nloc = mine > 0u ? mine : 1u; nx = cnt > 0u ? cnt : 1u;
}
__device__ __forceinline__ void xcd_barrier(const XcdBarrier& b) {
    asm volatile("s_waitcnt vmcnt(0)" ::: "memory");
    __syncthreads();
    if (threadIdx.x == 0) {
        unsigned* bar = b.bar; unsigned bx_ = b.x; asm volatile("" : "+s"(bx_));
        __builtin_amdgcn_s_waitcnt(0);
        unsigned nloc = b.st[0], nx = b.st[1];
        if (nloc == 0u) { xcd_barrier_complete(bar, bx_, nloc, nx); b.st[0] = nloc; b.st[1] = nx; }
        const unsigned old = xb_add(&bar[XB_XSUB(bx_)], 1u);
        const unsigned gen = old / nloc;
        if (old + 1u == (gen + 1u) * nloc) {
            __builtin_amdgcn_fence(__ATOMIC_RELEASE, "agent");
            asm volatile("s_waitcnt vmcnt(0)" ::: "memory");
            const unsigned og = xb_add(&bar[XB_TOP], 1u);
            const unsigned tg = og / nx;
            if (og + 1u == (tg + 1u) * nx) xb_add(&bar[XB_TOPGEN], 1u);
            else XB_SPIN(xb_ld(&bar[XB_TOPGEN]) == tg, bar);
            __builtin_amdgcn_fence(__ATOMIC_ACQUIRE, "agent");
            xb_add(&bar[XB_XGEN(bx_)], 1u);
            asm volatile("s_waitcnt vmcnt(0)" ::: "memory");
        } else {
            XB_SPIN(xb_ld(&bar[XB_XGEN(bx_)]) == gen, bar);
            __builtin_amdgcn_fence(__ATOMIC_ACQUIRE, "agent");
            asm volatile("s_waitcnt vmcnt(0)" ::: "memory");
        }
    }
    __syncthreads();
}

__device__ __forceinline__ float wave_sum(float v) {
#pragma unroll
    for (int o = 1; o < 64; o <<= 1) v += __shfl_xor(v, o);
    return v;
}
__device__ __forceinline__ void transpose_item(const float* W, int K, int N, bf16_t* WT, int k0, int n0, int drow0, const float* gain, LAS float* scr, int lane) {
    float tv[32];
#pragma unroll
    for (int i = 0; i < 32; ++i) tv[i] = ((const GAS float*)W)[(size_t)(k0 + 2 * i + (lane >> 5)) * N + n0 + (lane & 31)];
#pragma unroll
    for (int i = 0; i < 32; ++i) { const int kk = 2 * i + (lane >> 5); float v = tv[i]; if (gain) v *= ((const GAS float*)gain)[k0 + kk]; scr[kk * 33 + (lane & 31)] = v; }
    LDS_WAIT(); asm volatile("" ::: "memory");
    const int c = lane & 7;
#pragma unroll
    for (int j = 0; j < 4; ++j) { const int n = (lane >> 3) + 8 * j; const LAS float* s = scr + (8 * c) * 33 + n;
        u32x4 o; o.x = cvt_pk_bf16(s[0 * 33], s[1 * 33]); o.y = cvt_pk_bf16(s[2 * 33], s[3 * 33]); o.z = cvt_pk_bf16(s[4 * 33], s[5 * 33]); o.w = cvt_pk_bf16(s[6 * 33], s[7 * 33]);
        *(GAS u32x4*)(WT + pg8::paired_off(drow0 + n, k0 + 8 * c, K)) = o; }
    LDS_WAIT(); asm volatile("" ::: "memory");
}
__device__ __forceinline__ int win_row(int n) {
    if (n < D) return n;
    const int which = (n >= 2 * D) ? 1 : 0, cc = n - D - which * D;
    return D + (cc >> 5) * 64 + which * 32 + (cc & 31);
}
__device__ __forceinline__ float cas_pi(float t) { float s, c; sincospif(t, &s, &c); return c + s; }

__device__ __forceinline__ unsigned char* wsp(unsigned char* ws, size_t off) { asm volatile("" : "+s"(ws)); return ws + off; }

struct Ptrs {
    const float *x_prompt, *x_sample, *norm_mix, *a_w_in, *a_conv_w, *a_w_out, *f_w_out, *norm_ffn, *w_up, *w_down, *final_norm;
    float* out; unsigned char* ws;
};

__device__ __forceinline__ void prologue(const Ptrs& P, LAS unsigned char* lds, int gw, int NGW, int wave, int lane_) {
    int lane = lane_; asm volatile("" : "+v"(lane));
    LAS float* scr = (LAS float*)(lds + wave * 16384);
    bf16_t* WIN = (bf16_t*)(P.ws + WS_WIN); bf16_t* AWO = (bf16_t*)(P.ws + WS_AWO); bf16_t* FWO = (bf16_t*)(P.ws + WS_FWO);
    bf16_t* WUP = (bf16_t*)(P.ws + WS_WUP); bf16_t* WDN = (bf16_t*)(P.ws + WS_WDN);
    constexpr int I_IN = (D / 64) * (3 * D / 32), I_SQ = (D / 64) * (D / 32), I_UP = (D / 64) * (DFF / 32), I_DN = (DFF / 64) * (D / 32);
    constexpr int NITEMS = 2 * I_IN + 4 * I_SQ + 4 * I_UP + 4 * I_DN;
    for (int it = gw; it < NITEMS; it += NGW) {
        int r = it;
        if (r < 2 * I_IN) { const int j = r / I_IN; r -= j * I_IN; const int nblk = 3 * D / 32, kb = r / nblk, nb = r % nblk;
            transpose_item(P.a_w_in + (size_t)j * D * 3 * D, D, 3 * D, WIN + (size_t)j * 3 * D * D, 64 * kb, 32 * nb, win_row(32 * nb), P.norm_mix + (2 * j) * D, scr, lane); continue; }
        r -= 2 * I_IN;
        if (r < 2 * I_SQ) { const int j = r / I_SQ; r -= j * I_SQ; const int nblk = D / 32, kb = r / nblk, nb = r % nblk;
            transpose_item(P.a_w_out + (size_t)j * D * D, D, D, AWO + (size_t)j * D * D, 64 * kb, 32 * nb, 32 * nb, nullptr, scr, lane); continue; }
        r -= 2 * I_SQ;
        if (r < 2 * I_SQ) { const int j = r / I_SQ; r -= j * I_SQ; const int nblk = D / 32, kb = r / nblk, nb = r % nblk;
            transpose_item(P.f_w_out + (size_t)j * D * D, D, D, FWO + (size_t)j * D * D, 64 * kb, 32 * nb, 32 * nb, nullptr, scr, lane); continue; }
        r -= 2 * I_SQ;
        if (r < 4 * I_UP) { const int j = r / I_UP; r -= j * I_UP; const int nblk = DFF / 32, kb = r / nblk, nb = r % nblk;
            transpose_item(P.w_up + (size_t)j * D * DFF, D, DFF, WUP + (size_t)j * D * DFF, 64 * kb, 32 * nb, 32 * nb, P.norm_ffn + j * D, scr, lane); continue; }
        r -= 4 * I_UP;
        { const int j = r / I_DN; r -= j * I_DN; const int nblk = D / 32, kb = r / nblk, nb = r % nblk;
            transpose_item(P.w_down + (size_t)j * D * DFF, DFF, D, WDN + (size_t)j * D * DFF, 64 * kb, 32 * nb, 32 * nb, nullptr, scr, lane); }
    }
    const int gl = gw * 64 + lane, NGL = NGW * 64;
    for (int i = gl; i < 2 * NGRP * CG * CG / 8; i += NGL) { const int jl = i / (NGRP * CG * CG / 8), r = i % (NGRP * CG * CG / 8), g = r / (CG * CG / 8), q = r % (CG * CG / 8), c = q / (CG / 8), j0 = (q % (CG / 8)) * 8; float v[8];
        const GAS float* gn = (const GAS float*)P.norm_mix + (2 * jl + 1) * D + g * CG + j0;
#pragma unroll
        for (int e = 0; e < 8; ++e) v[e] = cas_pi(-(float)((c * (j0 + e)) & (CG - 1)) * (1.0f / 128.0f)) * gn[e];
        u32x4 o; o.x = cvt_pk_bf16(v[0], v[1]); o.y = cvt_pk_bf16(v[2], v[3]); o.z = cvt_pk_bf16(v[4], v[5]); o.w = cvt_pk_bf16(v[6], v[7]);
        *(GAS u32x4*)((bf16_t*)(P.ws + WS_PT) + (size_t)i * 8) = o; }
    for (int i = gl; i < SP * RAD; i += NGL) { const int k = i >> 3, s2 = i & 7; float s, c; sincospif((float)((k * s2) & (SP - 1)) * (1.0f / 8192.0f), &s, &c);
        ((GAS f32x2*)(P.ws + WS_TW))[i] = (f32x2){c, s}; }
    for (int i = gl; i < CG * CG / 8; i += NGL) { const int k = i / (CG / 8), s0 = (i % (CG / 8)) * 8; float v[8];
#pragma unroll
        for (int e = 0; e < 8; ++e) v[e] = cas_pi((float)((k * (s0 + e)) & (CG - 1)) * (1.0f / 128.0f));
        u32x4 o; o.x = cvt_pk_bf16(v[0], v[1]); o.y = cvt_pk_bf16(v[2], v[3]); o.z = cvt_pk_bf16(v[4], v[5]); o.w = cvt_pk_bf16(v[6], v[7]);
        *(GAS u32x4*)((bf16_t*)(P.ws + WS_H256) + (size_t)k * CG + s0) = o; }
    for (int i = gl; i < SS * RAD; i += NGL) { const int k = i >> 3, s2 = i & 7; float s, c; sincospif((float)((k * s2) & (SS - 1)) * (1.0f / 1024.0f), &s, &c);
        ((GAS f32x2*)(P.ws + WS_TW + 1 * MiB))[i] = (f32x2){c, s}; }
    for (int q = gw; q < M / 2; q += NGW) {
        const int m = (q >> 3) * 16 + (q & 7), hh = (lane >> 2) & 1, mr = m + 8 * hh;
        const GAS f32x4* xr = (const GAS f32x4*)(mr < MP ? P.x_prompt + (size_t)mr * D : P.x_sample + (size_t)(mr - MP) * D) + (lane >> 3) * 8 + (lane & 3) * 2;
        f32x4 v[8][2]; float s = 0.f;
#pragma unroll
        for (int j = 0; j < 8; ++j) { v[j][0] = xr[64 * j]; v[j][1] = xr[64 * j + 1]; }
        GAS u32x4* o16 = (GAS u32x4*)((bf16_t*)(P.ws + WS_B1) + pg8::paired_off(m, 0, D)) + lane;
#pragma unroll
        for (int j = 0; j < 8; ++j) { u32x4 w; w[0] = cvt_pk_bf16(v[j][0].x, v[j][0].y); w[1] = cvt_pk_bf16(v[j][0].z, v[j][0].w); w[2] = cvt_pk_bf16(v[j][1].x, v[j][1].y); w[3] = cvt_pk_bf16(v[j][1].z, v[j][1].w); o16[64 * j] = w;
#pragma unroll
            for (int e = 0; e < 4; ++e) { const float y0 = bf_lo(w[e]), y1 = bf_hi(w[e]); s += y0 * y0 + y1 * y1; } }
        s += __shfl_xor(s, 1); s += __shfl_xor(s, 2); s += __shfl_xor(s, 8); s += __shfl_xor(s, 16); s += __shfl_xor(s, 32);
        if ((lane & ~4) == 0) ((GAS u64*)(P.ws + WS_RS))[mr] = pg8::rs_fix(s);
    }
}

__device__ __forceinline__ void final_norm_phase(const bf16_t* xs, float* out, const u64* RS, const float* gain, int gw, int NGW, int lane_) {
    int lane = lane_; asm volatile("" : "+v"(lane));
    const int col4 = (lane >> 3) * 8 + (lane & 3) * 2, hh = (lane >> 2) & 1;
    f32x4 gv[8][2];
#pragma unroll
    for (int j = 0; j < 8; ++j) { gv[j][0] = ((const GAS f32x4*)gain)[col4 + 64 * j]; gv[j][1] = ((const GAS f32x4*)gain)[col4 + 64 * j + 1]; }
    for (int q = gw; q < M / 2; q += NGW) {
        const int m = (q >> 3) * 16 + (q & 7), mr = m + 8 * hh;
        const GAS u32x4* xr = (const GAS u32x4*)(xs + pg8::paired_off(m, 0, D)) + lane;
        GAS f32x4* orow = (GAS f32x4*)(out + (size_t)mr * D) + col4;
        const float rstd = pg8::row_rstd(RS + mr);
        u32x4 v[8];
#pragma unroll
        for (int j = 0; j < 8; ++j) v[j] = xr[64 * j];
#pragma unroll
        for (int j = 0; j < 8; ++j) { f32x4 y0, y1; y0.x = bf_lo(v[j][0]); y0.y = bf_hi(v[j][0]); y0.z = bf_lo(v[j][1]); y0.w = bf_hi(v[j][1]); y1.x = bf_lo(v[j][2]); y1.y = bf_hi(v[j][2]); y1.z = bf_lo(v[j][3]); y1.w = bf_hi(v[j][3]);
            orow[64 * j] = y0 * rstd * gv[j][0]; orow[64 * j + 1] = y1 * rstd * gv[j][1]; }
    }
}
__device__ __forceinline__ void conv_phase(const bf16_t* Bb, const bf16_t* Ub, const float* cw, const u64* RS, bf16_t* Gb, int gw, int NGW, int lane_) {
    int lane = lane_; asm volatile("" : "+v"(lane));
    for (int chunk = gw; chunk < M / 8; chunk += NGW) {
        const int m0 = chunk * 8;
        const bool first = (m0 == 0) || (m0 >= MP && ((m0 - MP) & (SS - 1)) == 0);
        const bool last = (m0 + 8 == MP) || (m0 >= MP && ((m0 + 8 - MP) & (SS - 1)) == 0);
        float rr[10];
#pragma unroll
        for (int q = 0; q < 10; ++q) { const bool ok = !((q == 0 && first) || (q == 9 && last)); rr[q] = ok ? pg8::row_rstd(RS + (m0 - 1 + q)) : 0.f; }
#pragma unroll 1
        for (int j = 0; j < 4; ++j) {
            const int ch0 = (lane + 64 * j) * 8;
            float w0[8], w1[8], w2[8];
#pragma unroll
            for (int h = 0; h < 2; ++h) { const f32x4 a = *(const GAS f32x4*)(cw + ch0 + 4 * h), b = *(const GAS f32x4*)(cw + D + ch0 + 4 * h), c = *(const GAS f32x4*)(cw + 2 * D + ch0 + 4 * h);
#pragma unroll
                for (int e = 0; e < 4; ++e) { w0[4 * h + e] = a[e]; w1[4 * h + e] = b[e]; w2[4 * h + e] = c[e]; } }
            const GAS u32x4* up = (const GAS u32x4*)(Ub + (size_t)m0 * D + ch0);
            const GAS u32x4* bp = (const GAS u32x4*)(Bb + (size_t)m0 * D + ch0);
            GAS u32x4* gp = (GAS u32x4*)(Gb + (size_t)m0 * D + ch0);
            u32x4 uu[10], bb[8];
#pragma unroll
            for (int q = 0; q < 10; ++q) { const bool ok = !((q == 0 && first) || (q == 9 && last)); uu[q] = (u32x4){0u, 0u, 0u, 0u}; if (ok) uu[q] = *(up + (ptrdiff_t)(q - 1) * (D / 8)); }
#pragma unroll
            for (int r = 0; r < 8; ++r) bb[r] = bp[(size_t)r * (D / 8)];
#pragma unroll
            for (int r = 0; r < 8; ++r) {
                const float rp = rr[r] * rr[r], rc = rr[r + 1] * rr[r + 1], rn = rr[r + 2] * rr[r + 2], rb = rr[r + 1];
                float o[8];
#pragma unroll
                for (int e = 0; e < 8; ++e) o[e] = rb * bf_at(bb[r], e) * (w0[e] * rp * bf_at(uu[r], e) + w1[e] * rc * bf_at(uu[r + 1], e) + w2[e] * rn * bf_at(uu[r + 2], e));
                u32x4 w; w.x = cvt_pk_bf16(o[0], o[1]); w.y = cvt_pk_bf16(o[2], o[3]); w.z = cvt_pk_bf16(o[4], o[5]); w.w = cvt_pk_bf16(o[6], o[7]);
                gp[(size_t)r * (D / 8)] = w;
            }
        }
    }
}
__device__ __forceinline__ void load_rev(const GAS bf16_t* rowp, int g0, int c0, float (&r)[8]) {
    const u32x4 A = *(const GAS u32x4*)(rowp + g0 + ((248 - c0) & 255)), Bv = *(const GAS u32x4*)(rowp + g0 + ((256 - c0) & 255));
    r[0] = bf_at(Bv, 0);
#pragma unroll
    for (int i = 1; i < 8; ++i) r[i] = bf_at(A, 8 - i);
}
__device__ __forceinline__ void post_phase(int mode, const bf16_t* UP, const bf16_t* US, const f32x2* TWP, const f32x2* TWS, bf16_t* MXP, bf16_t* MXS, const bf16_t* HP256, bf16_t* H2048, int gw, int NGW, int lane_) {
    int lane = lane_; asm volatile("" : "+v"(lane));
    const float SC_S = 0.5f / sqrtf((float)SS * (float)CG), SC_P = 0.5f / sqrtf((float)SP * (float)CG);
    for (int it = gw + (mode == 1 ? SS : 0); it < (mode == 1 ? SS + NB * CG : SS); it += NGW) {
        const bool pr = it < SS;
        const int L = pr ? SS : CG, b = pr ? 0 : (it - SS) >> 8, k1 = pr ? it : (it - SS) & (CG - 1), nk1 = (L - k1) & (L - 1);
        const GAS bf16_t* H = pr ? (const GAS bf16_t*)UP : (const GAS bf16_t*)US + (size_t)b * SS * D;
        GAS bf16_t* O = pr ? (GAS bf16_t*)MXP : (GAS bf16_t*)MXS + (size_t)(MP + b * SS) * D;
        const f32x2* TW = pr ? TWP : TWS; const float sc = pr ? SC_P : SC_S;
        f32x2 st[4];
#pragma unroll
        for (int k2 = 0; k2 < 4; ++k2) st[k2] = TW[(size_t)(k1 + L * k2) * RAD + 1];
#pragma unroll 1
        for (int j = 0; j < 4; ++j) { const int ch0 = (lane + 64 * j) * 8, g0 = ch0 & ~255, c0 = ch0 & 255;
            const int ra = g0 + ((248 - c0) & 255), rb = g0 + ((256 - c0) & 255);
            f32x2 acc[8][4], cw[4];
#pragma unroll
            for (int a = 0; a < 8; ++a) { if (a < 4) cw[a] = (f32x2){1.f, 0.f};
#pragma unroll
                for (int e = 0; e < 4; ++e) acc[a][e] = (f32x2){0.f, 0.f}; }
            const int lsa = ((lane & 32) + (31 - (lane & 31))) * 4, lsb = ((lane & 32) + ((32 - (lane & 31)) & 31)) * 4;
            {
            u32x4 va[8], vp[8];
#pragma unroll
            for (int s2 = 0; s2 < 8; ++s2) {
                va[s2] = *(const GAS u32x4*)(H + ((size_t)s2 * L + k1) * D + ch0); vp[s2] = *(const GAS u32x4*)(H + ((size_t)s2 * L + nk1) * D + ch0); }
#pragma unroll
            for (int s2 = 0; s2 < 8; ++s2) {
                __builtin_amdgcn_sched_barrier(0);
                u32x4 nA, kA; unsigned nB0, kB0;
#pragma unroll
                for (int d = 0; d < 4; ++d) { nA[d] = (unsigned)__builtin_amdgcn_ds_bpermute(lsa, (int)vp[s2][d]); kA[d] = (unsigned)__builtin_amdgcn_ds_bpermute(lsa, (int)va[s2][d]); }
                nB0 = (unsigned)__builtin_amdgcn_ds_bpermute(lsb, (int)vp[s2][0]); kB0 = (unsigned)__builtin_amdgcn_ds_bpermute(lsb, (int)va[s2][0]);
                float Ev[8], Ov[8];
                Ev[0] = bf_at(va[s2], 0) + bf_lo(nB0); Ov[0] = bf_at(vp[s2], 0) - bf_lo(kB0);
#pragma unroll
                for (int e = 1; e < 8; ++e) { Ev[e] = bf_at(va[s2], e) + bf_at(nA, 8 - e); Ov[e] = bf_at(vp[s2], e) - bf_at(kA, 8 - e); }
#pragma unroll
                for (int k2 = 0; k2 < 4; ++k2) { const f32x2 cc = (f32x2){cw[k2].x, cw[k2].x}, ss = (f32x2){cw[k2].y, cw[k2].y};
#pragma unroll
                    for (int e = 0; e < 4; ++e) { acc[4 * (s2 & 1) + k2][e] = __builtin_elementwise_fma((f32x2){Ev[2 * e], Ev[2 * e + 1]}, cc, acc[4 * (s2 & 1) + k2][e]);
                                                  acc[4 * (s2 & 1) + k2][e] = __builtin_elementwise_fma((f32x2){Ov[2 * e], Ov[2 * e + 1]}, ss, acc[4 * (s2 & 1) + k2][e]); }
                    const float nc = cw[k2].x * st[k2].x - cw[k2].y * st[k2].y, ns = cw[k2].y * st[k2].x + cw[k2].x * st[k2].y; cw[k2] = (f32x2){nc, ns}; }
            }
            }
#pragma unroll
            for (int k2 = 0; k2 < 8; ++k2) { u32x4 w; f32x2 o[4];
#pragma unroll
                for (int e = 0; e < 4; ++e) o[e] = (k2 < 4 ? acc[k2][e] + acc[4 + k2][e] : acc[k2 - 4][e] - acc[k2][e]) * sc;
                w.x = cvt_pk_bf16(o[0].x, o[0].y); w.y = cvt_pk_bf16(o[1].x, o[1].y);
                w.z = cvt_pk_bf16(o[2].x, o[2].y); w.w = cvt_pk_bf16(o[3].x, o[3].y);
                *(GAS u32x4*)(O + (size_t)(k1 + L * k2) * D + ch0) = w; }
        }
    }
    if (mode == 1) {
        for (int it = gw; it < RAD * CG; it += NGW) {
            const int t = it >> 8, k1 = it & (CG - 1), nk1 = (CG - k1) & (CG - 1);
            f32x2 st[4];
#pragma unroll
            for (int k2 = 0; k2 < 4; ++k2) st[k2] = TWS[(size_t)(k1 + CG * k2) * RAD + 1];
#pragma unroll 1
            for (int j = 0; j < 4; ++j) { const int ch0 = (lane + 64 * j) * 8;
                f32x2 acc[8][4], cw[4];
#pragma unroll
                for (int a = 0; a < 8; ++a) { if (a < 4) cw[a] = (f32x2){1.f, 0.f};
#pragma unroll
                    for (int e = 0; e < 4; ++e) acc[a][e] = (f32x2){0.f, 0.f}; }
                {
                    u32x4 va[8], vp[8];
#pragma unroll
                    for (int q = 0; q < 8; ++q) { const int s2 = t + 8 * q;
                        va[q] = *(const GAS u32x4*)((const GAS bf16_t*)HP256 + ((size_t)s2 * CG + k1) * D + ch0);
                        vp[q] = *(const GAS u32x4*)((const GAS bf16_t*)HP256 + ((size_t)s2 * CG + nk1) * D + ch0); }
#pragma unroll
                    for (int q = 0; q < 8; ++q) {
#pragma unroll
                        for (int k2 = 0; k2 < 4; ++k2) { const f32x2 cc = (f32x2){cw[k2].x, cw[k2].x}, ss = (f32x2){cw[k2].y, cw[k2].y};
#pragma unroll
                            for (int e = 0; e < 4; ++e) { acc[4 * (q & 1) + k2][e] = __builtin_elementwise_fma((f32x2){bf_at(va[q], 2 * e), bf_at(va[q], 2 * e + 1)}, cc, acc[4 * (q & 1) + k2][e]);
                                                          acc[4 * (q & 1) + k2][e] = __builtin_elementwise_fma((f32x2){bf_at(vp[q], 2 * e), bf_at(vp[q], 2 * e + 1)}, ss, acc[4 * (q & 1) + k2][e]); }
                            const float nc = cw[k2].x * st[k2].x - cw[k2].y * st[k2].y, ns = cw[k2].y * st[k2].x + cw[k2].x * st[k2].y; cw[k2] = (f32x2){nc, ns}; }
                    }
                }
#pragma unroll
                for (int k2 = 0; k2 < 8; ++k2) { u32x4 w; f32x2 o[4];
#pragma unroll
                    for (int e = 0; e < 4; ++e) o[e] = k2 < 4 ? acc[k2][e] + acc[4 + k2][e] : acc[k2 - 4][e] - acc[k2][e];
                    w.x = cvt_pk_bf16(o[0].x, o[0].y); w.y = cvt_pk_bf16(o[1].x, o[1].y);
                    w.z = cvt_pk_bf16(o[2].x, o[2].y); w.w = cvt_pk_bf16(o[3].x, o[3].y);
                    *(GAS u32x4*)((GAS bf16_t*)H2048 + ((size_t)t * SS + k1 + CG * k2) * D + ch0) = w; }
            }
        }
    }
}

#define TIC() do { if (PROBE_CAT) pt0 = __builtin_amdgcn_s_memrealtime(); } while (0)
#define TOC(cat) do { if (PROBE_CAT == (cat)) pacc += __builtin_amdgcn_s_memrealtime() - pt0; } while (0)
#define GRID_BAR() do { TIC(); xcd_barrier(bar); TOC(2); } while (0)
__global__ void __launch_bounds__(NWAVES * 64, 2) fwd_kernel(Ptrs P) {
    extern __shared__ __attribute__((aligned(16))) unsigned char lds_raw[];
    LAS unsigned char* lds = (LAS unsigned char*)lds_raw;
    const int tid = threadIdx.x, lane = tid & 63, wave = __builtin_amdgcn_readfirstlane(tid >> 6);
    const int G = gridDim.x, bx = blockIdx.x;
    const int vcu = (G % 8 == 0) ? (bx % 8) * (G / 8) + bx / 8 : bx;
    const int gw = vcu * NWAVES + wave, NGW = G * NWAVES;
    for (int u = tid; u < (LDS_BYTES - LDSCTL_OFF) / 4; u += NWAVES * 64) ((LAS unsigned*)(lds + LDSCTL_OFF))[u] = 0u;
    __syncthreads();
    volatile LAS unsigned* MISC = (volatile LAS unsigned*)(lds + MISC_OFF);
    XcdBarrier bar = xcd_barrier_post((unsigned*)(P.ws + WS_CTL) + CW_BAR, MISC + 8);

#define WIN ((bf16_t*)wsp(P.ws, WS_WIN))
#define AWO ((bf16_t*)wsp(P.ws, WS_AWO))
#define FWO ((bf16_t*)wsp(P.ws, WS_FWO))
#define WUP ((bf16_t*)wsp(P.ws, WS_WUP))
#define WDN ((bf16_t*)wsp(P.ws, WS_WDN))
#define HART ((bf16_t*)wsp(P.ws, WS_HART))
#define PT ((bf16_t*)wsp(P.ws, WS_PT))
#define TW ((const f32x2*)wsp(P.ws, WS_TW))
#define TWS ((const f32x2*)wsp(P.ws, WS_TW + 1 * MiB))
#define H256 ((bf16_t*)wsp(P.ws, WS_H256))
#define B1 ((bf16_t*)wsp(P.ws, WS_B1))
#define B2 ((bf16_t*)wsp(P.ws, WS_B2))
#define B3 ((bf16_t*)wsp(P.ws, WS_B3))

    unsigned long long pacc = 0ull, pt0 = 0ull;
    TIC(); prologue(P, lds, gw, NGW, wave, lane); TOC(1);
    GRID_BAR();

#define PTG PT
#define RSB ((u64*)wsp(P.ws, WS_RS))
#define XS B1
#pragma unroll 1
    for (int layer = 0; layer < 4; ++layer) {
        const int j = layer >> 1;
        u64* RS0 = RSB + (size_t)(2 * layer) * (RS_STRIDE / 8);
        u64* RS1 = RS0 + RS_STRIDE / 8;
        u64* RS2 = RS1 + RS_STRIDE / 8;
        if ((layer & 1) == 0) {
            {
                pg8::DescPlain g{XS, WIN + (size_t)j * 3 * D * D, D, D, D}; pg8::StaticOrder S; S.init(M, 3 * D, G, bx, 4, 1);
                pg8::EpiGate E{B2, B3};
                pg8::gemm_phase<pg8::DescPlain, pg8::EpiGate, true, true>(lds, g, S, E, pacc);
            }
            GRID_BAR();
            TIC(); conv_phase(B2, B3, P.a_conv_w + (size_t)j * 3 * D, RS0, B2, gw, NGW, lane); TOC(1);
            GRID_BAR();
        } else {
            bf16_t* VTS = B2 + (size_t)RAD * D * SS; bf16_t* USM = B3 + (size_t)RAD * SS * D;
#pragma unroll 1
            for (int pr = 1; pr >= 0; --pr) {
                pg8::DescF0 g{PTG + (size_t)j * NGRP * CG * CG, pr ? XS : XS + (size_t)MP * D, CG, CG, pr ? 64 * D : 8 * D, pr}; pg8::StaticOrder S; S.init(D, pr ? MP : MS, G, bx);
                pg8::EpiBf16<2> E{pr ? B2 : VTS, CG, RS0, pr, nullptr, 0};
                pg8::gemm_phase<pg8::DescF0, pg8::EpiBf16<2>, true, true>(lds, g, S, E, pacc);
            }
            GRID_BAR();
            {
                pg8::DescF2 g{H256, B2, CG, CG, CG, 0, 0}; pg8::StaticOrder S; S.init(M, D, G, bx);
                pg8::EpiBf16<0> E{B3, D, nullptr, 0, nullptr, 0};
                pg8::gemm_phase<pg8::DescF2, pg8::EpiBf16<0>, true, true>(lds, g, S, E, pacc);
            }
            GRID_BAR();
#pragma unroll 1
            for (int mode = 1; mode <= 2; ++mode) {
                TIC(); post_phase(mode, B2, USM, TW, TWS, B3, B2, B3, B2, gw, NGW, lane); TOC(1);
                GRID_BAR();
            }
        }
        {
            pg8::DescSplit g{(layer & 1) ? B3 : B2, B2 + (size_t)MP * D, MP / BMT, ((layer & 1) == 0 ? AWO : FWO) + (size_t)j * D * D, D, D, D, 0}; pg8::StaticOrder S; S.init(M, D, G, bx, 4);
            pg8::EpiRes<false> E{XS, RS1, 0, nullptr};
            pg8::gemm_phase<pg8::DescSplit, pg8::EpiRes<false>, true, true>(lds, g, S, E, pacc);
        }
        GRID_BAR();
        {
            pg8::DescPlain g{XS, WUP + (size_t)layer * D * DFF, D, D, D}; pg8::StaticOrder S; S.init(M, DFF, G, bx, 4, 1);
            pg8::EpiBf16<1> E{B2, DFF, nullptr, 0, (bf16_t*)P.out, MCH / BMT};
            pg8::gemm_phase<pg8::DescPlain, pg8::EpiBf16<1>, true, true>(lds, g, S, E, pacc);
        }
        GRID_BAR();
        {
            pg8::DescSplit g{B2, (const bf16_t*)P.out, MCH / BMT, WDN + (size_t)layer * D * DFF, DFF, DFF, DFF, 1}; pg8::StaticOrder S; S.init(M, D, G, bx, 4);
            pg8::EpiRes<true> E{XS, RS2, 0, RS1};
            pg8::gemm_phase<pg8::DescSplit, pg8::EpiRes<true>, true, true>(lds, g, S, E, pacc);
        }
        GRID_BAR();
    }
    TIC(); final_norm_phase(XS, P.out, RSB + (size_t)8 * (RS_STRIDE / 8), P.final_norm, gw, NGW, lane); TOC(1);
    if (PROBE_CAT && bx == 0 && wave == 0) { const unsigned long long te = __builtin_amdgcn_s_memrealtime() + PROBE_ALPHA * pacc; while (__builtin_amdgcn_s_memrealtime() < te) __builtin_amdgcn_s_sleep(8); }
}

#undef WIN
#undef AWO
#undef FWO
#undef WUP
#undef WDN
#undef HART
#undef PT
#undef TW
#undef TWS
#undef H256
#undef B1
#undef B2
#undef B3
#undef PTG
#undef RSB
#undef XS
extern "C" void kernel_launch(void* const* d_in, const int* in_sizes, int n_in, void* d_out, int out_size, void* d_ws, size_t ws_size, hipStream_t stream) {
    static int grid = 0;
    if (grid == 0) {
        if (n_in != 11 || out_size != M * D || ws_size < WS_END) { fprintf(stderr, "kernel_launch: unexpected shapes (n_in %d, out %d, ws %zu)\n", n_in, out_size, ws_size); grid = -1; return; }
        int dev = 0, cus = 0, per_cu = 0;
        if (hipGetDevice(&dev) != hipSuccess || hipDeviceGetAttribute(&cus, hipDeviceAttributeMultiprocessorCount, dev) != hipSuccess) { grid = -1; return; }
        if (hipFuncSetAttribute((const void*)fwd_kernel, hipFuncAttributeMaxDynamicSharedMemorySize, LDS_BYTES) != hipSuccess) { fprintf(stderr, "kernel_launch: hipFuncSetAttribute failed\n"); grid = -1; return; }
        if (hipOccupancyMaxActiveBlocksPerMultiprocessor(&per_cu, (const void*)fwd_kernel, NWAVES * 64, LDS_BYTES) != hipSuccess || per_cu < 1)
            fprintf(stderr, "kernel_launch: occupancy query reports %d workgroups per CU\n", per_cu);
        (void)hipGetLastError();
        grid = cus;
    }
    if (grid < 0) return;
    if (hipMemsetAsync((char*)d_ws + WS_CTL, 0, CTL_ZERO_BYTES, stream) != hipSuccess) return;
    Ptrs p{};
    p.x_prompt = (const float*)d_in[0]; p.x_sample = (const float*)d_in[1]; p.norm_mix = (const float*)d_in[2]; p.a_w_in = (const float*)d_in[3];
    p.a_conv_w = (const float*)d_in[4]; p.a_w_out = (const float*)d_in[5]; p.f_w_out = (const float*)d_in[6]; p.norm_ffn = (const float*)d_in[7];
    p.w_up = (const float*)d_in[8]; p.w_down = (const float*)d_in[9]; p.final_norm = (const float*)d_in[10];
    p.out = (float*)d_out; p.ws = (unsigned char*)d_ws;
    hipLaunchKernelGGL(fwd_kernel, dim3(grid), dim3(NWAVES * 64), LDS_BYTES, stream, p);
    const hipError_t le = hipPeekAtLastError();
    if (le != hipSuccess) fprintf(stderr, "kernel_launch: launch failed: %s\n", hipGetErrorName(le));
    (void)in_sizes;
}
```
